# Optimizing an MI355X kernel written in HIP

```python
import math
import jax, jax.numpy as jnp
from jax import lax
import numpy as np

D_MODEL = 1024
BATCH = 16
SEQ = 4096
DEPTH = 1
DEC_BATCH = 32
DEC_SEQ = 32
PAST_LEN = 1024

CHUNK = 64
D_CONV = 512
CONV_A_WIDTH = 3
N_HEADS_GDN = 4
HEAD_DIM = 128
D_GDN = N_HEADS_GDN * HEAD_DIM
D_QKV = 3 * D_GDN
CONV_QKV_WIDTH = 4
D_MIX = D_CONV + D_GDN
PROJ_SIZES = (D_CONV, D_CONV, D_CONV, D_CONV, D_QKV, D_GDN, N_HEADS_GDN, N_HEADS_GDN)
D_PROJ = 4 * D_CONV + D_QKV + D_GDN + 2 * N_HEADS_GDN
RMS_EPS = 1e-6
L2_EPS = 1e-6

kernel_name = "hybrid_shortconv_gated_deltanet_stream_step"


def rmsnorm(x, w):
    xf = x.astype(jnp.float32)
    var = jnp.mean(xf * xf, axis=-1, keepdims=True)
    return (xf * lax.rsqrt(var + RMS_EPS) * w.astype(jnp.float32)).astype(x.dtype)


def l2norm(x):
    xf = x.astype(jnp.float32)
    return xf * lax.rsqrt(jnp.sum(xf * xf, axis=-1, keepdims=True) + L2_EPS)


def causal_dwconv(u, buf, w):
    width = w.shape[0]
    t = u.shape[1]
    ucat = jnp.concatenate([buf.astype(u.dtype), u], axis=1)
    y = ucat[:, 0:t] * w[0]
    for j in range(1, width):
        y = y + ucat[:, j:j + t] * w[j]
    return y, ucat[:, t:]


def gated_delta_rule(q, k, v, g, beta, s0):
    f32 = jnp.float32
    bsz, t, h, dk = q.shape
    dv = v.shape[-1]
    c = math.gcd(t, CHUNK)
    n = t // c

    def blocks(a):
        a = a.astype(f32).reshape((bsz, n, c) + a.shape[2:])
        return jnp.moveaxis(a, 3, 1)

    qb = blocks(q) * (dk ** -0.5)
    kb = blocks(k)
    vb = blocks(v)
    gb = jnp.cumsum(blocks(g), axis=-1)
    bb = blocks(beta)

    incl = jnp.tril(jnp.ones((c, c), dtype=bool))
    strict = jnp.tril(jnp.ones((c, c), dtype=bool), -1)
    diff = gb[..., :, None] - gb[..., None, :]
    decay = jnp.where(incl, jnp.exp(jnp.where(incl, diff, 0.0)), 0.0)

    kbeta = kb * bb[..., None]
    a_mat = jnp.where(strict, jnp.einsum('bhnid,bhnjd->bhnij', kbeta, kb) * decay, 0.0)
    eye = jnp.broadcast_to(jnp.eye(c, dtype=f32), a_mat.shape)
    t_mat = lax.linalg.triangular_solve(a_mat, eye, left_side=True, lower=True,
                                        unit_diagonal=True)
    u = jnp.einsum('bhnij,bhnjd->bhnid', t_mat, vb * bb[..., None])
    w = jnp.einsum('bhnij,bhnjd->bhnid', t_mat, kbeta * jnp.exp(gb)[..., None])
    qg = qb * jnp.exp(gb)[..., None]
    attn = jnp.einsum('bhnid,bhnjd->bhnij', qb, kb) * decay
    g_last = gb[..., -1]
    kdec = kb * jnp.exp(g_last[..., None] - gb)[..., None]

    def step(s, xs):
        u_i, w_i, qg_i, attn_i, kdec_i, gl_i = xs
        v_new = u_i - jnp.einsum('bhcd,bhde->bhce', w_i, s)
        o_i = (jnp.einsum('bhcd,bhde->bhce', qg_i, s)
               + jnp.einsum('bhij,bhje->bhie', attn_i, v_new))
        s = s * jnp.exp(gl_i)[..., None, None] + jnp.einsum('bhcd,bhce->bhde', kdec_i, v_new)
        return s, o_i

    xs = (jnp.moveaxis(u, 2, 0), jnp.moveaxis(w, 2, 0), jnp.moveaxis(qg, 2, 0),
          jnp.moveaxis(attn, 2, 0), jnp.moveaxis(kdec, 2, 0), jnp.moveaxis(g_last, 2, 0))
    s_fin, o = lax.scan(step, s0.astype(f32), xs)
    o = jnp.moveaxis(o, 0, 2).reshape(bsz, h, t, dv).transpose(0, 2, 1, 3)
    return o, s_fin


def hybrid_layer(x, buf_a, buf_qkv, s0, ln_pre, w_in, conv_a_w, conv_qkv_w,
                 a_log, dt_bias, gdn_norm_w, w_out, ln_post):
    f32 = jnp.float32
    bsz, t, _ = x.shape
    h = rmsnorm(x, ln_pre)
    proj = jnp.einsum('btd,dp->btp', h, w_in)
    splits = np.cumsum(np.array(PROJ_SIZES))[:-1].tolist()
    b_a, c_a, x_a, z_a, qkv, z_g, a_dec, b_beta = jnp.split(proj, splits, axis=-1)

    conv_a, new_buf_a = causal_dwconv(c_a * x_a, buf_a, conv_a_w)
    y_a = b_a * conv_a * jax.nn.silu(z_a)

    qkv, new_buf_qkv = causal_dwconv(qkv, buf_qkv, conv_qkv_w)
    qkv = jax.nn.silu(qkv)
    q, k, v = jnp.split(qkv, 3, axis=-1)

    def heads(a):
        return a.reshape(bsz, t, N_HEADS_GDN, HEAD_DIM)

    q = l2norm(heads(q))
    k = l2norm(heads(k))
    v = heads(v)
    g = -jnp.exp(a_log.astype(f32)) * jax.nn.softplus(a_dec.astype(f32) + dt_bias.astype(f32))
    beta = jax.nn.sigmoid(b_beta.astype(f32))
    o, s_new = gated_delta_rule(q, k, v, g, beta, s0)
    o = rmsnorm(o, gdn_norm_w) * jax.nn.silu(heads(z_g).astype(f32))
    y_g = o.reshape(bsz, t, D_GDN).astype(x.dtype)

    mix = jnp.concatenate([y_a, y_g], axis=-1)
    out = jnp.einsum('btm,md->btd', mix, w_out)
    y = x + rmsnorm(out, ln_post)
    return y, new_buf_a, new_buf_qkv, s_new.astype(s0.dtype)


def setup_inputs(seed: int = 0) -> dict:
    key = jax.random.key(seed)
    ks = jax.random.split(key, 16)
    f32 = jnp.float32
    x_prompt = jax.random.normal(ks[0], (BATCH, SEQ, D_MODEL), f32)
    x_sample = jax.random.normal(ks[1], (DEC_BATCH, DEC_SEQ, D_MODEL), f32)
    cache_conv_a = jax.random.normal(ks[2], (DEPTH, DEC_BATCH, CONV_A_WIDTH - 1, D_CONV), f32)
    cache_conv_qkv = jax.random.normal(ks[3], (DEPTH, DEC_BATCH, CONV_QKV_WIDTH - 1, D_QKV), f32)
    state_gdn = 0.1 * jax.random.normal(ks[4], (DEPTH, DEC_BATCH, N_HEADS_GDN, HEAD_DIM, HEAD_DIM), f32)
    ln_pre = 1.0 + 0.01 * jax.random.normal(ks[5], (DEPTH, D_MODEL), f32)
    w_in = jax.random.normal(ks[6], (DEPTH, D_MODEL, D_PROJ), f32) * D_MODEL ** -0.5
    conv_a_w = jax.random.normal(ks[7], (DEPTH, CONV_A_WIDTH, D_CONV), f32) * CONV_A_WIDTH ** -0.5
    conv_qkv_w = jax.random.normal(ks[8], (DEPTH, CONV_QKV_WIDTH, D_QKV), f32) * CONV_QKV_WIDTH ** -0.5
    a_log = jnp.log(jax.random.uniform(ks[9], (DEPTH, N_HEADS_GDN), f32, 1.0, 16.0))
    dt_bias = 0.1 * jax.random.normal(ks[10], (DEPTH, N_HEADS_GDN), f32)
    gdn_norm_w = 1.0 + 0.01 * jax.random.normal(ks[11], (DEPTH, HEAD_DIM), f32)
    w_out = jax.random.normal(ks[12], (DEPTH, D_MIX, D_MODEL), f32) * D_MIX ** -0.5
    ln_post = 1.0 + 0.01 * jax.random.normal(ks[13], (DEPTH, D_MODEL), f32)
    return {"x_prompt": x_prompt, "x_sample": x_sample,
            "cache_conv_a": cache_conv_a, "cache_conv_qkv": cache_conv_qkv, "state_gdn": state_gdn,
            "ln_pre": ln_pre, "w_in": w_in, "conv_a_w": conv_a_w, "conv_qkv_w": conv_qkv_w,
            "a_log": a_log, "dt_bias": dt_bias, "gdn_norm_w": gdn_norm_w,
            "w_out": w_out, "ln_post": ln_post}


def reference(x_prompt, x_sample, cache_conv_a, cache_conv_qkv, state_gdn,
              ln_pre, w_in, conv_a_w, conv_qkv_w, a_log, dt_bias, gdn_norm_w, w_out, ln_post):
    y_p = x_prompt
    y_s = x_sample
    p_a, p_qkv, p_s = [], [], []
    s_a, s_qkv, s_s = [], [], []
    for layer in range(DEPTH):
        params = (ln_pre[layer], w_in[layer], conv_a_w[layer], conv_qkv_w[layer],
                  a_log[layer], dt_bias[layer], gdn_norm_w[layer], w_out[layer], ln_post[layer])
        bsz = y_p.shape[0]
        zero_a = jnp.zeros((bsz, CONV_A_WIDTH - 1, D_CONV), y_p.dtype)
        zero_qkv = jnp.zeros((bsz, CONV_QKV_WIDTH - 1, D_QKV), y_p.dtype)
        zero_s = jnp.zeros((bsz, N_HEADS_GDN, HEAD_DIM, HEAD_DIM), state_gdn.dtype)
        y_p, ba, bq, st = hybrid_layer(y_p, zero_a, zero_qkv, zero_s, *params)
        p_a.append(ba)
        p_qkv.append(bq)
        p_s.append(st)
        y_s, ba, bq, st = hybrid_layer(y_s, cache_conv_a[layer], cache_conv_qkv[layer],
                                       state_gdn[layer], *params)
        s_a.append(ba)
        s_qkv.append(bq)
        s_s.append(st)
    return (y_p, y_s, jnp.stack(p_a), jnp.stack(p_qkv), jnp.stack(p_s),
            jnp.stack(s_a), jnp.stack(s_qkv), jnp.stack(s_s))
```

```cpp
#include <hip/hip_runtime.h>
#include <hip/hip_cooperative_groups.h>
#include <cstdio>
#include <cstdint>
namespace cg = cooperative_groups;
#ifndef ONE_LAUNCH
#define ONE_LAUNCH 0
#endif
namespace pg8 {
#define PG8_LAS __attribute__((address_space(3)))
typedef unsigned short bf16_t;
typedef short bf16x8 __attribute__((ext_vector_type(8)));
typedef float f32x4 __attribute__((ext_vector_type(4)));
typedef unsigned u32x4 __attribute__((ext_vector_type(4)));
constexpr int BM = 256, BK = 64, HALF = 128, HTB = HALF * BK * 2  , STAGE_BYTES = 8 * HTB, NXCD = 8, WGM = 8;

__host__ __device__ __forceinline__ int lds_byte(int r, int c) { const int st = (r >> 4) * 2 + (c >> 5), rr = r & 15, cc = c & 31, ob = rr * 64 + cc * 2; return st * 1024 + (ob ^ (((ob >> 9) & 1) << 5)); }
__host__ __device__ __forceinline__ void stage_rc(int b, int& R, int& C) { const int st = b / 1024, sb = b % 1024, swz = sb ^ (((sb >> 9) & 1) << 5); R = (st >> 1) * 16 + swz / 64; C = (st & 1) * 32 + (swz % 64) / 2; }
__host__ __device__ __forceinline__ int perm32(int rho) { const int n = rho >> 4, i = rho & 15; return 8 * (i >> 2) + 4 * n + (i & 3); }

struct Unit { int pm, pn; };
struct Gemm { const bf16_t* A; const bf16_t* Bt; int M, N, K; };

struct StaticOrder {
    int nM, nN, nwg, G, c;
    __host__ __device__ void init(int M, int N, int G_, int c_) { nM = M / BM; nN = N / BM; nwg = nM * nN; G = G_; c = c_; }
    __host__ __device__ bool next(int i, Unit& u) const {
        const long L = (long)i * G + c; if (L >= nwg) return false;
        int wgid = (int)L; { const int q = nwg / NXCD, r = nwg % NXCD, xcd = wgid % NXCD, off = wgid / NXCD; wgid = (xcd < r ? xcd * (q + 1) : r * (q + 1) + (xcd - r) * q) + off; }
        const int nig = WGM * nN, gid = wgid / nig, fm = gid * WGM, gsz = (nM - fm) < WGM ? (nM - fm) : WGM;
        u.pm = fm + ((wgid % nig) % gsz); u.pn = (wgid % nig) / gsz; return true;
    }
    __device__ __forceinline__ void a_ready(const Unit&) const {}
    __device__ __forceinline__ void done(const Unit&) const {}
};
__device__ __forceinline__ unsigned cvt_pk_bf16(float lo, float hi) { unsigned r; asm volatile("v_cvt_pk_bf16_f32 %0, %1, %2" : "=v"(r) : "v"(lo), "v"(hi)); return r; }

struct EpiProj {
    static constexpr bool PERM = true, AFTER_DRAIN = false;
    bf16_t* O; int ldc; const float* rstd;
    __device__ __forceinline__ void operator()(const f32x4 (&acc)[2][2][4][2], const Unit& u, int wr, int wc, int fr, int fq) const {
        const int row0 = u.pm * BM + wr * 64 + fr; const int col0 = u.pn * BM + wc * 32 + 8 * fq;
#pragma unroll
        for (int ai = 0; ai < 2; ++ai)
#pragma unroll
            for (int m = 0; m < 4; ++m) { const int r = row0 + ai * HALF + m * 16; const float sc = rstd[r]; bf16_t* rowp = O + (size_t)r * ldc + col0;
#pragma unroll
                for (int bj = 0; bj < 2; ++bj) { const f32x4 v0 = acc[ai][bj][m][0] * sc, v1 = acc[ai][bj][m][1] * sc;
                    u32x4 w; w.x = cvt_pk_bf16(v0[0], v0[1]); w.y = cvt_pk_bf16(v0[2], v0[3]); w.z = cvt_pk_bf16(v1[0], v1[1]); w.w = cvt_pk_bf16(v1[2], v1[3]);
                    *(u32x4*)(rowp + bj * HALF) = w; } }
    }
};
struct EpiF32 {
    static constexpr bool PERM = false, AFTER_DRAIN = false;
    float* C; int ldc;
    __device__ __forceinline__ void operator()(const f32x4 (&acc)[2][2][4][2], const Unit& u, int wr, int wc, int fr, int fq) const {
        const int row0 = u.pm * BM + wr * 64 + fr, col0 = u.pn * BM + wc * 32 + 4 * fq;
#pragma unroll
        for (int ai = 0; ai < 2; ++ai)
#pragma unroll
            for (int m = 0; m < 4; ++m) { float* rowp = C + (size_t)(row0 + ai * HALF + m * 16) * ldc + col0;
#pragma unroll
                for (int bj = 0; bj < 2; ++bj)
#pragma unroll
                    for (int n = 0; n < 2; ++n) *(f32x4*)(rowp + bj * HALF + n * 16) = acc[ai][bj][m][n]; }
    }
};
template <class Epi, class Sched, bool ALIGN_EPI = false, bool SP2 = false>
__device__ __forceinline__ void gemm_phase(PG8_LAS unsigned char* lds, const Gemm g, const Sched& S, const Epi& E) {
    const int tid = threadIdx.x, wid = __builtin_amdgcn_readfirstlane(tid >> 6), lane = tid & 63, wr = wid >> 2, wc = wid & 3, fr = lane & 15, fq = lane >> 4;
    const int K = g.K, nt = K / BK;
    unsigned voffA[2], voffB[2];
#pragma unroll
    for (int i = 0; i < 2; ++i) { int R, C; stage_rc(tid * 16 + i * 8192, R, C); const int Rb = Epi::PERM ? ((R & ~31) + perm32(R & 31)) : R;
        voffA[i] = (unsigned)(R * K + C) * 2u; voffB[i] = (unsigned)(Rb * K + C) * 2u; }
    const size_t kstep = (size_t)(BK * 2);
    const size_t hstep = (size_t)HALF * K * 2;
    const size_t tstep = 2 * hstep;
    const unsigned ldsw = (unsigned)wid * 1024u;
    const int aoff = lds_byte(wr * 64 + fr, fq * 8), boff = lds_byte(wc * 32 + fr, fq * 8);
#define PG8_SA(b, h) (((b) * 2 + (h)) * HTB)
#define PG8_SB(b, h) ((4 + (b) * 2 + (h)) * HTB)
#define PG8_STAGE(bufoff, gbase, voff) do { _Pragma("unroll") for (int _i = 0; _i < 2; ++_i) \
        __builtin_amdgcn_global_load_lds((const unsigned*)((const char*)(gbase) + (voff)[_i]), (PG8_LAS unsigned*)(lds + (bufoff) + ldsw + _i * 8192), 16, 0, 0); } while (0)
#define PG8_LDA(dst, b, h) do { _Pragma("unroll") for (int m = 0; m < 4; ++m) _Pragma("unroll") for (int k = 0; k < 2; ++k) dst[m][k] = *(const PG8_LAS bf16x8*)(lds + PG8_SA(b, h) + aoff + m * 2048 + k * 1024); } while (0)
#define PG8_LDB(dst, b, h) do { _Pragma("unroll") for (int n = 0; n < 2; ++n) _Pragma("unroll") for (int k = 0; k < 2; ++k) dst[n][k] = *(const PG8_LAS bf16x8*)(lds + PG8_SB(b, h) + boff + n * 2048 + k * 1024); } while (0)
#define PG8_MMA(ai, bj, At, Bt) do { __builtin_amdgcn_s_setprio(1); _Pragma("unroll") for (int m = 0; m < 4; ++m) _Pragma("unroll") for (int n = 0; n < 2; ++n) _Pragma("unroll") for (int k = 0; k < 2; ++k) \
        acc[ai][bj][m][n] = __builtin_amdgcn_mfma_f32_16x16x32_bf16(Bt[n][k], At[m][k], acc[ai][bj][m][n], 0, 0, 0); __builtin_amdgcn_s_setprio(0); } while (0)
#define PG8_WAIT_V(n) asm volatile("s_waitcnt vmcnt(" #n ")" ::: "memory")
#define PG8_WAIT_L(n) asm volatile("s_waitcnt lgkmcnt(" #n ")" ::: "memory")
#define PG8_BAR __builtin_amdgcn_s_barrier()
#define PG8_SCHED __builtin_amdgcn_sched_barrier(0)
    Unit cur, nxt; int ui = 0;
    if (!S.next(0, cur)) return;
    f32x4 acc[2][2][4][2];
#pragma unroll
    for (int a = 0; a < 2; ++a)
#pragma unroll
        for (int b = 0; b < 2; ++b)
#pragma unroll
            for (int m = 0; m < 4; ++m)
#pragma unroll
                for (int n = 0; n < 2; ++n) acc[a][b][m][n] = (f32x4){0.f, 0.f, 0.f, 0.f};
    bf16x8 At[4][2], B0[2][2], B1[2][2];
    const char* cA = (const char*)g.A + (size_t)cur.pm * tstep; const char* cB = (const char*)g.Bt + (size_t)cur.pn * tstep;
    S.a_ready(cur);
    if constexpr (SP2) {
        PG8_STAGE(PG8_SB(0, 0), cB, voffB); PG8_STAGE(PG8_SB(0, 1), cB + hstep, voffB); PG8_STAGE(PG8_SA(0, 0), cA, voffA); PG8_STAGE(PG8_SA(0, 1), cA + hstep, voffA);
        if (wr == 1) PG8_BAR;
        PG8_WAIT_V(2); PG8_BAR;
        PG8_STAGE(PG8_SB(1, 0), cB + kstep, voffB); PG8_STAGE(PG8_SA(1, 0), cA + kstep, voffA); PG8_STAGE(PG8_SB(1, 1), cB + hstep + kstep, voffB);
        PG8_WAIT_V(6); PG8_BAR;
    } else {
        PG8_STAGE(PG8_SB(0, 0), cB, voffB); PG8_STAGE(PG8_SA(0, 0), cA, voffA); PG8_STAGE(PG8_SB(0, 1), cB + hstep, voffB); PG8_STAGE(PG8_SA(0, 1), cA + hstep, voffA);
        if (wr == 1) PG8_BAR;
        PG8_WAIT_V(4); PG8_BAR;
        PG8_STAGE(PG8_SB(1, 0), cB + kstep, voffB); PG8_STAGE(PG8_SA(1, 0), cA + kstep, voffA); PG8_STAGE(PG8_SB(1, 1), cB + hstep + kstep, voffB);
        PG8_WAIT_V(6); PG8_BAR;
    }
    for (;;) {
        const bool has_next = S.next(ui + 1, nxt);
        const char* nA = has_next ? (const char*)g.A + (size_t)nxt.pm * tstep : cA; const char* nB = has_next ? (const char*)g.Bt + (size_t)nxt.pn * tstep : cB;
        for (int t = 0; t < nt; t += 2) {
            const bool last = (t == nt - 2);
            const char* a1 = cA + (size_t)(t + 1) * kstep;
            const char* a2 = last ? nA : cA + (size_t)(t + 2) * kstep; const char* b2 = last ? nB : cB + (size_t)(t + 2) * kstep;
            const char* a3 = a2 + kstep; const char* b3 = b2 + kstep;
            if (last && has_next) S.a_ready(nxt);
            if constexpr (SP2) {
            PG8_LDB(B0, 0, 0); PG8_LDB(B1, 0, 1); PG8_SCHED; PG8_LDA(At, 0, 0); PG8_STAGE(PG8_SA(1, 1), a1 + hstep, voffA);
            PG8_WAIT_V(8); PG8_WAIT_L(0); PG8_BAR; PG8_MMA(0, 0, At, B0); PG8_MMA(0, 1, At, B1); PG8_BAR; PG8_SCHED;
            PG8_LDA(At, 0, 1); PG8_STAGE(PG8_SB(0, 0), b2, voffB); PG8_STAGE(PG8_SB(0, 1), b2 + hstep, voffB); PG8_STAGE(PG8_SA(0, 0), a2, voffA);
            PG8_WAIT_V(8); PG8_WAIT_L(0); PG8_BAR; PG8_MMA(1, 0, At, B0); PG8_MMA(1, 1, At, B1); PG8_BAR; PG8_SCHED;
            PG8_LDB(B0, 1, 0); PG8_LDB(B1, 1, 1); PG8_SCHED; PG8_LDA(At, 1, 0); PG8_STAGE(PG8_SA(0, 1), a2 + hstep, voffA);
            PG8_WAIT_V(8); PG8_WAIT_L(0); PG8_BAR; PG8_MMA(0, 0, At, B0); PG8_MMA(0, 1, At, B1); PG8_BAR; PG8_SCHED;
            PG8_LDA(At, 1, 1); PG8_STAGE(PG8_SB(1, 0), b3, voffB); PG8_STAGE(PG8_SB(1, 1), b3 + hstep, voffB); PG8_STAGE(PG8_SA(1, 0), a3, voffA);
            PG8_WAIT_V(8); PG8_WAIT_L(0); PG8_BAR; PG8_MMA(1, 0, At, B0); PG8_MMA(1, 1, At, B1); PG8_BAR; PG8_SCHED;
            } else {
            PG8_LDB(B0, 0, 0); PG8_SCHED; PG8_LDA(At, 0, 0); PG8_STAGE(PG8_SA(1, 1), a1 + hstep, voffA);
            PG8_WAIT_L(8); PG8_BAR; PG8_WAIT_L(0); PG8_MMA(0, 0, At, B0); PG8_BAR; PG8_SCHED;
            PG8_LDB(B1, 0, 1); PG8_STAGE(PG8_SB(0, 0), b2, voffB);
            PG8_BAR; PG8_WAIT_L(0); PG8_MMA(0, 1, At, B1); PG8_BAR;
            PG8_LDA(At, 0, 1); PG8_STAGE(PG8_SA(0, 0), a2, voffA);
            PG8_BAR; PG8_WAIT_L(0); PG8_MMA(1, 0, At, B0); PG8_BAR; PG8_SCHED;
            PG8_STAGE(PG8_SB(0, 1), b2 + hstep, voffB);
            PG8_WAIT_V(6); PG8_BAR; PG8_MMA(1, 1, At, B1); PG8_BAR;
            PG8_LDB(B0, 1, 0); PG8_SCHED; PG8_LDA(At, 1, 0); PG8_STAGE(PG8_SA(0, 1), a2 + hstep, voffA);
            PG8_WAIT_L(8); PG8_BAR; PG8_WAIT_L(0); PG8_MMA(0, 0, At, B0); PG8_BAR; PG8_SCHED;
            PG8_LDB(B1, 1, 1); PG8_STAGE(PG8_SB(1, 0), b3, voffB);
            PG8_BAR; PG8_WAIT_L(0); PG8_MMA(0, 1, At, B1); PG8_BAR;
            PG8_LDA(At, 1, 1); PG8_STAGE(PG8_SA(1, 0), a3, voffA);
            PG8_BAR; PG8_WAIT_L(0); PG8_MMA(1, 0, At, B0); PG8_BAR; PG8_SCHED;
            PG8_STAGE(PG8_SB(1, 1), b3 + hstep, voffB);
            PG8_WAIT_V(6); PG8_BAR; PG8_MMA(1, 1, At, B1); PG8_BAR;
            }
        }
        if constexpr (ALIGN_EPI) { if (wr == 0) PG8_BAR; }
        if constexpr (!Epi::AFTER_DRAIN) { E(acc, cur, wr, wc, fr, fq); S.done(cur); }
        if (!has_next) break;
#pragma unroll
        for (int a = 0; a < 2; ++a)
#pragma unroll
            for (int b = 0; b < 2; ++b)
#pragma unroll
                for (int m = 0; m < 4; ++m)
#pragma unroll
                    for (int n = 0; n < 2; ++n) acc[a][b][m][n] = (f32x4){0.f, 0.f, 0.f, 0.f};
        cur = nxt; cA = nA; cB = nB; ++ui;
        if constexpr (ALIGN_EPI) { if (wr == 1) PG8_BAR; }
    }
    PG8_WAIT_V(0);
    if constexpr (!ALIGN_EPI) { if (wr == 0) PG8_BAR; }
    PG8_BAR;
    if constexpr (Epi::AFTER_DRAIN) { E.fused(acc, cur, wr, wc, fr, fq, lds, wid, lane); S.done(cur); }
#undef PG8_SA
#undef PG8_SB
#undef PG8_STAGE
#undef PG8_LDA
#undef PG8_LDB
#undef PG8_MMA
#undef PG8_WAIT_V
#undef PG8_WAIT_L
#undef PG8_BAR
#undef PG8_SCHED
}
}

#define LAS __attribute__((address_space(3)))
typedef unsigned short bf16;
typedef unsigned v4u __attribute__((ext_vector_type(4)));
typedef unsigned v2u __attribute__((ext_vector_type(2)));
typedef float f32x4 __attribute__((ext_vector_type(4)));

constexpr int D = 1024, MP = 16 * 4096, MS = 32 * 32, MT = MP + MS, SEQ = 4096, DSEQ = 32, NB = 16, NBS = 32;
constexpr int NPROJ = 4104, NP = 4096, DC = 512, DQKV = 1536, NH = 4, HD = 128;
constexpr int C_BA = 0, C_CA = 512, C_XA = 1024, C_ZA = 1536, C_QKV = 2048, C_ZG = 3584;
constexpr float RMS_EPS = 1e-6f, L2_EPS = 1e-6f;
constexpr int NWAVES = 8, NTHREADS = 512;
constexpr int LDS_BYTES = 144 * 1024;

constexpr size_t O_Y = 0;
constexpr size_t O_CA_P = (size_t)MT * D;
constexpr size_t O_CQ_P = O_CA_P + 16 * 2 * 512;
constexpr size_t O_ST_P = O_CQ_P + 16 * 3 * 1536;
constexpr size_t O_CA_S = O_ST_P + (size_t)16 * 4 * 128 * 128;
constexpr size_t O_CQ_S = O_CA_S + 32 * 2 * 512;
constexpr size_t O_ST_S = O_CQ_S + 32 * 3 * 1536;
constexpr size_t O_END = O_ST_S + (size_t)32 * 4 * 128 * 128;

constexpr size_t WS_XB = 0;
constexpr size_t WS_PROJ = WS_XB + (size_t)MT * D * 2;
constexpr size_t WS_QKV = WS_PROJ + (size_t)MT * NP * 2;
constexpr size_t WS_O = WS_QKV + (size_t)MT * DQKV * 2;
constexpr size_t WS_WB1 = WS_O + (size_t)MT * 512 * 4;
constexpr size_t WS_WB2 = WS_WB1 + (size_t)NP * D * 2;
constexpr size_t WS_RSTD = WS_WB2 + (size_t)D * D * 2;
constexpr size_t WS_AB = WS_RSTD + (size_t)MT * 4;
constexpr size_t WS_GB = WS_AB + (size_t)MT * 8 * 4;
constexpr size_t WS_END = WS_GB + (size_t)MT * 8 * 4;

struct Args { const float* in[14]; float* out; unsigned char* ws; int ph_lo, ph_hi; };

__device__ __forceinline__ unsigned f2bf(float f) { unsigned u = __builtin_bit_cast(unsigned, f); return (u + 0x7fffu + ((u >> 16) & 1u)) >> 16; }
__device__ __forceinline__ unsigned pk2(float lo, float hi) { return f2bf(lo) | (f2bf(hi) << 16); }
__device__ __forceinline__ float bflo(unsigned w) { return __builtin_bit_cast(float, w << 16); }
__device__ __forceinline__ float bfhi(unsigned w) { return __builtin_bit_cast(float, w & 0xffff0000u); }
__device__ __forceinline__ void unpack8(const v4u w, float (&f)[8]) { f[0] = bflo(w.x); f[1] = bfhi(w.x); f[2] = bflo(w.y); f[3] = bfhi(w.y); f[4] = bflo(w.z); f[5] = bfhi(w.z); f[6] = bflo(w.w); f[7] = bfhi(w.w); }
__device__ __forceinline__ v4u pack8(const float (&f)[8]) { v4u w; w.x = pk2(f[0], f[1]); w.y = pk2(f[2], f[3]); w.z = pk2(f[4], f[5]); w.w = pk2(f[6], f[7]); return w; }
__device__ __forceinline__ float wave_sum(float v) {
#pragma unroll
    for (int o = 1; o < 64; o <<= 1) v += __shfl_xor(v, o);
    return v;
}
__device__ __forceinline__ float silu_f(float x) { return x / (1.0f + __expf(-x)); }
__device__ __forceinline__ float sigmoid_f(float x) { return 1.0f / (1.0f + expf(-x)); }
__device__ __forceinline__ float softplus_f(float x) { return x > 20.f ? x : log1pf(expf(x)); }

__device__ __forceinline__ void p0_transpose_item(const float* W, int K, int ldw, int N, const float* sc, bf16* WT, float* scr, int item, int lane) {
    const int nblk = N / 32, kb = item / nblk, nb = item % nblk, k0 = 64 * kb, n0 = 32 * nb;
#pragma unroll 8
    for (int i = 0; i < 32; ++i) { const int kk = 2 * i + (lane >> 5); const float s = sc ? sc[k0 + kk] : 1.0f; scr[kk * 33 + (lane & 31)] = W[(size_t)(k0 + kk) * ldw + n0 + (lane & 31)] * s; }
    asm volatile("s_waitcnt lgkmcnt(0)" ::: "memory");
    const int c = lane & 7;
#pragma unroll
    for (int j = 0; j < 4; ++j) { const int n = (lane >> 3) + 8 * j; const float* s = scr + (8 * c) * 33 + n;
        v4u o; o.x = pk2(s[0 * 33], s[1 * 33]); o.y = pk2(s[2 * 33], s[3 * 33]); o.z = pk2(s[4 * 33], s[5 * 33]); o.w = pk2(s[6 * 33], s[7 * 33]);
        *(v4u*)(WT + (size_t)(n0 + n) * K + k0 + 8 * c) = o; }
    asm volatile("s_waitcnt lgkmcnt(0)" ::: "memory");
}
__device__ __forceinline__ void phase0(const Args& a, unsigned char* lds, int G) {
    const int tid = threadIdx.x, lane = tid & 63, wave = tid >> 6;
    const int gw = blockIdx.x * NWAVES + wave, NGW = G * NWAVES;
    unsigned char* ws = a.ws;
    const float* ln_pre = a.in[5]; const float* w_in = a.in[6]; const float* w_out = a.in[12];
    float* scr = (float*)(lds + wave * 16384);
    constexpr int I1 = (D / 64) * (NP / 32), I2 = (D / 64) * (D / 32);
    for (int it = gw; it < I1 + I2; it += NGW) {
        if (it < I1) p0_transpose_item(w_in, D, NPROJ, NP, ln_pre, (bf16*)(ws + WS_WB1), scr, it, lane);
        else p0_transpose_item(w_out, D, D, D, nullptr, (bf16*)(ws + WS_WB2), scr, it - I1, lane);
    }
    float wx[4][4][8];
#pragma unroll
    for (int i = 0; i < 4; ++i)
#pragma unroll
        for (int c = 0; c < 4; ++c) { const int k = 256 * i + 4 * lane + c; const float s = ln_pre[k];
            const f32x4 w0 = *(const f32x4*)(w_in + (size_t)k * NPROJ + NP), w1 = *(const f32x4*)(w_in + (size_t)k * NPROJ + NP + 4);
#pragma unroll
            for (int j = 0; j < 4; ++j) { wx[i][c][j] = w0[j] * s; wx[i][c][4 + j] = w1[j] * s; } }
    float* rstd = (float*)(ws + WS_RSTD); float* ab = (float*)(ws + WS_AB); bf16* xb = (bf16*)(ws + WS_XB);
    for (int r = gw; r < MT; r += NGW) {
        const float* xrow = (r < MP) ? a.in[0] + (size_t)r * D : a.in[1] + (size_t)(r - MP) * D;
        f32x4 v[4]; float ss = 0.f; float dot[8];
#pragma unroll
        for (int j = 0; j < 8; ++j) dot[j] = 0.f;
#pragma unroll
        for (int i = 0; i < 4; ++i) { v[i] = *((const f32x4*)xrow + 64 * i + lane);
#pragma unroll
            for (int c = 0; c < 4; ++c) { ss += v[i][c] * v[i][c];
#pragma unroll
                for (int j = 0; j < 8; ++j) dot[j] += v[i][c] * wx[i][c][j]; } }
        ss = wave_sum(ss);
#pragma unroll
        for (int j = 0; j < 8; ++j) dot[j] = wave_sum(dot[j]);
        const float rs = 1.0f / sqrtf(ss * (1.0f / D) + RMS_EPS);
        unsigned long long* o8 = (unsigned long long*)(xb + (size_t)r * D) + lane;
#pragma unroll
        for (int i = 0; i < 4; ++i) o8[64 * i] = (unsigned long long)pk2(v[i][0], v[i][1]) | ((unsigned long long)pk2(v[i][2], v[i][3]) << 32);
        if (lane == 0) rstd[r] = rs;
        if (lane < 8) { float d = dot[0];
#pragma unroll
            for (int j = 1; j < 8; ++j) d = (lane == j) ? dot[j] : d;
            ab[(size_t)r * 8 + lane] = d * rs; }
    }
}

__device__ __forceinline__ void phase2(const Args& a, int G) {
    const int tid = threadIdx.x, lane = tid & 63, wave = tid >> 6;
    const int gw = blockIdx.x * NWAVES + wave, NGW = G * NWAVES;
    unsigned char* ws = a.ws;
    const bf16* proj = (const bf16*)(ws + WS_PROJ); bf16* mix = (bf16*)(ws + WS_XB); bf16* qkv = (bf16*)(ws + WS_QKV);
    const float* ab = (const float*)(ws + WS_AB); float* gbv = (float*)(ws + WS_GB);
    const float* cache_a = a.in[2]; const float* cache_q = a.in[3]; const float* cw_a = a.in[7]; const float* cw_q = a.in[8];
    const float* a_log = a.in[9]; const float* dt_bias = a.in[10];
    float* out = a.out;
    const int c8 = 8 * lane;
    constexpr int RB = 8;
    for (int blk = gw; blk < MT / RB; blk += NGW) {
        const int r0 = blk * RB;
        const bool smp = r0 >= MP;
        const int b = smp ? (r0 - MP) / DSEQ : r0 / SEQ;
        const int t0 = smp ? (r0 - MP) % DSEQ : r0 % SEQ;
        const int T = smp ? DSEQ : SEQ;
        {
            float w[3][8];
#pragma unroll
            for (int j = 0; j < 3; ++j) { const f32x4 x0 = *(const f32x4*)(cw_a + j * DC + c8), x1 = *(const f32x4*)(cw_a + j * DC + c8 + 4);
#pragma unroll
                for (int c = 0; c < 4; ++c) { w[j][c] = x0[c]; w[j][4 + c] = x1[c]; } }
            float um2[8], um1[8];
            if (t0 == 0) {
                if (smp) { const float* cp = cache_a + (size_t)b * 2 * DC + c8;
#pragma unroll
                    for (int c = 0; c < 8; ++c) { um2[c] = cp[c]; um1[c] = cp[DC + c]; } }
                else {
#pragma unroll
                    for (int c = 0; c < 8; ++c) { um2[c] = 0.f; um1[c] = 0.f; } }
            } else {
                float ca[8], xa[8];
                unpack8(*(const v4u*)(proj + (size_t)(r0 - 2) * NP + C_CA + c8), ca); unpack8(*(const v4u*)(proj + (size_t)(r0 - 2) * NP + C_XA + c8), xa);
#pragma unroll
                for (int c = 0; c < 8; ++c) um2[c] = ca[c] * xa[c];
                unpack8(*(const v4u*)(proj + (size_t)(r0 - 1) * NP + C_CA + c8), ca); unpack8(*(const v4u*)(proj + (size_t)(r0 - 1) * NP + C_XA + c8), xa);
#pragma unroll
                for (int c = 0; c < 8; ++c) um1[c] = ca[c] * xa[c];
            }
#pragma unroll 2
            for (int i = 0; i < RB; ++i) {
                const int r = r0 + i, t = t0 + i;
                const bf16* pr = proj + (size_t)r * NP + c8;
                float ba[8], ca[8], xa[8], za[8], y[8], u[8];
                unpack8(*(const v4u*)(pr + C_BA), ba); unpack8(*(const v4u*)(pr + C_CA), ca); unpack8(*(const v4u*)(pr + C_XA), xa); unpack8(*(const v4u*)(pr + C_ZA), za);
#pragma unroll
                for (int c = 0; c < 8; ++c) { u[c] = ca[c] * xa[c]; const float cv = w[0][c] * um2[c] + w[1][c] * um1[c] + w[2][c] * u[c]; y[c] = ba[c] * cv * silu_f(za[c]); um2[c] = um1[c]; um1[c] = u[c]; }
                *(v4u*)(mix + (size_t)r * D + c8) = pack8(y);
                if (t >= T - 2) { float* op = out + (smp ? O_CA_S : O_CA_P) + ((size_t)b * 2 + (t - (T - 2))) * DC + c8;
                    *(f32x4*)op = (f32x4){u[0], u[1], u[2], u[3]}; *(f32x4*)(op + 4) = (f32x4){u[4], u[5], u[6], u[7]}; }
            }
        }
#pragma unroll 1
        for (int seg = 0; seg < 3; ++seg) {
            const int cc = seg * 512 + c8;
            float w[4][8];
#pragma unroll
            for (int j = 0; j < 4; ++j) { const f32x4 x0 = *(const f32x4*)(cw_q + j * DQKV + cc), x1 = *(const f32x4*)(cw_q + j * DQKV + cc + 4);
#pragma unroll
                for (int c = 0; c < 4; ++c) { w[j][c] = x0[c]; w[j][4 + c] = x1[c]; } }
            float xm3[8], xm2[8], xm1[8];
            if (t0 == 0) {
                if (smp) { const float* cp = cache_q + (size_t)b * 3 * DQKV + cc;
#pragma unroll
                    for (int c = 0; c < 8; ++c) { xm3[c] = cp[c]; xm2[c] = cp[DQKV + c]; xm1[c] = cp[2 * DQKV + c]; } }
                else {
#pragma unroll
                    for (int c = 0; c < 8; ++c) { xm3[c] = 0.f; xm2[c] = 0.f; xm1[c] = 0.f; } }
            } else {
                unpack8(*(const v4u*)(proj + (size_t)(r0 - 3) * NP + C_QKV + cc), xm3);
                unpack8(*(const v4u*)(proj + (size_t)(r0 - 2) * NP + C_QKV + cc), xm2);
                unpack8(*(const v4u*)(proj + (size_t)(r0 - 1) * NP + C_QKV + cc), xm1);
            }
#pragma unroll 2
            for (int i = 0; i < RB; ++i) {
                const int r = r0 + i, t = t0 + i;
                float x[8], s[8]; unpack8(*(const v4u*)(proj + (size_t)r * NP + C_QKV + cc), x);
                float ss = 0.f;
#pragma unroll
                for (int c = 0; c < 8; ++c) { const float cv = w[0][c] * xm3[c] + w[1][c] * xm2[c] + w[2][c] * xm1[c] + w[3][c] * x[c]; s[c] = silu_f(cv); ss += s[c] * s[c]; xm3[c] = xm2[c]; xm2[c] = xm1[c]; xm1[c] = x[c]; }
                if (seg < 2) {
                    ss += __shfl_xor(ss, 1); ss += __shfl_xor(ss, 2); ss += __shfl_xor(ss, 4); ss += __shfl_xor(ss, 8);
                    float inv = 1.0f / sqrtf(ss + L2_EPS); if (seg == 0) inv *= 0.08838834764831845f;
#pragma unroll
                    for (int c = 0; c < 8; ++c) s[c] *= inv;
                }
                *(v4u*)(qkv + (size_t)r * DQKV + cc) = pack8(s);
                if (t >= T - 3) { float* op = out + (smp ? O_CQ_S : O_CQ_P) + ((size_t)b * 3 + (t - (T - 3))) * DQKV + cc;
                    *(f32x4*)op = (f32x4){x[0], x[1], x[2], x[3]}; *(f32x4*)(op + 4) = (f32x4){x[4], x[5], x[6], x[7]}; }
            }
        }
        if (lane < RB * NH) { const int i = lane >> 2, h = lane & 3, r = r0 + i;
            const float ad = ab[(size_t)r * 8 + h], bb = ab[(size_t)r * 8 + 4 + h];
            gbv[(size_t)r * 8 + h] = -expf(a_log[h]) * softplus_f(ad + dt_bias[h]);
            gbv[(size_t)r * 8 + 4 + h] = sigmoid_f(bb); }
    }
}

__device__ __forceinline__ void phase3(const Args& a, unsigned char* lds, int G) {
    const int tid = threadIdx.x;
    unsigned char* ws = a.ws;
    const bf16* qkv = (const bf16*)(ws + WS_QKV); const float* gbv = (const float*)(ws + WS_GB); float* obuf = (float*)(ws + WS_O);
    float* tile = (float*)lds;
    constexpr int TT = 32, TS = 388;
    const int e = tid >> 2, dq = tid & 3;
    for (int sq = blockIdx.x; sq < NB * NH + NBS * NH; sq += G) {
        const bool smp = sq >= NB * NH;
        const int sl = smp ? sq - NB * NH : sq, b = sl >> 2, h = sl & 3;
        const int rbase = smp ? MP + b * DSEQ : b * SEQ, T = smp ? DSEQ : SEQ;
        float s[32];
        if (smp) { const float* sp = a.in[4] + ((size_t)sl * HD + 32 * dq) * HD + e;
#pragma unroll
            for (int i = 0; i < 32; ++i) s[i] = sp[(size_t)i * HD]; }
        else {
#pragma unroll
            for (int i = 0; i < 32; ++i) s[i] = 0.f; }
        for (int tt = 0; tt < T; tt += TT) {
            __syncthreads();
#pragma unroll
            for (int j = 0; j < 3; ++j) { const int id = tid + 512 * j, tok = id / 48, ci = id % 48, seg = ci >> 4, cc = (ci & 15) * 8;
                float f[8]; unpack8(*(const v4u*)(qkv + (size_t)(rbase + tt + tok) * DQKV + seg * 512 + h * HD + cc), f);
                float* tp = tile + tok * TS + seg * 128 + cc;
                *(f32x4*)tp = (f32x4){f[0], f[1], f[2], f[3]}; *(f32x4*)(tp + 4) = (f32x4){f[4], f[5], f[6], f[7]}; }
            if (tid < TT) { const int r = rbase + tt + tid; tile[tid * TS + 384] = expf(gbv[(size_t)r * 8 + h]); tile[tid * TS + 385] = gbv[(size_t)r * 8 + 4 + h]; }
            __syncthreads();
#pragma unroll 1
            for (int tok = 0; tok < TT; ++tok) {
                const float* tk = tile + tok * TS;
                const float eg = tk[384], beta = tk[385], vv = tk[256 + e];
                float kk[32], qq[32];
#pragma unroll
                for (int i = 0; i < 8; ++i) { const f32x4 k4 = *(const f32x4*)(tk + 128 + 32 * dq + 4 * i), q4 = *(const f32x4*)(tk + 32 * dq + 4 * i);
#pragma unroll
                    for (int c = 0; c < 4; ++c) { kk[4 * i + c] = k4[c]; qq[4 * i + c] = q4[c]; } }
                float ks = 0.f;
#pragma unroll
                for (int i = 0; i < 32; ++i) ks += kk[i] * s[i];
                ks += __shfl_xor(ks, 1); ks += __shfl_xor(ks, 2);
                const float delta = beta * (vv - eg * ks);
                float o = 0.f;
#pragma unroll
                for (int i = 0; i < 32; ++i) { s[i] = eg * s[i] + kk[i] * delta; o += qq[i] * s[i]; }
                o += __shfl_xor(o, 1); o += __shfl_xor(o, 2);
                if (dq == 0) obuf[(size_t)(rbase + tt + tok) * 512 + h * HD + e] = o;
            }
        }
        float* so = a.out + (smp ? O_ST_S : O_ST_P) + ((size_t)sl * HD + 32 * dq) * HD + e;
#pragma unroll
        for (int i = 0; i < 32; ++i) so[(size_t)i * HD] = s[i];
    }
}

__device__ __forceinline__ void phase4(const Args& a, int G) {
    const int tid = threadIdx.x, lane = tid & 63, wave = tid >> 6;
    const int gw = blockIdx.x * NWAVES + wave, NGW = G * NWAVES;
    unsigned char* ws = a.ws;
    const bf16* proj = (const bf16*)(ws + WS_PROJ); bf16* mix = (bf16*)(ws + WS_XB); const float* obuf = (const float*)(ws + WS_O);
    const float* gw_n = a.in[11];
    const int c8 = 8 * lane;
    float wn[8];
#pragma unroll
    for (int c = 0; c < 8; ++c) wn[c] = gw_n[(c8 & 127) + c];
    for (int r = gw; r < MT; r += NGW) {
        const f32x4 o0 = *(const f32x4*)(obuf + (size_t)r * 512 + c8), o1 = *(const f32x4*)(obuf + (size_t)r * 512 + c8 + 4);
        float z[8]; unpack8(*(const v4u*)(proj + (size_t)r * NP + C_ZG + c8), z);
        float o[8] = {o0[0], o0[1], o0[2], o0[3], o1[0], o1[1], o1[2], o1[3]};
        float ss = 0.f;
#pragma unroll
        for (int c = 0; c < 8; ++c) ss += o[c] * o[c];
        ss += __shfl_xor(ss, 1); ss += __shfl_xor(ss, 2); ss += __shfl_xor(ss, 4); ss += __shfl_xor(ss, 8);
        const float rs = 1.0f / sqrtf(ss * (1.0f / HD) + RMS_EPS);
        float y[8];
#pragma unroll
        for (int c = 0; c < 8; ++c) y[c] = o[c] * rs * wn[c] * silu_f(z[c]);
        *(v4u*)(mix + (size_t)r * D + 512 + c8) = pack8(y);
    }
}

__device__ __forceinline__ void phase6(const Args& a, int G) {
    const int tid = threadIdx.x, lane = tid & 63, wave = tid >> 6;
    const int gw = blockIdx.x * NWAVES + wave, NGW = G * NWAVES;
    const float* outb = (const float*)(a.ws + WS_PROJ); const float* ln_post = a.in[13];
    f32x4 lw[4];
#pragma unroll
    for (int i = 0; i < 4; ++i) lw[i] = *((const f32x4*)ln_post + 64 * i + lane);
    for (int r = gw; r < MT; r += NGW) {
        const float* xrow = (r < MP) ? a.in[0] + (size_t)r * D : a.in[1] + (size_t)(r - MP) * D;
        f32x4 v[4], xv[4]; float ss = 0.f;
#pragma unroll
        for (int i = 0; i < 4; ++i) { v[i] = *((const f32x4*)(outb + (size_t)r * D) + 64 * i + lane); xv[i] = *((const f32x4*)xrow + 64 * i + lane);
            ss += (v[i][0] * v[i][0] + v[i][1] * v[i][1]) + (v[i][2] * v[i][2] + v[i][3] * v[i][3]); }
        ss = wave_sum(ss);
        const float rs = 1.0f / sqrtf(ss * (1.0f / D) + RMS_EPS);
#pragma unroll
        for (int i = 0; i < 4; ++i) *((f32x4*)(a.out + O_Y + (size_t)r * D) + 64 * i + lane) = xv[i] + v[i] * rs * lw[i];
    }
}

constexpr int NPHASES = 7;
__global__ void __launch_bounds__(NTHREADS, 2) fwd(Args args) {
    extern __shared__ __attribute__((aligned(16))) unsigned char lds[];
    const int G = gridDim.x;
    const int lo = args.ph_lo, hi = args.ph_hi;
#if ONE_LAUNCH
    cg::grid_group grid = cg::this_grid();
#define SEAM() grid.sync()
#else
#define SEAM() do {} while (0)
#endif
#define IN(k) (lo <= (k) && (k) < hi)
    if (IN(0)) { phase0(args, lds, G); if (IN(1)) SEAM(); }
    if (IN(1)) {
        pg8::Gemm g{(const pg8::bf16_t*)(args.ws + WS_XB), (const pg8::bf16_t*)(args.ws + WS_WB1), MT, NP, D};
        pg8::StaticOrder S; S.init(MT, NP, G, (int)blockIdx.x);
        pg8::EpiProj E{(pg8::bf16_t*)(args.ws + WS_PROJ), NP, (const float*)(args.ws + WS_RSTD)};
        pg8::gemm_phase<pg8::EpiProj, pg8::StaticOrder, true, true>((LAS unsigned char*)lds, g, S, E);
        if (IN(2)) SEAM();
    }
    if (IN(2)) { phase2(args, G); if (IN(3)) SEAM(); }
    if (IN(3)) { phase3(args, lds, G); if (IN(4)) SEAM(); }
    if (IN(4)) { phase4(args, G); if (IN(5)) SEAM(); }
    if (IN(5)) {
        pg8::Gemm g{(const pg8::bf16_t*)(args.ws + WS_XB), (const pg8::bf16_t*)(args.ws + WS_WB2), MT, D, D};
        pg8::StaticOrder S; S.init(MT, D, G, (int)blockIdx.x);
        pg8::EpiF32 E{(float*)(args.ws + WS_PROJ), D};
        pg8::gemm_phase<pg8::EpiF32, pg8::StaticOrder, true, true>((LAS unsigned char*)lds, g, S, E);
        if (IN(6)) SEAM();
    }
    if (IN(6)) { phase6(args, G); }
#undef IN
}

extern "C" void kernel_launch(void* const* d_in, const int* in_sizes, int n_in, void* d_out, int out_size, void* d_ws, size_t ws_size, hipStream_t stream) {
    static int grid = 0;
    if (grid == 0) {
        if (n_in != 14 || in_sizes[0] != MP * D || (size_t)out_size != O_END || ws_size < WS_END) {
            fprintf(stderr, "kernel_launch: unexpected shapes: n_in %d in0 %d out %d (want %zu) ws %zu (want >= %zu)\n", n_in, n_in > 0 ? in_sizes[0] : -1, out_size, (size_t)O_END, ws_size, (size_t)WS_END); grid = -1; return; }
        int dev = 0, cus = 0, per_cu = 0;
        (void)hipGetDevice(&dev); (void)hipDeviceGetAttribute(&cus, hipDeviceAttributeMultiprocessorCount, dev);
        if (hipFuncSetAttribute((const void*)fwd, hipFuncAttributeMaxDynamicSharedMemorySize, LDS_BYTES) != hipSuccess) { fprintf(stderr, "kernel_launch: hipFuncSetAttribute failed\n"); grid = -1; return; }
        (void)hipOccupancyMaxActiveBlocksPerMultiprocessor(&per_cu, (const void*)fwd, NTHREADS, LDS_BYTES);
        if (per_cu < 1) { fprintf(stderr, "kernel_launch: occupancy query says %d blocks per CU\n", per_cu); per_cu = 1; }
        (void)hipGetLastError();
        grid = cus * 1;
        fprintf(stderr, "kernel_launch: cus %d per_cu %d grid %d\n", cus, per_cu, grid);
    }
    if (grid < 0) return;
    Args a{};
    for (int i = 0; i < 14; ++i) a.in[i] = (const float*)d_in[i];
    a.out = (float*)d_out; a.ws = (unsigned char*)d_ws;
#if ONE_LAUNCH
    a.ph_lo = 0; a.ph_hi = NPHASES;
    void* kargs[] = {&a};
    hipError_t e = hipLaunchCooperativeKernel((const void*)fwd, dim3(grid), dim3(NTHREADS), kargs, LDS_BYTES, stream);
    if (e != hipSuccess) fprintf(stderr, "kernel_launch: cooperative launch failed: %s (grid %d)\n", hipGetErrorString(e), grid);
#else
    for (int p = 0; p < NPHASES; ++p) { a.ph_lo = p; a.ph_hi = p + 1;
        hipLaunchKernelGGL(fwd, dim3(grid), dim3(NTHREADS), LDS_BYTES, stream, a);
        const hipError_t le = hipPeekAtLastError();
        if (le != hipSuccess) { fprintf(stderr, "kernel_launch: launch %d failed: %s\n", p, hipGetErrorName(le)); break; } }
#endif
}
```

```cpp
#include <hip/hip_runtime.h>
#include <hip/hip_cooperative_groups.h>
#include <cstdio>
#include <cstdint>
namespace cg = cooperative_groups;
#ifndef ONE_LAUNCH
#define ONE_LAUNCH 1
#endif
namespace pg8 {
#define PG8_LAS __attribute__((address_space(3)))
typedef unsigned short bf16_t;
typedef short bf16x8 __attribute__((ext_vector_type(8)));
typedef float f32x4 __attribute__((ext_vector_type(4)));
typedef unsigned u32x4 __attribute__((ext_vector_type(4)));
constexpr int BM = 256, BK = 64, HALF = 128, HTB = HALF * BK * 2  , STAGE_BYTES = 8 * HTB, NXCD = 8, WGM = 8;

__host__ __device__ __forceinline__ int lds_byte(int r, int c) { const int st = (r >> 4) * 2 + (c >> 5), rr = r & 15, cc = c & 31, ob = rr * 64 + cc * 2; return st * 1024 + (ob ^ (((ob >> 9) & 1) << 5)); }
__host__ __device__ __forceinline__ void stage_rc(int b, int& R, int& C) { const int st = b / 1024, sb = b % 1024, swz = sb ^ (((sb >> 9) & 1) << 5); R = (st >> 1) * 16 + swz / 64; C = (st & 1) * 32 + (swz % 64) / 2; }
__host__ __device__ __forceinline__ int perm32(int rho) { const int n = rho >> 4, i = rho & 15; return 8 * (i >> 2) + 4 * n + (i & 3); }

struct Unit { int pm, pn; };
struct Gemm { const bf16_t* A; const bf16_t* Bt; int M, N, K; };

struct StaticOrder {
    int nM, nN, nwg, G, c;
    __host__ __device__ void init(int M, int N, int G_, int c_) { nM = M / BM; nN = N / BM; nwg = nM * nN; G = G_; c = c_; }
    __host__ __device__ bool next(int i, Unit& u) const {
        const long L = (long)i * G + c; if (L >= nwg) return false;
        int wgid = (int)L; { const int q = nwg / NXCD, r = nwg % NXCD, xcd = wgid % NXCD, off = wgid / NXCD; wgid = (xcd < r ? xcd * (q + 1) : r * (q + 1) + (xcd - r) * q) + off; }
        const int nig = WGM * nN, gid = wgid / nig, fm = gid * WGM, gsz = (nM - fm) < WGM ? (nM - fm) : WGM;
        u.pm = fm + ((wgid % nig) % gsz); u.pn = (wgid % nig) / gsz; return true;
    }
    __device__ __forceinline__ void a_ready(const Unit&) const {}
    __device__ __forceinline__ void done(const Unit&) const {}
};
__device__ __forceinline__ unsigned cvt_pk_bf16(float lo, float hi) { unsigned r; asm volatile("v_cvt_pk_bf16_f32 %0, %1, %2" : "=v"(r) : "v"(lo), "v"(hi)); return r; }

struct EpiProj {
    static constexpr bool PERM = true, AFTER_DRAIN = false;
    bf16_t* O; int ldc; const float* rstd;
    __device__ __forceinline__ void operator()(const f32x4 (&acc)[2][2][4][2], const Unit& u, int wr, int wc, int fr, int fq) const {
        const int row0 = u.pm * BM + wr * 64 + fr; const int col0 = u.pn * BM + wc * 32 + 8 * fq;
#pragma unroll
        for (int ai = 0; ai < 2; ++ai)
#pragma unroll
            for (int m = 0; m < 4; ++m) { const int r = row0 + ai * HALF + m * 16; const float sc = rstd[r]; bf16_t* rowp = O + (size_t)r * ldc + col0;
#pragma unroll
                for (int bj = 0; bj < 2; ++bj) { const f32x4 v0 = acc[ai][bj][m][0] * sc, v1 = acc[ai][bj][m][1] * sc;
                    u32x4 w; w.x = cvt_pk_bf16(v0[0], v0[1]); w.y = cvt_pk_bf16(v0[2], v0[3]); w.z = cvt_pk_bf16(v1[0], v1[1]); w.w = cvt_pk_bf16(v1[2], v1[3]);
                    *(u32x4*)(rowp + bj * HALF) = w; } }
    }
};
struct EpiF32 {
    static constexpr bool PERM = false, AFTER_DRAIN = false;
    float* C; int ldc;
    __device__ __forceinline__ void operator()(const f32x4 (&acc)[2][2][4][2], const Unit& u, int wr, int wc, int fr, int fq) const {
        const int row0 = u.pm * BM + wr * 64 + fr, col0 = u.pn * BM + wc * 32 + 4 * fq;
#pragma unroll
        for (int ai = 0; ai < 2; ++ai)
#pragma unroll
            for (int m = 0; m < 4; ++m) { float* rowp = C + (size_t)(row0 + ai * HALF + m * 16) * ldc + col0;
#pragma unroll
                for (int bj = 0; bj < 2; ++bj)
#pragma unroll
                    for (int n = 0; n < 2; ++n) *(f32x4*)(rowp + bj * HALF + n * 16) = acc[ai][bj][m][n]; }
    }
};
template <class Epi, class Sched, bool ALIGN_EPI = false, bool SP2 = false>
__device__ __forceinline__ void gemm_phase(PG8_LAS unsigned char* lds, const Gemm g, const Sched& S, const Epi& E) {
    const int tid = threadIdx.x, wid = __builtin_amdgcn_readfirstlane(tid >> 6), lane = tid & 63, wr = wid >> 2, wc = wid & 3, fr = lane & 15, fq = lane >> 4;
    const int K = g.K, nt = K / BK;
    unsigned voffA[2], voffB[2];
#pragma unroll
    for (int i = 0; i < 2; ++i) { int R, C; stage_rc(tid * 16 + i * 8192, R, C); const int Rb = Epi::PERM ? ((R & ~31) + perm32(R & 31)) : R;
        voffA[i] = (unsigned)(R * K + C) * 2u; voffB[i] = (unsigned)(Rb * K + C) * 2u; }
    const size_t kstep = (size_t)(BK * 2);
    const size_t hstep = (size_t)HALF * K * 2;
    const size_t tstep = 2 * hstep;
    const unsigned ldsw = (unsigned)wid * 1024u;
    const int aoff = lds_byte(wr * 64 + fr, fq * 8), boff = lds_byte(wc * 32 + fr, fq * 8);
#define PG8_SA(b, h) (((b) * 2 + (h)) * HTB)
#define PG8_SB(b, h) ((4 + (b) * 2 + (h)) * HTB)
#define PG8_STAGE(bufoff, gbase, voff) do { _Pragma("unroll") for (int _i = 0; _i < 2; ++_i) \
        __builtin_amdgcn_global_load_lds((const unsigned*)((const char*)(gbase) + (voff)[_i]), (PG8_LAS unsigned*)(lds + (bufoff) + ldsw + _i * 8192), 16, 0, 0); } while (0)
#define PG8_LDA(dst, b, h) do { _Pragma("unroll") for (int m = 0; m < 4; ++m) _Pragma("unroll") for (int k = 0; k < 2; ++k) dst[m][k] = *(const PG8_LAS bf16x8*)(lds + PG8_SA(b, h) + aoff + m * 2048 + k * 1024); } while (0)
#define PG8_LDB(dst, b, h) do { _Pragma("unroll") for (int n = 0; n < 2; ++n) _Pragma("unroll") for (int k = 0; k < 2; ++k) dst[n][k] = *(const PG8_LAS bf16x8*)(lds + PG8_SB(b, h) + boff + n * 2048 + k * 1024); } while (0)
#define PG8_MMA(ai, bj, At, Bt) do { __builtin_amdgcn_s_setprio(1); _Pragma("unroll") for (int m = 0; m < 4; ++m) _Pragma("unroll") for (int n = 0; n < 2; ++n) _Pragma("unroll") for (int k = 0; k < 2; ++k) \
        acc[ai][bj][m][n] = __builtin_amdgcn_mfma_f32_16x16x32_bf16(Bt[n][k], At[m][k], acc[ai][bj][m][n], 0, 0, 0); __builtin_amdgcn_s_setprio(0); } while (0)
#define PG8_WAIT_V(n) asm volatile("s_waitcnt vmcnt(" #n ")" ::: "memory")
#define PG8_WAIT_L(n) asm volatile("s_waitcnt lgkmcnt(" #n ")" ::: "memory")
#define PG8_BAR __builtin_amdgcn_s_barrier()
#define PG8_SCHED __builtin_amdgcn_sched_barrier(0)
    Unit cur, nxt; int ui = 0;
    if (!S.next(0, cur)) return;
    f32x4 acc[2][2][4][2];
#pragma unroll
    for (int a = 0; a < 2; ++a)
#pragma unroll
        for (int b = 0; b < 2; ++b)
#pragma unroll
            for (int m = 0; m < 4; ++m)
#pragma unroll
                for (int n = 0; n < 2; ++n) acc[a][b][m][n] = (f32x4){0.f, 0.f, 0.f, 0.f};
    bf16x8 At[4][2], B0[2][2], B1[2][2];
    const char* cA = (const char*)g.A + (size_t)cur.pm * tstep; const char* cB = (const char*)g.Bt + (size_t)cur.pn * tstep;
    S.a_ready(cur);
    if constexpr (SP2) {
        PG8_STAGE(PG8_SB(0, 0), cB, voffB); PG8_STAGE(PG8_SB(0, 1), cB + hstep, voffB); PG8_STAGE(PG8_SA(0, 0), cA, voffA); PG8_STAGE(PG8_SA(0, 1), cA + hstep, voffA);
        if (wr == 1) PG8_BAR;
        PG8_WAIT_V(2); PG8_BAR;
        PG8_STAGE(PG8_SB(1, 0), cB + kstep, voffB); PG8_STAGE(PG8_SA(1, 0), cA + kstep, voffA); PG8_STAGE(PG8_SB(1, 1), cB + hstep + kstep, voffB);
        PG8_WAIT_V(6); PG8_BAR;
    } else {
        PG8_STAGE(PG8_SB(0, 0), cB, voffB); PG8_STAGE(PG8_SA(0, 0), cA, voffA); PG8_STAGE(PG8_SB(0, 1), cB + hstep, voffB); PG8_STAGE(PG8_SA(0, 1), cA + hstep, voffA);
        if (wr == 1) PG8_BAR;
        PG8_WAIT_V(4); PG8_BAR;
        PG8_STAGE(PG8_SB(1, 0), cB + kstep, voffB); PG8_STAGE(PG8_SA(1, 0), cA + kstep, voffA); PG8_STAGE(PG8_SB(1, 1), cB + hstep + kstep, voffB);
        PG8_WAIT_V(6); PG8_BAR;
    }
    for (;;) {
        const bool has_next = S.next(ui + 1, nxt);
        const char* nA = has_next ? (const char*)g.A + (size_t)nxt.pm * tstep : cA; const char* nB = has_next ? (const char*)g.Bt + (size_t)nxt.pn * tstep : cB;
        for (int t = 0; t < nt; t += 2) {
            const bool last = (t == nt - 2);
            const char* a1 = cA + (size_t)(t + 1) * kstep;
            const char* a2 = last ? nA : cA + (size_t)(t + 2) * kstep; const char* b2 = last ? nB : cB + (size_t)(t + 2) * kstep;
            const char* a3 = a2 + kstep; const char* b3 = b2 + kstep;
            if (last && has_next) S.a_ready(nxt);
            if constexpr (SP2) {
            PG8_LDB(B0, 0, 0); PG8_LDB(B1, 0, 1); PG8_SCHED; PG8_LDA(At, 0, 0); PG8_STAGE(PG8_SA(1, 1), a1 + hstep, voffA);
            PG8_WAIT_V(8); PG8_WAIT_L(0); PG8_BAR; PG8_MMA(0, 0, At, B0); PG8_MMA(0, 1, At, B1); PG8_BAR; PG8_SCHED;
            PG8_LDA(At, 0, 1); PG8_STAGE(PG8_SB(0, 0), b2, voffB); PG8_STAGE(PG8_SB(0, 1), b2 + hstep, voffB); PG8_STAGE(PG8_SA(0, 0), a2, voffA);
            PG8_WAIT_V(8); PG8_WAIT_L(0); PG8_BAR; PG8_MMA(1, 0, At, B0); PG8_MMA(1, 1, At, B1); PG8_BAR; PG8_SCHED;
            PG8_LDB(B0, 1, 0); PG8_LDB(B1, 1, 1); PG8_SCHED; PG8_LDA(At, 1, 0); PG8_STAGE(PG8_SA(0, 1), a2 + hstep, voffA);
            PG8_WAIT_V(8); PG8_WAIT_L(0); PG8_BAR; PG8_MMA(0, 0, At, B0); PG8_MMA(0, 1, At, B1); PG8_BAR; PG8_SCHED;
            PG8_LDA(At, 1, 1); PG8_STAGE(PG8_SB(1, 0), b3, voffB); PG8_STAGE(PG8_SB(1, 1), b3 + hstep, voffB); PG8_STAGE(PG8_SA(1, 0), a3, voffA);
            PG8_WAIT_V(8); PG8_WAIT_L(0); PG8_BAR; PG8_MMA(1, 0, At, B0); PG8_MMA(1, 1, At, B1); PG8_BAR; PG8_SCHED;
            } else {
            PG8_LDB(B0, 0, 0); PG8_SCHED; PG8_LDA(At, 0, 0); PG8_STAGE(PG8_SA(1, 1), a1 + hstep, voffA);
            PG8_WAIT_L(8); PG8_BAR; PG8_WAIT_L(0); PG8_MMA(0, 0, At, B0); PG8_BAR; PG8_SCHED;
            PG8_LDB(B1, 0, 1); PG8_STAGE(PG8_SB(0, 0), b2, voffB);
            PG8_BAR; PG8_WAIT_L(0); PG8_MMA(0, 1, At, B1); PG8_BAR;
            PG8_LDA(At, 0, 1); PG8_STAGE(PG8_SA(0, 0), a2, voffA);
            PG8_BAR; PG8_WAIT_L(0); PG8_MMA(1, 0, At, B0); PG8_BAR; PG8_SCHED;
            PG8_STAGE(PG8_SB(0, 1), b2 + hstep, voffB);
            PG8_WAIT_V(6); PG8_BAR; PG8_MMA(1, 1, At, B1); PG8_BAR;
            PG8_LDB(B0, 1, 0); PG8_SCHED; PG8_LDA(At, 1, 0); PG8_STAGE(PG8_SA(0, 1), a2 + hstep, voffA);
            PG8_WAIT_L(8); PG8_BAR; PG8_WAIT_L(0); PG8_MMA(0, 0, At, B0); PG8_BAR; PG8_SCHED;
            PG8_LDB(B1, 1, 1); PG8_STAGE(PG8_SB(1, 0), b3, voffB);
            PG8_BAR; PG8_WAIT_L(0); PG8_MMA(0, 1, At, B1); PG8_BAR;
            PG8_LDA(At, 1, 1); PG8_STAGE(PG8_SA(1, 0), a3, voffA);
            PG8_BAR; PG8_WAIT_L(0); PG8_MMA(1, 0, At, B0); PG8_BAR; PG8_SCHED;
            PG8_STAGE(PG8_SB(1, 1), b3 + hstep, voffB);
            PG8_WAIT_V(6); PG8_BAR; PG8_MMA(1, 1, At, B1); PG8_BAR;
            }
        }
        if constexpr (ALIGN_EPI) { if (wr == 0) PG8_BAR; }
        if constexpr (!Epi::AFTER_DRAIN) { E(acc, cur, wr, wc, fr, fq); S.done(cur); }
        if (!has_next) break;
#pragma unroll
        for (int a = 0; a < 2; ++a)
#pragma unroll
            for (int b = 0; b < 2; ++b)
#pragma unroll
                for (int m = 0; m < 4; ++m)
#pragma unroll
                    for (int n = 0; n < 2; ++n) acc[a][b][m][n] = (f32x4){0.f, 0.f, 0.f, 0.f};
        cur = nxt; cA = nA; cB = nB; ++ui;
        if constexpr (ALIGN_EPI) { if (wr == 1) PG8_BAR; }
    }
    PG8_WAIT_V(0);
    if constexpr (!ALIGN_EPI) { if (wr == 0) PG8_BAR; }
    PG8_BAR;
    if constexpr (Epi::AFTER_DRAIN) { E.fused(acc, cur, wr, wc, fr, fq, lds, wid, lane); S.done(cur); }
#undef PG8_SA
#undef PG8_SB
#undef PG8_STAGE
#undef PG8_LDA
#undef PG8_LDB
#undef PG8_MMA
#undef PG8_WAIT_V
#undef PG8_WAIT_L
#undef PG8_BAR
#undef PG8_SCHED
}
}

#define LAS __attribute__((address_space(3)))
typedef unsigned short bf16;
typedef unsigned v4u __attribute__((ext_vector_type(4)));
typedef unsigned v2u __attribute__((ext_vector_type(2)));
typedef float f32x4 __attribute__((ext_vector_type(4)));

constexpr int D = 1024, MP = 16 * 4096, MS = 32 * 32, MT = MP + MS, SEQ = 4096, DSEQ = 32, NB = 16, NBS = 32;
constexpr int NPROJ = 4104, NP = 4096, DC = 512, DQKV = 1536, NH = 4, HD = 128;
constexpr int C_BA = 0, C_CA = 512, C_XA = 1024, C_ZA = 1536, C_QKV = 2048, C_ZG = 3584;
constexpr float RMS_EPS = 1e-6f, L2_EPS = 1e-6f;
constexpr int NWAVES = 8, NTHREADS = 512;
constexpr int LDS_BYTES = 144 * 1024;

constexpr size_t O_Y = 0;
constexpr size_t O_CA_P = (size_t)MT * D;
constexpr size_t O_CQ_P = O_CA_P + 16 * 2 * 512;
constexpr size_t O_ST_P = O_CQ_P + 16 * 3 * 1536;
constexpr size_t O_CA_S = O_ST_P + (size_t)16 * 4 * 128 * 128;
constexpr size_t O_CQ_S = O_CA_S + 32 * 2 * 512;
constexpr size_t O_ST_S = O_CQ_S + 32 * 3 * 1536;
constexpr size_t O_END = O_ST_S + (size_t)32 * 4 * 128 * 128;

constexpr size_t WS_XB = 0;
constexpr size_t WS_PROJ = WS_XB + (size_t)MT * D * 2;
constexpr size_t WS_QKV = WS_PROJ + (size_t)MT * NP * 2;
constexpr size_t WS_O = WS_QKV + (size_t)MT * DQKV * 2;
constexpr size_t WS_WB1 = WS_O + (size_t)MT * 512 * 4;
constexpr size_t WS_WB2 = WS_WB1 + (size_t)NP * D * 2;
constexpr size_t WS_RSTD = WS_WB2 + (size_t)D * D * 2;
constexpr size_t WS_AB = WS_RSTD + (size_t)MT * 4;
constexpr size_t WS_GB = WS_AB + (size_t)MT * 8 * 4;
constexpr size_t WS_END = WS_GB + (size_t)MT * 8 * 4;

struct Args { const float* in[14]; float* out; unsigned char* ws; int ph_lo, ph_hi; };

__device__ __forceinline__ unsigned f2bf(float f) { unsigned u = __builtin_bit_cast(unsigned, f); return (u + 0x7fffu + ((u >> 16) & 1u)) >> 16; }
__device__ __forceinline__ unsigned pk2(float lo, float hi) { return f2bf(lo) | (f2bf(hi) << 16); }
__device__ __forceinline__ float bflo(unsigned w) { return __builtin_bit_cast(float, w << 16); }
__device__ __forceinline__ float bfhi(unsigned w) { return __builtin_bit_cast(float, w & 0xffff0000u); }
__device__ __forceinline__ void unpack8(const v4u w, float (&f)[8]) { f[0] = bflo(w.x); f[1] = bfhi(w.x); f[2] = bflo(w.y); f[3] = bfhi(w.y); f[4] = bflo(w.z); f[5] = bfhi(w.z); f[6] = bflo(w.w); f[7] = bfhi(w.w); }
__device__ __forceinline__ v4u pack8(const float (&f)[8]) { v4u w; w.x = pk2(f[0], f[1]); w.y = pk2(f[2], f[3]); w.z = pk2(f[4], f[5]); w.w = pk2(f[6], f[7]); return w; }
__device__ __forceinline__ float wave_sum(float v) {
#pragma unroll
    for (int o = 1; o < 64; o <<= 1) v += __shfl_xor(v, o);
    return v;
}
__device__ __forceinline__ float silu_f(float x) { return x / (1.0f + __expf(-x)); }
__device__ __forceinline__ float sigmoid_f(float x) { return 1.0f / (1.0f + expf(-x)); }
__device__ __forceinline__ float softplus_f(float x) { return x > 20.f ? x : log1pf(expf(x)); }

__device__ __forceinline__ void p0_transpose_item(const float* W, int K, int ldw, int N, const float* sc, bf16* WT, float* scr, int item, int lane) {
    const int nblk = N / 32, kb = item / nblk, nb = item % nblk, k0 = 64 * kb, n0 = 32 * nb;
#pragma unroll 8
    for (int i = 0; i < 32; ++i) { const int kk = 2 * i + (lane >> 5); const float s = sc ? sc[k0 + kk] : 1.0f; scr[kk * 33 + (lane & 31)] = W[(size_t)(k0 + kk) * ldw + n0 + (lane & 31)] * s; }
    asm volatile("s_waitcnt lgkmcnt(0)" ::: "memory");
    const int c = lane & 7;
#pragma unroll
    for (int j = 0; j < 4; ++j) { const int n = (lane >> 3) + 8 * j; const float* s = scr + (8 * c) * 33 + n;
        v4u o; o.x = pk2(s[0 * 33], s[1 * 33]); o.y = pk2(s[2 * 33], s[3 * 33]); o.z = pk2(s[4 * 33], s[5 * 33]); o.w = pk2(s[6 * 33], s[7 * 33]);
        *(v4u*)(WT + (size_t)(n0 + n) * K + k0 + 8 * c) = o; }
    asm volatile("s_waitcnt lgkmcnt(0)" ::: "memory");
}
__device__ __forceinline__ void phase0(const Args& a, unsigned char* lds, int G) {
    const int tid = threadIdx.x, lane = tid & 63, wave = tid >> 6;
    const int gw = blockIdx.x * NWAVES + wave, NGW = G * NWAVES;
    unsigned char* ws = a.ws;
    const float* ln_pre = a.in[5]; const float* w_in = a.in[6]; const float* w_out = a.in[12];
    float* scr = (float*)(lds + wave * 16384);
    constexpr int I1 = (D / 64) * (NP / 32), I2 = (D / 64) * (D / 32);
    for (int it = gw; it < I1 + I2; it += NGW) {
        if (it < I1) p0_transpose_item(w_in, D, NPROJ, NP, ln_pre, (bf16*)(ws + WS_WB1), scr, it, lane);
        else p0_transpose_item(w_out, D, D, D, nullptr, (bf16*)(ws + WS_WB2), scr, it - I1, lane);
    }
    float wx[4][4][8];
#pragma unroll
    for (int i = 0; i < 4; ++i)
#pragma unroll
        for (int c = 0; c < 4; ++c) { const int k = 256 * i + 4 * lane + c; const float s = ln_pre[k];
            const f32x4 w0 = *(const f32x4*)(w_in + (size_t)k * NPROJ + NP), w1 = *(const f32x4*)(w_in + (size_t)k * NPROJ + NP + 4);
#pragma unroll
            for (int j = 0; j < 4; ++j) { wx[i][c][j] = w0[j] * s; wx[i][c][4 + j] = w1[j] * s; } }
    float* rstd = (float*)(ws + WS_RSTD); float* ab = (float*)(ws + WS_AB); bf16* xb = (bf16*)(ws + WS_XB);
    for (int r = gw; r < MT; r += NGW) {
        const float* xrow = (r < MP) ? a.in[0] + (size_t)r * D : a.in[1] + (size_t)(r - MP) * D;
        f32x4 v[4]; float ss = 0.f; float dot[8];
#pragma unroll
        for (int j = 0; j < 8; ++j) dot[j] = 0.f;
#pragma unroll
        for (int i = 0; i < 4; ++i) { v[i] = *((const f32x4*)xrow + 64 * i + lane);
#pragma unroll
            for (int c = 0; c < 4; ++c) { ss += v[i][c] * v[i][c];
#pragma unroll
                for (int j = 0; j < 8; ++j) dot[j] += v[i][c] * wx[i][c][j]; } }
        ss = wave_sum(ss);
#pragma unroll
        for (int j = 0; j < 8; ++j) dot[j] = wave_sum(dot[j]);
        const float rs = 1.0f / sqrtf(ss * (1.0f / D) + RMS_EPS);
        unsigned long long* o8 = (unsigned long long*)(xb + (size_t)r * D) + lane;
#pragma unroll
        for (int i = 0; i < 4; ++i) o8[64 * i] = (unsigned long long)pk2(v[i][0], v[i][1]) | ((unsigned long long)pk2(v[i][2], v[i][3]) << 32);
        if (lane == 0) rstd[r] = rs;
        if (lane < 8) { float d = dot[0];
#pragma unroll
            for (int j = 1; j < 8; ++j) d = (lane == j) ? dot[j] : d;
            ab[(size_t)r * 8 + lane] = d * rs; }
    }
}

__device__ __forceinline__ void phase2(const Args& a, int G) {
    const int tid = threadIdx.x, lane = tid & 63, wave = tid >> 6;
    const int gw = blockIdx.x * NWAVES + wave, NGW = G * NWAVES;
    unsigned char* ws = a.ws;
    const bf16* proj = (const bf16*)(ws + WS_PROJ); bf16* mix = (bf16*)(ws + WS_XB); bf16* qkv = (bf16*)(ws + WS_QKV);
    const float* ab = (const float*)(ws + WS_AB); float* gbv = (float*)(ws + WS_GB);
    const float* cache_a = a.in[2]; const float* cache_q = a.in[3]; const float* cw_a = a.in[7]; const float* cw_q = a.in[8];
    const float* a_log = a.in[9]; const float* dt_bias = a.in[10];
    float* out = a.out;
    const int c8 = 8 * lane;
    constexpr int RB = 8;
    for (int blk = gw; blk < MT / RB; blk += NGW) {
        const int r0 = blk * RB;
        const bool smp = r0 >= MP;
        const int b = smp ? (r0 - MP) / DSEQ : r0 / SEQ;
        const int t0 = smp ? (r0 - MP) % DSEQ : r0 % SEQ;
        const int T = smp ? DSEQ : SEQ;
        {
            float w[3][8];
#pragma unroll
            for (int j = 0; j < 3; ++j) { const f32x4 x0 = *(const f32x4*)(cw_a + j * DC + c8), x1 = *(const f32x4*)(cw_a + j * DC + c8 + 4);
#pragma unroll
                for (int c = 0; c < 4; ++c) { w[j][c] = x0[c]; w[j][4 + c] = x1[c]; } }
            float um2[8], um1[8];
            if (t0 == 0) {
                if (smp) { const float* cp = cache_a + (size_t)b * 2 * DC + c8;
#pragma unroll
                    for (int c = 0; c < 8; ++c) { um2[c] = cp[c]; um1[c] = cp[DC + c]; } }
                else {
#pragma unroll
                    for (int c = 0; c < 8; ++c) { um2[c] = 0.f; um1[c] = 0.f; } }
            } else {
                float ca[8], xa[8];
                unpack8(*(const v4u*)(proj + (size_t)(r0 - 2) * NP + C_CA + c8), ca); unpack8(*(const v4u*)(proj + (size_t)(r0 - 2) * NP + C_XA + c8), xa);
#pragma unroll
                for (int c = 0; c < 8; ++c) um2[c] = ca[c] * xa[c];
                unpack8(*(const v4u*)(proj + (size_t)(r0 - 1) * NP + C_CA + c8), ca); unpack8(*(const v4u*)(proj + (size_t)(r0 - 1) * NP + C_XA + c8), xa);
#pragma unroll
                for (int c = 0; c < 8; ++c) um1[c] = ca[c] * xa[c];
            }
#pragma unroll 2
            for (int i = 0; i < RB; ++i) {
                const int r = r0 + i, t = t0 + i;
                const bf16* pr = proj + (size_t)r * NP + c8;
                float ba[8], ca[8], xa[8], za[8], y[8], u[8];
                unpack8(*(const v4u*)(pr + C_BA), ba); unpack8(*(const v4u*)(pr + C_CA), ca); unpack8(*(const v4u*)(pr + C_XA), xa); unpack8(*(const v4u*)(pr + C_ZA), za);
#pragma unroll
                for (int c = 0; c < 8; ++c) { u[c] = ca[c] * xa[c]; const float cv = w[0][c] * um2[c] + w[1][c] * um1[c] + w[2][c] * u[c]; y[c] = ba[c] * cv * silu_f(za[c]); um2[c] = um1[c]; um1[c] = u[c]; }
                *(v4u*)(mix + (size_t)r * D + c8) = pack8(y);
                if (t >= T - 2) { float* op = out + (smp ? O_CA_S : O_CA_P) + ((size_t)b * 2 + (t - (T - 2))) * DC + c8;
                    *(f32x4*)op = (f32x4){u[0], u[1], u[2], u[3]}; *(f32x4*)(op + 4) = (f32x4){u[4], u[5], u[6], u[7]}; }
            }
        }
#pragma unroll 1
        for (int seg = 0; seg < 3; ++seg) {
            const int cc = seg * 512 + c8;
            float w[4][8];
#pragma unroll
            for (int j = 0; j < 4; ++j) { const f32x4 x0 = *(const f32x4*)(cw_q + j * DQKV + cc), x1 = *(const f32x4*)(cw_q + j * DQKV + cc + 4);
#pragma unroll
                for (int c = 0; c < 4; ++c) { w[j][c] = x0[c]; w[j][4 + c] = x1[c]; } }
            float xm3[8], xm2[8], xm1[8];
            if (t0 == 0) {
                if (smp) { const float* cp = cache_q + (size_t)b * 3 * DQKV + cc;
#pragma unroll
                    for (int c = 0; c < 8; ++c) { xm3[c] = cp[c]; xm2[c] = cp[DQKV + c]; xm1[c] = cp[2 * DQKV + c]; } }
                else {
#pragma unroll
                    for (int c = 0; c < 8; ++c) { xm3[c] = 0.f; xm2[c] = 0.f; xm1[c] = 0.f; } }
            } else {
                unpack8(*(const v4u*)(proj + (size_t)(r0 - 3) * NP + C_QKV + cc), xm3);
                unpack8(*(const v4u*)(proj + (size_t)(r0 - 2) * NP + C_QKV + cc), xm2);
                unpack8(*(const v4u*)(proj + (size_t)(r0 - 1) * NP + C_QKV + cc), xm1);
            }
#pragma unroll 2
            for (int i = 0; i < RB; ++i) {
                const int r = r0 + i, t = t0 + i;
                float x[8], s[8]; unpack8(*(const v4u*)(proj + (size_t)r * NP + C_QKV + cc), x);
                float ss = 0.f;
#pragma unroll
                for (int c = 0; c < 8; ++c) { const float cv = w[0][c] * xm3[c] + w[1][c] * xm2[c] + w[2][c] * xm1[c] + w[3][c] * x[c]; s[c] = silu_f(cv); ss += s[c] * s[c]; xm3[c] = xm2[c]; xm2[c] = xm1[c]; xm1[c] = x[c]; }
                if (seg < 2) {
                    ss += __shfl_xor(ss, 1); ss += __shfl_xor(ss, 2); ss += __shfl_xor(ss, 4); ss += __shfl_xor(ss, 8);
                    float inv = 1.0f / sqrtf(ss + L2_EPS); if (seg == 0) inv *= 0.08838834764831845f;
#pragma unroll
                    for (int c = 0; c < 8; ++c) s[c] *= inv;
                }
                *(v4u*)(qkv + (size_t)r * DQKV + cc) = pack8(s);
                if (t >= T - 3) { float* op = out + (smp ? O_CQ_S : O_CQ_P) + ((size_t)b * 3 + (t - (T - 3))) * DQKV + cc;
                    *(f32x4*)op = (f32x4){x[0], x[1], x[2], x[3]}; *(f32x4*)(op + 4) = (f32x4){x[4], x[5], x[6], x[7]}; }
            }
        }
        if (lane < RB * NH) { const int i = lane >> 2, h = lane & 3, r = r0 + i;
            const float ad = ab[(size_t)r * 8 + h], bb = ab[(size_t)r * 8 + 4 + h];
            gbv[(size_t)r * 8 + h] = -expf(a_log[h]) * softplus_f(ad + dt_bias[h]);
            gbv[(size_t)r * 8 + 4 + h] = sigmoid_f(bb); }
    }
}

__device__ __forceinline__ void phase3(const Args& a, unsigned char* lds, int G) {
    const int tid = threadIdx.x;
    unsigned char* ws = a.ws;
    const bf16* qkv = (const bf16*)(ws + WS_QKV); const float* gbv = (const float*)(ws + WS_GB); float* obuf = (float*)(ws + WS_O);
    float* tile = (float*)lds;
    constexpr int TT = 32, TS = 388;
    const int e = tid >> 2, dq = tid & 3;
    for (int sq = blockIdx.x; sq < NB * NH + NBS * NH; sq += G) {
        const bool smp = sq >= NB * NH;
        const int sl = smp ? sq - NB * NH : sq, b = sl >> 2, h = sl & 3;
        const int rbase = smp ? MP + b * DSEQ : b * SEQ, T = smp ? DSEQ : SEQ;
        float s[32];
        if (smp) { const float* sp = a.in[4] + ((size_t)sl * HD + 32 * dq) * HD + e;
#pragma unroll
            for (int i = 0; i < 32; ++i) s[i] = sp[(size_t)i * HD]; }
        else {
#pragma unroll
            for (int i = 0; i < 32; ++i) s[i] = 0.f; }
        for (int tt = 0; tt < T; tt += TT) {
            __syncthreads();
#pragma unroll
            for (int j = 0; j < 3; ++j) { const int id = tid + 512 * j, tok = id / 48, ci = id % 48, seg = ci >> 4, cc = (ci & 15) * 8;
                float f[8]; unpack8(*(const v4u*)(qkv + (size_t)(rbase + tt + tok) * DQKV + seg * 512 + h * HD + cc), f);
                float* tp = tile + tok * TS + seg * 128 + cc;
                *(f32x4*)tp = (f32x4){f[0], f[1], f[2], f[3]}; *(f32x4*)(tp + 4) = (f32x4){f[4], f[5], f[6], f[7]}; }
            if (tid < TT) { const int r = rbase + tt + tid; tile[tid * TS + 384] = expf(gbv[(size_t)r * 8 + h]); tile[tid * TS + 385] = gbv[(size_t)r * 8 + 4 + h]; }
            __syncthreads();
#pragma unroll 1
            for (int tok = 0; tok < TT; ++tok) {
                const float* tk = tile + tok * TS;
                const float eg = tk[384], beta = tk[385], vv = tk[256 + e];
                float kk[32], qq[32];
#pragma unroll
                for (int i = 0; i < 8; ++i) { const f32x4 k4 = *(const f32x4*)(tk + 128 + 32 * dq + 4 * i), q4 = *(const f32x4*)(tk + 32 * dq + 4 * i);
#pragma unroll
                    for (int c = 0; c < 4; ++c) { kk[4 * i + c] = k4[c]; qq[4 * i + c] = q4[c]; } }
                float ks = 0.f;
#pragma unroll
                for (int i = 0; i < 32; ++i) ks += kk[i] * s[i];
                ks += __shfl_xor(ks, 1); ks += __shfl_xor(ks, 2);
                const float delta = beta * (vv - eg * ks);
                float o = 0.f;
#pragma unroll
                for (int i = 0; i < 32; ++i) { s[i] = eg * s[i] + kk[i] * delta; o += qq[i] * s[i]; }
                o += __shfl_xor(o, 1); o += __shfl_xor(o, 2);
                if (dq == 0) obuf[(size_t)(rbase + tt + tok) * 512 + h * HD + e] = o;
            }
        }
        float* so = a.out + (smp ? O_ST_S : O_ST_P) + ((size_t)sl * HD + 32 * dq) * HD + e;
#pragma unroll
        for (int i = 0; i < 32; ++i) so[(size_t)i * HD] = s[i];
    }
}

__device__ __forceinline__ void phase4(const Args& a, int G) {
    const int tid = threadIdx.x, lane = tid & 63, wave = tid >> 6;
    const int gw = blockIdx.x * NWAVES + wave, NGW = G * NWAVES;
    unsigned char* ws = a.ws;
    const bf16* proj = (const bf16*)(ws + WS_PROJ); bf16* mix = (bf16*)(ws + WS_XB); const float* obuf = (const float*)(ws + WS_O);
    const float* gw_n = a.in[11];
    const int c8 = 8 * lane;
    float wn[8];
#pragma unroll
    for (int c = 0; c < 8; ++c) wn[c] = gw_n[(c8 & 127) + c];
    for (int r = gw; r < MT; r += NGW) {
        const f32x4 o0 = *(const f32x4*)(obuf + (size_t)r * 512 + c8), o1 = *(const f32x4*)(obuf + (size_t)r * 512 + c8 + 4);
        float z[8]; unpack8(*(const v4u*)(proj + (size_t)r * NP + C_ZG + c8), z);
        float o[8] = {o0[0], o0[1], o0[2], o0[3], o1[0], o1[1], o1[2], o1[3]};
        float ss = 0.f;
#pragma unroll
        for (int c = 0; c < 8; ++c) ss += o[c] * o[c];
        ss += __shfl_xor(ss, 1); ss += __shfl_xor(ss, 2); ss += __shfl_xor(ss, 4); ss += __shfl_xor(ss, 8);
        const float rs = 1.0f / sqrtf(ss * (1.0f / HD) + RMS_EPS);
        float y[8];
#pragma unroll
        for (int c = 0; c < 8; ++c) y[c] = o[c] * rs * wn[c] * silu_f(z[c]);
        *(v4u*)(mix + (size_t)r * D + 512 + c8) = pack8(y);
    }
}

__device__ __forceinline__ void phase6(const Args& a, int G) {
    const int tid = threadIdx.x, lane = tid & 63, wave = tid >> 6;
    const int gw = blockIdx.x * NWAVES + wave, NGW = G * NWAVES;
    const float* outb = (const float*)(a.ws + WS_PROJ); const float* ln_post = a.in[13];
    f32x4 lw[4];
#pragma unroll
    for (int i = 0; i < 4; ++i) lw[i] = *((const f32x4*)ln_post + 64 * i + lane);
    for (int r = gw; r < MT; r += NGW) {
        const float* xrow = (r < MP) ? a.in[0] + (size_t)r * D : a.in[1] + (size_t)(r - MP) * D;
        f32x4 v[4], xv[4]; float ss = 0.f;
#pragma unroll
        for (int i = 0; i < 4; ++i) { v[i] = *((const f32x4*)(outb + (size_t)r * D) + 64 * i + lane); xv[i] = *((const f32x4*)xrow + 64 * i + lane);
            ss += (v[i][0] * v[i][0] + v[i][1] * v[i][1]) + (v[i][2] * v[i][2] + v[i][3] * v[i][3]); }
        ss = wave_sum(ss);
        const float rs = 1.0f / sqrtf(ss * (1.0f / D) + RMS_EPS);
#pragma unroll
        for (int i = 0; i < 4; ++i) *((f32x4*)(a.out + O_Y + (size_t)r * D) + 64 * i + lane) = xv[i] + v[i] * rs * lw[i];
    }
}

constexpr int NPHASES = 7;
__global__ void __launch_bounds__(NTHREADS, 2) fwd(Args args) {
    extern __shared__ __attribute__((aligned(16))) unsigned char lds[];
    const int G = gridDim.x;
    const int lo = args.ph_lo, hi = args.ph_hi;
#if ONE_LAUNCH
    cg::grid_group grid = cg::this_grid();
#define SEAM() grid.sync()
#else
#define SEAM() do {} while (0)
#endif
#define IN(k) (lo <= (k) && (k) < hi)
    if (IN(0)) { phase0(args, lds, G); if (IN(1)) SEAM(); }
    if (IN(1)) {
        pg8::Gemm g{(const pg8::bf16_t*)(args.ws + WS_XB), (const pg8::bf16_t*)(args.ws + WS_WB1), MT, NP, D};
        pg8::StaticOrder S; S.init(MT, NP, G, (int)blockIdx.x);
        pg8::EpiProj E{(pg8::bf16_t*)(args.ws + WS_PROJ), NP, (const float*)(args.ws + WS_RSTD)};
        pg8::gemm_phase<pg8::EpiProj, pg8::StaticOrder, true, true>((LAS unsigned char*)lds, g, S, E);
        if (IN(2)) SEAM();
    }
    if (IN(2)) { phase2(args, G); if (IN(3)) SEAM(); }
    if (IN(3)) { phase3(args, lds, G); if (IN(4)) SEAM(); }
    if (IN(4)) { phase4(args, G); if (IN(5)) SEAM(); }
    if (IN(5)) {
        pg8::Gemm g{(const pg8::bf16_t*)(args.ws + WS_XB), (const pg8::bf16_t*)(args.ws + WS_WB2), MT, D, D};
        pg8::StaticOrder S; S.init(MT, D, G, (int)blockIdx.x);
        pg8::EpiF32 E{(float*)(args.ws + WS_PROJ), D};
        pg8::gemm_phase<pg8::EpiF32, pg8::StaticOrder, true, true>((LAS unsigned char*)lds, g, S, E);
        if (IN(6)) SEAM();
    }
    if (IN(6)) { phase6(args, G); }
#undef IN
}

extern "C" void kernel_launch(void* const* d_in, const int* in_sizes, int n_in, void* d_out, int out_size, void* d_ws, size_t ws_size, hipStream_t stream) {
    static int grid = 0;
    if (grid == 0) {
        if (n_in != 14 || in_sizes[0] != MP * D || (size_t)out_size != O_END || ws_size < WS_END) {
            fprintf(stderr, "kernel_launch: unexpected shapes: n_in %d in0 %d out %d (want %zu) ws %zu (want >= %zu)\n", n_in, n_in > 0 ? in_sizes[0] : -1, out_size, (size_t)O_END, ws_size, (size_t)WS_END); grid = -1; return; }
        int dev = 0, cus = 0, per_cu = 0;
        (void)hipGetDevice(&dev); (void)hipDeviceGetAttribute(&cus, hipDeviceAttributeMultiprocessorCount, dev);
        if (hipFuncSetAttribute((const void*)fwd, hipFuncAttributeMaxDynamicSharedMemorySize, LDS_BYTES) != hipSuccess) { fprintf(stderr, "kernel_launch: hipFuncSetAttribute failed\n"); grid = -1; return; }
        (void)hipOccupancyMaxActiveBlocksPerMultiprocessor(&per_cu, (const void*)fwd, NTHREADS, LDS_BYTES);
        if (per_cu < 1) { fprintf(stderr, "kernel_launch: occupancy query says %d blocks per CU\n", per_cu); per_cu = 1; }
        (void)hipGetLastError();
        grid = cus * 1;
        fprintf(stderr, "kernel_launch: cus %d per_cu %d grid %d\n", cus, per_cu, grid);
    }
    if (grid < 0) return;
    Args a{};
    for (int i = 0; i < 14; ++i) a.in[i] = (const float*)d_in[i];
    a.out = (float*)d_out; a.ws = (unsigned char*)d_ws;
#if ONE_LAUNCH
    a.ph_lo = 0; a.ph_hi = NPHASES;
    void* kargs[] = {&a};
    hipError_t e = hipLaunchCooperativeKernel((const void*)fwd, dim3(grid), dim3(NTHREADS), kargs, LDS_BYTES, stream);
    if (e != hipSuccess) fprintf(stderr, "kernel_launch: cooperative launch failed: %s (grid %d)\n", hipGetErrorString(e), grid);
#else
    for (int p = 0; p < NPHASES; ++p) { a.ph_lo = p; a.ph_hi = p + 1;
        hipLaunchKernelGGL(fwd, dim3(grid), dim3(NTHREADS), LDS_BYTES, stream, a);
        const hipError_t le = hipPeekAtLastError();
        if (le != hipSuccess) { fprintf(stderr, "kernel_launch: launch %d failed: %s\n", p, hipGetErrorName(le)); break; } }
#endif
}
```

```cpp
#include <hip/hip_runtime.h>
#include <hip/hip_cooperative_groups.h>
#include <cstdio>
#include <cstdint>
namespace cg = cooperative_groups;
#ifndef ONE_LAUNCH
#define ONE_LAUNCH 1
#endif
namespace pg8 {
#define PG8_LAS __attribute__((address_space(3)))
typedef unsigned short bf16_t;
typedef short bf16x8 __attribute__((ext_vector_type(8)));
typedef float f32x4 __attribute__((ext_vector_type(4)));
typedef unsigned u32x4 __attribute__((ext_vector_type(4)));
constexpr int BM = 256, BK = 64, HALF = 128, HTB = HALF * BK * 2  , STAGE_BYTES = 8 * HTB, NXCD = 8, WGM = 8;

__host__ __device__ __forceinline__ int lds_byte(int r, int c) { const int st = (r >> 4) * 2 + (c >> 5), rr = r & 15, cc = c & 31, ob = rr * 64 + cc * 2; return st * 1024 + (ob ^ (((ob >> 9) & 1) << 5)); }
__host__ __device__ __forceinline__ void stage_rc(int b, int& R, int& C) { const int st = b / 1024, sb = b % 1024, swz = sb ^ (((sb >> 9) & 1) << 5); R = (st >> 1) * 16 + swz / 64; C = (st & 1) * 32 + (swz % 64) / 2; }
__host__ __device__ __forceinline__ int perm32(int rho) { const int n = rho >> 4, i = rho & 15; return 8 * (i >> 2) + 4 * n + (i & 3); }

struct Unit { int pm, pn; };
struct Gemm { const bf16_t* A; const bf16_t* Bt; int M, N, K; };

struct StaticOrder {
    int nM, nN, nwg, G, c;
    __host__ __device__ void init(int M, int N, int G_, int c_) { nM = M / BM; nN = N / BM; nwg = nM * nN; G = G_; c = c_; }
    __host__ __device__ bool next(int i, Unit& u) const {
        const long L = (long)i * G + c; if (L >= nwg) return false;
        int wgid = (int)L; { const int q = nwg / NXCD, r = nwg % NXCD, xcd = wgid % NXCD, off = wgid / NXCD; wgid = (xcd < r ? xcd * (q + 1) : r * (q + 1) + (xcd - r) * q) + off; }
        const int nig = WGM * nN, gid = wgid / nig, fm = gid * WGM, gsz = (nM - fm) < WGM ? (nM - fm) : WGM;
        u.pm = fm + ((wgid % nig) % gsz); u.pn = (wgid % nig) / gsz; return true;
    }
    __device__ __forceinline__ void a_ready(const Unit&) const {}
    __device__ __forceinline__ void done(const Unit&) const {}
};
__device__ __forceinline__ unsigned cvt_pk_bf16(float lo, float hi) { unsigned r; asm volatile("v_cvt_pk_bf16_f32 %0, %1, %2" : "=v"(r) : "v"(lo), "v"(hi)); return r; }

struct EpiProj {
    static constexpr bool PERM = true, AFTER_DRAIN = false;
    bf16_t* OA; bf16_t* OQ; bf16_t* OZ; const float* rstd;
    __device__ __forceinline__ void operator()(const f32x4 (&acc)[2][2][4][2], const Unit& u, int wr, int wc, int fr, int fq) const {
        const int row0 = u.pm * BM + wr * 64 + fr; int colt = u.pn * BM; bf16_t* base; int ldc;
        if (colt < 2048) { base = OA; ldc = 2048; } else if (colt < 3584) { base = OQ; ldc = 1536; colt -= 2048; } else { base = OZ; ldc = 512; colt -= 3584; }
        const int col0 = colt + wc * 32 + 8 * fq;
#pragma unroll
        for (int ai = 0; ai < 2; ++ai)
#pragma unroll
            for (int m = 0; m < 4; ++m) { const int r = row0 + ai * HALF + m * 16; const float sc = rstd[r]; bf16_t* rowp = base + (size_t)r * ldc + col0;
#pragma unroll
                for (int bj = 0; bj < 2; ++bj) { const f32x4 v0 = acc[ai][bj][m][0] * sc, v1 = acc[ai][bj][m][1] * sc;
                    u32x4 w; w.x = cvt_pk_bf16(v0[0], v0[1]); w.y = cvt_pk_bf16(v0[2], v0[3]); w.z = cvt_pk_bf16(v1[0], v1[1]); w.w = cvt_pk_bf16(v1[2], v1[3]);
                    *(u32x4*)(rowp + bj * HALF) = w; } }
    }
};
struct EpiF32 {
    static constexpr bool PERM = false, AFTER_DRAIN = false;
    float* C; int ldc;
    __device__ __forceinline__ void operator()(const f32x4 (&acc)[2][2][4][2], const Unit& u, int wr, int wc, int fr, int fq) const {
        const int row0 = u.pm * BM + wr * 64 + fr, col0 = u.pn * BM + wc * 32 + 4 * fq;
#pragma unroll
        for (int ai = 0; ai < 2; ++ai)
#pragma unroll
            for (int m = 0; m < 4; ++m) { float* rowp = C + (size_t)(row0 + ai * HALF + m * 16) * ldc + col0;
#pragma unroll
                for (int bj = 0; bj < 2; ++bj)
#pragma unroll
                    for (int n = 0; n < 2; ++n) *(f32x4*)(rowp + bj * HALF + n * 16) = acc[ai][bj][m][n]; }
    }
};
template <class Epi, class Sched, bool ALIGN_EPI = false, bool SP2 = false>
__device__ __forceinline__ void gemm_phase(PG8_LAS unsigned char* lds, const Gemm g, const Sched& S, const Epi& E) {
    const int tid = threadIdx.x, wid = __builtin_amdgcn_readfirstlane(tid >> 6), lane = tid & 63, wr = wid >> 2, wc = wid & 3, fr = lane & 15, fq = lane >> 4;
    const int K = g.K, nt = K / BK;
    unsigned voffA[2], voffB[2];
#pragma unroll
    for (int i = 0; i < 2; ++i) { int R, C; stage_rc(tid * 16 + i * 8192, R, C); const int Rb = Epi::PERM ? ((R & ~31) + perm32(R & 31)) : R;
        voffA[i] = (unsigned)(R * K + C) * 2u; voffB[i] = (unsigned)(Rb * K + C) * 2u; }
    const size_t kstep = (size_t)(BK * 2);
    const size_t hstep = (size_t)HALF * K * 2;
    const size_t tstep = 2 * hstep;
    const unsigned ldsw = (unsigned)wid * 1024u;
    const int aoff = lds_byte(wr * 64 + fr, fq * 8), boff = lds_byte(wc * 32 + fr, fq * 8);
#define PG8_SA(b, h) (((b) * 2 + (h)) * HTB)
#define PG8_SB(b, h) ((4 + (b) * 2 + (h)) * HTB)
#define PG8_STAGE(bufoff, gbase, voff) do { _Pragma("unroll") for (int _i = 0; _i < 2; ++_i) \
        __builtin_amdgcn_global_load_lds((const unsigned*)((const char*)(gbase) + (voff)[_i]), (PG8_LAS unsigned*)(lds + (bufoff) + ldsw + _i * 8192), 16, 0, 0); } while (0)
#define PG8_LDA(dst, b, h) do { _Pragma("unroll") for (int m = 0; m < 4; ++m) _Pragma("unroll") for (int k = 0; k < 2; ++k) dst[m][k] = *(const PG8_LAS bf16x8*)(lds + PG8_SA(b, h) + aoff + m * 2048 + k * 1024); } while (0)
#define PG8_LDB(dst, b, h) do { _Pragma("unroll") for (int n = 0; n < 2; ++n) _Pragma("unroll") for (int k = 0; k < 2; ++k) dst[n][k] = *(const PG8_LAS bf16x8*)(lds + PG8_SB(b, h) + boff + n * 2048 + k * 1024); } while (0)
#define PG8_MMA(ai, bj, At, Bt) do { __builtin_amdgcn_s_setprio(1); _Pragma("unroll") for (int m = 0; m < 4; ++m) _Pragma("unroll") for (int n = 0; n < 2; ++n) _Pragma("unroll") for (int k = 0; k < 2; ++k) \
        acc[ai][bj][m][n] = __builtin_amdgcn_mfma_f32_16x16x32_bf16(Bt[n][k], At[m][k], acc[ai][bj][m][n], 0, 0, 0); __builtin_amdgcn_s_setprio(0); } while (0)
#define PG8_WAIT_V(n) asm volatile("s_waitcnt vmcnt(" #n ")" ::: "memory")
#define PG8_WAIT_L(n) asm volatile("s_waitcnt lgkmcnt(" #n ")" ::: "memory")
#define PG8_BAR __builtin_amdgcn_s_barrier()
#define PG8_SCHED __builtin_amdgcn_sched_barrier(0)
    Unit cur, nxt; int ui = 0;
    if (!S.next(0, cur)) return;
    f32x4 acc[2][2][4][2];
#pragma unroll
    for (int a = 0; a < 2; ++a)
#pragma unroll
        for (int b = 0; b < 2; ++b)
#pragma unroll
            for (int m = 0; m < 4; ++m)
#pragma unroll
                for (int n = 0; n < 2; ++n) acc[a][b][m][n] = (f32x4){0.f, 0.f, 0.f, 0.f};
    bf16x8 At[4][2], B0[2][2], B1[2][2];
    const char* cA = (const char*)g.A + (size_t)cur.pm * tstep; const char* cB = (const char*)g.Bt + (size_t)cur.pn * tstep;
    S.a_ready(cur);
    if constexpr (SP2) {
        PG8_STAGE(PG8_SB(0, 0), cB, voffB); PG8_STAGE(PG8_SB(0, 1), cB + hstep, voffB); PG8_STAGE(PG8_SA(0, 0), cA, voffA); PG8_STAGE(PG8_SA(0, 1), cA + hstep, voffA);
        if (wr == 1) PG8_BAR;
        PG8_WAIT_V(2); PG8_BAR;
        PG8_STAGE(PG8_SB(1, 0), cB + kstep, voffB); PG8_STAGE(PG8_SA(1, 0), cA + kstep, voffA); PG8_STAGE(PG8_SB(1, 1), cB + hstep + kstep, voffB);
        PG8_WAIT_V(6); PG8_BAR;
    } else {
        PG8_STAGE(PG8_SB(0, 0), cB, voffB); PG8_STAGE(PG8_SA(0, 0), cA, voffA); PG8_STAGE(PG8_SB(0, 1), cB + hstep, voffB); PG8_STAGE(PG8_SA(0, 1), cA + hstep, voffA);
        if (wr == 1) PG8_BAR;
        PG8_WAIT_V(4); PG8_BAR;
        PG8_STAGE(PG8_SB(1, 0), cB + kstep, voffB); PG8_STAGE(PG8_SA(1, 0), cA + kstep, voffA); PG8_STAGE(PG8_SB(1, 1), cB + hstep + kstep, voffB);
        PG8_WAIT_V(6); PG8_BAR;
    }
    for (;;) {
        const bool has_next = S.next(ui + 1, nxt);
        const char* nA = has_next ? (const char*)g.A + (size_t)nxt.pm * tstep : cA; const char* nB = has_next ? (const char*)g.Bt + (size_t)nxt.pn * tstep : cB;
        for (int t = 0; t < nt; t += 2) {
            const bool last = (t == nt - 2);
            const char* a1 = cA + (size_t)(t + 1) * kstep;
            const char* a2 = last ? nA : cA + (size_t)(t + 2) * kstep; const char* b2 = last ? nB : cB + (size_t)(t + 2) * kstep;
            const char* a3 = a2 + kstep; const char* b3 = b2 + kstep;
            if (last && has_next) S.a_ready(nxt);
            if constexpr (SP2) {
            PG8_LDB(B0, 0, 0); PG8_LDB(B1, 0, 1); PG8_SCHED; PG8_LDA(At, 0, 0); PG8_STAGE(PG8_SA(1, 1), a1 + hstep, voffA);
            PG8_WAIT_V(8); PG8_WAIT_L(0); PG8_BAR; PG8_MMA(0, 0, At, B0); PG8_MMA(0, 1, At, B1); PG8_BAR; PG8_SCHED;
            PG8_LDA(At, 0, 1); PG8_STAGE(PG8_SB(0, 0), b2, voffB); PG8_STAGE(PG8_SB(0, 1), b2 + hstep, voffB); PG8_STAGE(PG8_SA(0, 0), a2, voffA);
            PG8_WAIT_V(8); PG8_WAIT_L(0); PG8_BAR; PG8_MMA(1, 0, At, B0); PG8_MMA(1, 1, At, B1); PG8_BAR; PG8_SCHED;
            PG8_LDB(B0, 1, 0); PG8_LDB(B1, 1, 1); PG8_SCHED; PG8_LDA(At, 1, 0); PG8_STAGE(PG8_SA(0, 1), a2 + hstep, voffA);
            PG8_WAIT_V(8); PG8_WAIT_L(0); PG8_BAR; PG8_MMA(0, 0, At, B0); PG8_MMA(0, 1, At, B1); PG8_BAR; PG8_SCHED;
            PG8_LDA(At, 1, 1); PG8_STAGE(PG8_SB(1, 0), b3, voffB); PG8_STAGE(PG8_SB(1, 1), b3 + hstep, voffB); PG8_STAGE(PG8_SA(1, 0), a3, voffA);
            PG8_WAIT_V(8); PG8_WAIT_L(0); PG8_BAR; PG8_MMA(1, 0, At, B0); PG8_MMA(1, 1, At, B1); PG8_BAR; PG8_SCHED;
            } else {
            PG8_LDB(B0, 0, 0); PG8_SCHED; PG8_LDA(At, 0, 0); PG8_STAGE(PG8_SA(1, 1), a1 + hstep, voffA);
            PG8_WAIT_L(8); PG8_BAR; PG8_WAIT_L(0); PG8_MMA(0, 0, At, B0); PG8_BAR; PG8_SCHED;
            PG8_LDB(B1, 0, 1); PG8_STAGE(PG8_SB(0, 0), b2, voffB);
            PG8_BAR; PG8_WAIT_L(0); PG8_MMA(0, 1, At, B1); PG8_BAR;
            PG8_LDA(At, 0, 1); PG8_STAGE(PG8_SA(0, 0), a2, voffA);
            PG8_BAR; PG8_WAIT_L(0); PG8_MMA(1, 0, At, B0); PG8_BAR; PG8_SCHED;
            PG8_STAGE(PG8_SB(0, 1), b2 + hstep, voffB);
            PG8_WAIT_V(6); PG8_BAR; PG8_MMA(1, 1, At, B1); PG8_BAR;
            PG8_LDB(B0, 1, 0); PG8_SCHED; PG8_LDA(At, 1, 0); PG8_STAGE(PG8_SA(0, 1), a2 + hstep, voffA);
            PG8_WAIT_L(8); PG8_BAR; PG8_WAIT_L(0); PG8_MMA(0, 0, At, B0); PG8_BAR; PG8_SCHED;
            PG8_LDB(B1, 1, 1); PG8_STAGE(PG8_SB(1, 0), b3, voffB);
            PG8_BAR; PG8_WAIT_L(0); PG8_MMA(0, 1, At, B1); PG8_BAR;
            PG8_LDA(At, 1, 1); PG8_STAGE(PG8_SA(1, 0), a3, voffA);
            PG8_BAR; PG8_WAIT_L(0); PG8_MMA(1, 0, At, B0); PG8_BAR; PG8_SCHED;
            PG8_STAGE(PG8_SB(1, 1), b3 + hstep, voffB);
            PG8_WAIT_V(6); PG8_BAR; PG8_MMA(1, 1, At, B1); PG8_BAR;
            }
        }
        if constexpr (ALIGN_EPI) { if (wr == 0) PG8_BAR; }
        if constexpr (!Epi::AFTER_DRAIN) { E(acc, cur, wr, wc, fr, fq); S.done(cur); }
        if (!has_next) break;
#pragma unroll
        for (int a = 0; a < 2; ++a)
#pragma unroll
            for (int b = 0; b < 2; ++b)
#pragma unroll
                for (int m = 0; m < 4; ++m)
#pragma unroll
                    for (int n = 0; n < 2; ++n) acc[a][b][m][n] = (f32x4){0.f, 0.f, 0.f, 0.f};
        cur = nxt; cA = nA; cB = nB; ++ui;
        if constexpr (ALIGN_EPI) { if (wr == 1) PG8_BAR; }
    }
    PG8_WAIT_V(0);
    if constexpr (!ALIGN_EPI) { if (wr == 0) PG8_BAR; }
    PG8_BAR;
    if constexpr (Epi::AFTER_DRAIN) { E.fused(acc, cur, wr, wc, fr, fq, lds, wid, lane); S.done(cur); }
#undef PG8_SA
#undef PG8_SB
#undef PG8_STAGE
#undef PG8_LDA
#undef PG8_LDB
#undef PG8_MMA
#undef PG8_WAIT_V
#undef PG8_WAIT_L
#undef PG8_BAR
#undef PG8_SCHED
}
}

#define LAS __attribute__((address_space(3)))
typedef unsigned short bf16;
typedef unsigned v4u __attribute__((ext_vector_type(4)));
typedef unsigned v2u __attribute__((ext_vector_type(2)));
typedef float f32x4 __attribute__((ext_vector_type(4)));

constexpr int D = 1024, MP = 16 * 4096, MS = 32 * 32, MT = MP + MS, SEQ = 4096, DSEQ = 32, NB = 16, NBS = 32;
constexpr int NPROJ = 4104, NP = 4096, DC = 512, DQKV = 1536, NH = 4, HD = 128;
constexpr int C_BA = 0, C_CA = 512, C_XA = 1024, C_ZA = 1536, C_QKV = 2048, C_ZG = 3584;
constexpr float RMS_EPS = 1e-6f, L2_EPS = 1e-6f;
constexpr int NWAVES = 8, NTHREADS = 512;
constexpr int LDS_BYTES = 144 * 1024;

constexpr size_t O_Y = 0;
constexpr size_t O_CA_P = (size_t)MT * D;
constexpr size_t O_CQ_P = O_CA_P + 16 * 2 * 512;
constexpr size_t O_ST_P = O_CQ_P + 16 * 3 * 1536;
constexpr size_t O_CA_S = O_ST_P + (size_t)16 * 4 * 128 * 128;
constexpr size_t O_CQ_S = O_CA_S + 32 * 2 * 512;
constexpr size_t O_ST_S = O_CQ_S + 32 * 3 * 1536;
constexpr size_t O_END = O_ST_S + (size_t)32 * 4 * 128 * 128;

constexpr int NCH = NB * NH * 64 + NBS * NH;
constexpr int REC = 90368;
constexpr int R_NEGW = 0, R_QG = 16384, R_ATTN = 32768, R_KDEC = 40960, R_U = 57344, R_EGL = 90112, R_OPS = 57344;
constexpr size_t WS_XB = 0;
constexpr size_t WS_ZG = WS_XB + (size_t)MT * D * 2;
constexpr size_t WS_PA = WS_ZG + (size_t)MT * 512 * 2;
constexpr size_t WS_PQ = WS_PA + (size_t)MT * 2048 * 2;
constexpr size_t WS_QKR = WS_PQ + (size_t)MT * DQKV * 2;
constexpr size_t WS_KVT = WS_QKR + (size_t)MT * 1024 * 2;
constexpr size_t WS_WB1 = WS_KVT + (size_t)NCH * 32768;
constexpr size_t WS_WB2 = WS_WB1 + (size_t)NP * D * 2;
constexpr size_t WS_RSTD = WS_WB2 + (size_t)D * D * 2;
constexpr size_t WS_AB = WS_RSTD + (size_t)MT * 4;
constexpr size_t WS_GB = WS_AB + (size_t)MT * 8 * 4;
constexpr size_t WS_END = WS_GB + (size_t)MT * 8 * 4;
constexpr size_t WS_PREP = WS_PA, WS_OUT = WS_PA;
static_assert(WS_PREP + (size_t)NCH * REC <= WS_QKR, "PREP must fit in the dead projection regions");
static_assert(WS_END <= ((size_t)1 << 30), "workspace map exceeds 1 GiB");

struct Args { const float* in[14]; float* out; unsigned char* ws; int ph_lo, ph_hi; };

__device__ __forceinline__ unsigned f2bf(float f) { unsigned u = __builtin_bit_cast(unsigned, f); return (u + 0x7fffu + ((u >> 16) & 1u)) >> 16; }
typedef float f32x2_t __attribute__((ext_vector_type(2)));
typedef __bf16 bf16x2_t __attribute__((ext_vector_type(2)));
__device__ __forceinline__ unsigned pk2(float lo, float hi) { const f32x2_t v = {lo, hi}; return __builtin_bit_cast(unsigned, __builtin_convertvector(v, bf16x2_t)); }
__device__ __forceinline__ float bflo(unsigned w) { return __builtin_bit_cast(float, w << 16); }
__device__ __forceinline__ float bfhi(unsigned w) { return __builtin_bit_cast(float, w & 0xffff0000u); }
__device__ __forceinline__ void unpack8(const v4u w, float (&f)[8]) { f[0] = bflo(w.x); f[1] = bfhi(w.x); f[2] = bflo(w.y); f[3] = bfhi(w.y); f[4] = bflo(w.z); f[5] = bfhi(w.z); f[6] = bflo(w.w); f[7] = bfhi(w.w); }
__device__ __forceinline__ v4u pack8(const float (&f)[8]) { v4u w; w.x = pk2(f[0], f[1]); w.y = pk2(f[2], f[3]); w.z = pk2(f[4], f[5]); w.w = pk2(f[6], f[7]); return w; }
__device__ __forceinline__ float wave_sum(float v) {
#pragma unroll
    for (int o = 1; o < 64; o <<= 1) v += __shfl_xor(v, o);
    return v;
}
__device__ __forceinline__ float silu_f(float x) { return x / (1.0f + __expf(-x)); }
__device__ __forceinline__ float sigmoid_f(float x) { return 1.0f / (1.0f + expf(-x)); }
__device__ __forceinline__ float softplus_f(float x) { return x > 20.f ? x : log1pf(expf(x)); }

__device__ __forceinline__ void p0_transpose_item(const float* W, int K, int ldw, int N, const float* sc, bf16* WT, float* scr, int item, int lane) {
    const int nblk = N / 32, kb = item / nblk, nb = item % nblk, k0 = 64 * kb, n0 = 32 * nb;
#pragma unroll 8
    for (int i = 0; i < 32; ++i) { const int kk = 2 * i + (lane >> 5); const float s = sc ? sc[k0 + kk] : 1.0f; scr[kk * 33 + (lane & 31)] = W[(size_t)(k0 + kk) * ldw + n0 + (lane & 31)] * s; }
    asm volatile("s_waitcnt lgkmcnt(0)" ::: "memory");
    const int c = lane & 7;
#pragma unroll
    for (int j = 0; j < 4; ++j) { const int n = (lane >> 3) + 8 * j; const float* s = scr + (8 * c) * 33 + n;
        v4u o; o.x = pk2(s[0 * 33], s[1 * 33]); o.y = pk2(s[2 * 33], s[3 * 33]); o.z = pk2(s[4 * 33], s[5 * 33]); o.w = pk2(s[6 * 33], s[7 * 33]);
        *(v4u*)(WT + (size_t)(n0 + n) * K + k0 + 8 * c) = o; }
    asm volatile("s_waitcnt lgkmcnt(0)" ::: "memory");
}
__device__ __forceinline__ void phase0(const Args& a, unsigned char* lds, int G) {
    const int tid = threadIdx.x, lane = tid & 63, wave = tid >> 6;
    const int gw = blockIdx.x * NWAVES + wave, NGW = G * NWAVES;
    unsigned char* ws = a.ws;
    const float* ln_pre = a.in[5]; const float* w_in = a.in[6]; const float* w_out = a.in[12];
    float* scr = (float*)(lds + wave * 16384);
    constexpr int I1 = (D / 64) * (NP / 32), I2 = (D / 64) * (D / 32);
    for (int it = gw; it < I1 + I2; it += NGW) {
        if (it < I1) p0_transpose_item(w_in, D, NPROJ, NP, ln_pre, (bf16*)(ws + WS_WB1), scr, it, lane);
        else p0_transpose_item(w_out, D, D, D, nullptr, (bf16*)(ws + WS_WB2), scr, it - I1, lane);
    }
    float wx[4][4][8];
#pragma unroll
    for (int i = 0; i < 4; ++i)
#pragma unroll
        for (int c = 0; c < 4; ++c) { const int k = 256 * i + 4 * lane + c; const float s = ln_pre[k];
            const f32x4 w0 = *(const f32x4*)(w_in + (size_t)k * NPROJ + NP), w1 = *(const f32x4*)(w_in + (size_t)k * NPROJ + NP + 4);
#pragma unroll
            for (int j = 0; j < 4; ++j) { wx[i][c][j] = w0[j] * s; wx[i][c][4 + j] = w1[j] * s; } }
    float* rstd = (float*)(ws + WS_RSTD); float* ab = (float*)(ws + WS_AB); bf16* xb = (bf16*)(ws + WS_XB);
    for (int r = gw; r < MT; r += NGW) {
        const float* xrow = (r < MP) ? a.in[0] + (size_t)r * D : a.in[1] + (size_t)(r - MP) * D;
        f32x4 v[4]; float ss = 0.f; float dot[8];
#pragma unroll
        for (int j = 0; j < 8; ++j) dot[j] = 0.f;
#pragma unroll
        for (int i = 0; i < 4; ++i) { v[i] = *((const f32x4*)xrow + 64 * i + lane);
#pragma unroll
            for (int c = 0; c < 4; ++c) { ss += v[i][c] * v[i][c];
#pragma unroll
                for (int j = 0; j < 8; ++j) dot[j] += v[i][c] * wx[i][c][j]; } }
        ss = wave_sum(ss);
#pragma unroll
        for (int j = 0; j < 8; ++j) dot[j] = wave_sum(dot[j]);
        const float rs = 1.0f / sqrtf(ss * (1.0f / D) + RMS_EPS);
        unsigned long long* o8 = (unsigned long long*)(xb + (size_t)r * D) + lane;
#pragma unroll
        for (int i = 0; i < 4; ++i) o8[64 * i] = (unsigned long long)pk2(v[i][0], v[i][1]) | ((unsigned long long)pk2(v[i][2], v[i][3]) << 32);
        if (lane == 0) rstd[r] = rs;
        if (lane < 8) { float d = dot[0];
#pragma unroll
            for (int j = 1; j < 8; ++j) d = (lane == j) ? dot[j] : d;
            ab[(size_t)r * 8 + lane] = d * rs; }
    }
}

__device__ __forceinline__ void phase2(const Args& a, int G) {
    const int tid = threadIdx.x, lane = tid & 63, wave = tid >> 6;
    const int gw = blockIdx.x * NWAVES + wave, NGW = G * NWAVES;
    unsigned char* ws = a.ws;
    const bf16* pa = (const bf16*)(ws + WS_PA); const bf16* pq = (const bf16*)(ws + WS_PQ);
    bf16* mix = (bf16*)(ws + WS_XB); bf16* qkr = (bf16*)(ws + WS_QKR); bf16* kvt = (bf16*)(ws + WS_KVT);
    const float* ab = (const float*)(ws + WS_AB); float* gbv = (float*)(ws + WS_GB);
    const float* cache_a = a.in[2]; const float* cache_q = a.in[3]; const float* cw_a = a.in[7]; const float* cw_q = a.in[8];
    const float* a_log = a.in[9]; const float* dt_bias = a.in[10];
    float* out = a.out;
    const int c8 = 8 * lane;
    const int hh = lane >> 4, dl = 8 * (lane & 15);
    constexpr int RB = 8;
    for (int blk = gw; blk < MT / RB; blk += NGW) {
        const int r0 = blk * RB;
        const bool smp = r0 >= MP;
        const int b = smp ? (r0 - MP) / DSEQ : r0 / SEQ;
        const int t0 = smp ? (r0 - MP) % DSEQ : r0 % SEQ;
        const int T = smp ? DSEQ : SEQ;
        {
            float w[3][8];
#pragma unroll
            for (int j = 0; j < 3; ++j) { const f32x4 x0 = *(const f32x4*)(cw_a + j * DC + c8), x1 = *(const f32x4*)(cw_a + j * DC + c8 + 4);
#pragma unroll
                for (int c = 0; c < 4; ++c) { w[j][c] = x0[c]; w[j][4 + c] = x1[c]; } }
            float um2[8], um1[8];
            if (t0 == 0) {
                if (smp) { const float* cp = cache_a + (size_t)b * 2 * DC + c8;
#pragma unroll
                    for (int c = 0; c < 8; ++c) { um2[c] = cp[c]; um1[c] = cp[DC + c]; } }
                else {
#pragma unroll
                    for (int c = 0; c < 8; ++c) { um2[c] = 0.f; um1[c] = 0.f; } }
            } else {
                float ca[8], xa[8];
                unpack8(*(const v4u*)(pa + (size_t)(r0 - 2) * 2048 + C_CA + c8), ca); unpack8(*(const v4u*)(pa + (size_t)(r0 - 2) * 2048 + C_XA + c8), xa);
#pragma unroll
                for (int c = 0; c < 8; ++c) um2[c] = ca[c] * xa[c];
                unpack8(*(const v4u*)(pa + (size_t)(r0 - 1) * 2048 + C_CA + c8), ca); unpack8(*(const v4u*)(pa + (size_t)(r0 - 1) * 2048 + C_XA + c8), xa);
#pragma unroll
                for (int c = 0; c < 8; ++c) um1[c] = ca[c] * xa[c];
            }
#pragma unroll 2
            for (int i = 0; i < RB; ++i) {
                const int r = r0 + i, t = t0 + i;
                const bf16* pr = pa + (size_t)r * 2048 + c8;
                float ba[8], ca[8], xa[8], za[8], y[8], u[8];
                unpack8(*(const v4u*)(pr + C_BA), ba); unpack8(*(const v4u*)(pr + C_CA), ca); unpack8(*(const v4u*)(pr + C_XA), xa); unpack8(*(const v4u*)(pr + C_ZA), za);
#pragma unroll
                for (int c = 0; c < 8; ++c) { u[c] = ca[c] * xa[c]; const float cv = w[0][c] * um2[c] + w[1][c] * um1[c] + w[2][c] * u[c]; y[c] = ba[c] * cv * silu_f(za[c]); um2[c] = um1[c]; um1[c] = u[c]; }
                *(v4u*)(mix + (size_t)r * D + c8) = pack8(y);
                if (t >= T - 2) { float* op = out + (smp ? O_CA_S : O_CA_P) + ((size_t)b * 2 + (t - (T - 2))) * DC + c8;
                    *(f32x4*)op = (f32x4){u[0], u[1], u[2], u[3]}; *(f32x4*)(op + 4) = (f32x4){u[4], u[5], u[6], u[7]}; }
            }
        }
        const int ch = smp ? NB * NH * 64 + b * NH + hh : (b * NH + hh) * 64 + t0 / 64;
        const int tq = smp ? t0 : (t0 & 63);
        const int ks = tq >> 4, jj0 = (tq & 8) >> 1;
#pragma unroll 1
        for (int seg = 0; seg < 3; ++seg) {
            const int cc = seg * 512 + c8;
            float w[4][8];
#pragma unroll
            for (int j = 0; j < 4; ++j) { const f32x4 x0 = *(const f32x4*)(cw_q + j * DQKV + cc), x1 = *(const f32x4*)(cw_q + j * DQKV + cc + 4);
#pragma unroll
                for (int c = 0; c < 4; ++c) { w[j][c] = x0[c]; w[j][4 + c] = x1[c]; } }
            float xm3[8], xm2[8], xm1[8];
            if (t0 == 0) {
                if (smp) { const float* cp = cache_q + (size_t)b * 3 * DQKV + cc;
#pragma unroll
                    for (int c = 0; c < 8; ++c) { xm3[c] = cp[c]; xm2[c] = cp[DQKV + c]; xm1[c] = cp[2 * DQKV + c]; } }
                else {
#pragma unroll
                    for (int c = 0; c < 8; ++c) { xm3[c] = 0.f; xm2[c] = 0.f; xm1[c] = 0.f; } }
            } else {
                unpack8(*(const v4u*)(pq + (size_t)(r0 - 3) * DQKV + cc), xm3);
                unpack8(*(const v4u*)(pq + (size_t)(r0 - 2) * DQKV + cc), xm2);
                unpack8(*(const v4u*)(pq + (size_t)(r0 - 1) * DQKV + cc), xm1);
            }
            unsigned tkp[8][4];
#pragma unroll
            for (int i = 0; i < RB; ++i) {
                const int r = r0 + i, t = t0 + i;
                float x[8], s[8]; unpack8(*(const v4u*)(pq + (size_t)r * DQKV + cc), x);
                float ss = 0.f;
#pragma unroll
                for (int c = 0; c < 8; ++c) { const float cv = w[0][c] * xm3[c] + w[1][c] * xm2[c] + w[2][c] * xm1[c] + w[3][c] * x[c]; s[c] = silu_f(cv); ss += s[c] * s[c]; xm3[c] = xm2[c]; xm2[c] = xm1[c]; xm1[c] = x[c]; }
                if (seg < 2) {
                    ss += __shfl_xor(ss, 1); ss += __shfl_xor(ss, 2); ss += __shfl_xor(ss, 4); ss += __shfl_xor(ss, 8);
                    float inv = 1.0f / sqrtf(ss + L2_EPS); if (seg == 0) inv *= 0.08838834764831845f;
#pragma unroll
                    for (int c = 0; c < 8; ++c) s[c] *= inv;
                    bf16* qp = qkr + (size_t)r * 1024 + seg * 512 + hh * HD + (dl & ~15) + 4 * (lane & 1);
                    *(v2u*)qp = (v2u){pk2(s[0], s[1]), pk2(s[2], s[3])};
                    *(v2u*)(qp + 8) = (v2u){pk2(s[4], s[5]), pk2(s[6], s[7])};
                }
                if (seg >= 1) {
#pragma unroll
                    for (int c = 0; c < 8; ++c) { const unsigned bv = pk2(s[c], 0.f) & 0xffffu; if (i & 1) tkp[c][i >> 1] |= bv << 16; else tkp[c][i >> 1] = bv; }
                }
                if (t >= T - 3) { float* op = out + (smp ? O_CQ_S : O_CQ_P) + ((size_t)b * 3 + (t - (T - 3))) * DQKV + cc;
                    *(f32x4*)op = (f32x4){x[0], x[1], x[2], x[3]}; *(f32x4*)(op + 4) = (f32x4){x[4], x[5], x[6], x[7]}; }
            }
            if (seg >= 1) {
                bf16* base = kvt + (size_t)ch * 16384 + (seg - 1) * 8192;
#pragma unroll
                for (int c = 0; c < 8; ++c) { const int d = dl + c, dt = d >> 5, rr = d & 31;
                    bf16* bp = base + (dt * 4 + ks) * 512 + rr * 8 + jj0;
                    *(v2u*)bp = (v2u){tkp[c][0], tkp[c][1]};
                    *(v2u*)(bp + 256) = (v2u){tkp[c][2], tkp[c][3]}; }
            }
        }
        if (lane < RB * NH) { const int i = lane >> 2, h = lane & 3, r = r0 + i;
            const float ad = ab[(size_t)r * 8 + h], bb = ab[(size_t)r * 8 + 4 + h];
            gbv[(size_t)r * 8 + h] = -expf(a_log[h]) * softplus_f(ad + dt_bias[h]);
            gbv[(size_t)r * 8 + 4 + h] = sigmoid_f(bb); }
    }
}

typedef short bf16x8 __attribute__((ext_vector_type(8)));
typedef float f32x16 __attribute__((ext_vector_type(16)));
#define MFMA32(a, b, c) __builtin_amdgcn_mfma_f32_32x32x16_bf16((a), (b), (c), 0, 0, 0)
__device__ __forceinline__ bf16x8 pack_regs(const f32x16& x, int s) {
    v4u w; w.x = pk2(x[8 * s + 0], x[8 * s + 1]); w.y = pk2(x[8 * s + 2], x[8 * s + 3]); w.z = pk2(x[8 * s + 4], x[8 * s + 5]); w.w = pk2(x[8 * s + 6], x[8 * s + 7]);
    return __builtin_bit_cast(bf16x8, w);
}
__device__ __forceinline__ f32x16 zero16() { f32x16 z;
#pragma unroll
    for (int i = 0; i < 16; ++i) z[i] = 0.f;
    return z; }
constexpr int AP = 68;
constexpr int SLOT_BYTES = 64 * AP * 4 + 1024;
static_assert(SLOT_BYTES * NWAVES <= LDS_BYTES, "chunk-prep LDS");

__device__ __forceinline__ void phase3(const Args& a, unsigned char* lds, int G) {
    const int tid = threadIdx.x, lane = tid & 63, wave = __builtin_amdgcn_readfirstlane(tid >> 6);
    const int gw = blockIdx.x * NWAVES + wave, NGW = G * NWAVES;
    unsigned char* ws = a.ws;
    const bf16* qkr = (const bf16*)(ws + WS_QKR); const bf16* kvt = (const bf16*)(ws + WS_KVT); const float* gbv = (const float*)(ws + WS_GB);
    float* Am = (float*)(lds + wave * SLOT_BYTES);
    float* tab = Am + 64 * AP;
    const int r = lane & 31, hf = lane >> 5;
    for (int ch = gw; ch < NCH; ch += NGW) {
        const bool smp = ch >= NB * NH * 64;
        int rbase, hh, ntok;
        if (smp) { const int sl = ch - NB * NH * 64; rbase = MP + (sl >> 2) * DSEQ; hh = sl & 3; ntok = DSEQ; }
        else { const int sq = ch >> 6, n = ch & 63; rbase = (sq >> 2) * SEQ + n * 64; hh = sq & 3; ntok = 64; }
        const int nks = ntok >> 4;
        unsigned char* rec = ws + WS_PREP + (size_t)ch * REC;
        float g = 0.f, bt = 0.f;
        if (lane < ntok) { g = gbv[(size_t)(rbase + lane) * 8 + hh]; bt = gbv[(size_t)(rbase + lane) * 8 + 4 + hh]; }
        float gb = g;
#pragma unroll
        for (int o = 1; o < 64; o <<= 1) { const float t = __shfl_up(gb, o); if (lane >= o) gb += t; }
        const float gl = __shfl(gb, 63);
        tab[lane] = gb; tab[64 + lane] = bt; tab[128 + lane] = expf(gb); tab[192 + lane] = expf(gl - gb);
        asm volatile("s_waitcnt lgkmcnt(0)" ::: "memory");
        const int row0 = r & (ntok - 1), row1 = (32 + r) & (ntok - 1);
        const bf16* q0p = qkr + (size_t)(rbase + row0) * 1024 + hh * HD + 8 * hf; const bf16* q1p = qkr + (size_t)(rbase + row1) * 1024 + hh * HD + 8 * hf;
        f32x16 at00 = zero16(), at01 = zero16(), at11 = zero16(), ak00 = zero16(), ak10 = zero16(), ak11 = zero16();
        const float e0 = tab[128 + r], e1 = tab[160 + r];
#pragma unroll
        for (int ks8 = 0; ks8 < 8; ++ks8) {
            const v4u qf0 = *(const v4u*)(q0p + 16 * ks8), qf1 = *(const v4u*)(q1p + 16 * ks8), kf0 = *(const v4u*)(q0p + 512 + 16 * ks8), kf1 = *(const v4u*)(q1p + 512 + 16 * ks8);
            const bf16x8 q0 = __builtin_bit_cast(bf16x8, qf0), q1 = __builtin_bit_cast(bf16x8, qf1), k0 = __builtin_bit_cast(bf16x8, kf0), k1 = __builtin_bit_cast(bf16x8, kf1);
            at00 = MFMA32(k0, q0, at00); at01 = MFMA32(k0, q1, at01); at11 = MFMA32(k1, q1, at11);
            ak00 = MFMA32(k0, k0, ak00); ak10 = MFMA32(k1, k0, ak10); ak11 = MFMA32(k1, k1, ak11);
            float f0[8], f1[8]; unpack8(qf0, f0); unpack8(qf1, f1);
#pragma unroll
            for (int c = 0; c < 8; ++c) { f0[c] *= e0; f1[c] *= e1; }
            *(v4u*)(rec + R_QG + (0 * 8 + ks8) * 1024 + lane * 16) = pack8(f0);
            *(v4u*)(rec + R_QG + (1 * 8 + ks8) * 1024 + lane * 16) = pack8(f1);
        }
        {
            const float gi0 = tab[r], gi1 = tab[32 + r];
#pragma unroll
            for (int tile = 0; tile < 3; ++tile) {
                const int jt = (tile == 2) ? 1 : 0, it = (tile == 0) ? 0 : 1;
                f32x16& acc = (tile == 0) ? at00 : (tile == 1 ? at01 : at11);
                const float gi = it ? gi1 : gi0; const int i = 32 * it + r;
#pragma unroll
                for (int gq = 0; gq < 4; ++gq) { const f32x4 gj = *(const f32x4*)(tab + 32 * jt + 8 * gq + 4 * hf);
#pragma unroll
                    for (int c = 0; c < 4; ++c) { const int j = 32 * jt + 8 * gq + 4 * hf + c; const float dcy = __expf(fminf(gi - gj[c], 0.f)); acc[4 * gq + c] = (i >= j) ? acc[4 * gq + c] * dcy : 0.f; } }
#pragma unroll
                for (int s = 0; s < 2; ++s) *(bf16x8*)(rec + R_ATTN + (it * 4 + 2 * jt + s) * 1024 + lane * 16) = pack_regs(acc, s);
            }
        }
        {
            const float gj0 = tab[r], gj1 = tab[32 + r];
#pragma unroll
            for (int tile = 0; tile < 3; ++tile) {
                const int it = (tile == 0) ? 0 : 1, jt = (tile == 2) ? 1 : 0;
                const f32x16& acc = (tile == 0) ? ak00 : (tile == 1 ? ak10 : ak11);
                const float gj = jt ? gj1 : gj0; const int j = 32 * jt + r;
#pragma unroll
                for (int gq = 0; gq < 4; ++gq) { const f32x4 gi = *(const f32x4*)(tab + 32 * it + 8 * gq + 4 * hf), bi = *(const f32x4*)(tab + 64 + 32 * it + 8 * gq + 4 * hf);
#pragma unroll
                    for (int c = 0; c < 4; ++c) { const int i = 32 * it + 8 * gq + 4 * hf + c; Am[i * AP + j] = bi[c] * acc[4 * gq + c] * __expf(fminf(gi[c] - gj, 0.f)); } }
            }
        }
        asm volatile("s_waitcnt lgkmcnt(0)" ::: "memory");
        {
            float x[64];
#pragma unroll
            for (int i = 0; i < 64; ++i) {
                float acc = (lane == i) ? 1.f : 0.f;
#pragma unroll
                for (int k4 = 0; k4 < (i + 3) / 4; ++k4) { const f32x4 av = *(const f32x4*)(Am + i * AP + 4 * k4);
#pragma unroll
                    for (int c = 0; c < 4; ++c) if (4 * k4 + c < i) acc -= av[c] * x[4 * k4 + c]; }
                x[i] = acc;
            }
            asm volatile("s_waitcnt lgkmcnt(0)" ::: "memory");
#pragma unroll
            for (int i = 0; i < 64; ++i) Am[i * AP + lane] = x[i] * bt;
        }
        asm volatile("s_waitcnt lgkmcnt(0)" ::: "memory");
        bf16x8 t2f[2][4];
#pragma unroll
        for (int it = 0; it < 2; ++it)
#pragma unroll
            for (int ks = 0; ks < 4; ++ks) { if (it == 0 && ks >= 2) continue;
                const f32x4 lo = *(const f32x4*)(Am + (32 * it + r) * AP + 16 * ks + 4 * hf), hi = *(const f32x4*)(Am + (32 * it + r) * AP + 16 * ks + 8 + 4 * hf);
                v4u w; w.x = pk2(lo[0], lo[1]); w.y = pk2(lo[2], lo[3]); w.z = pk2(hi[0], hi[1]); w.w = pk2(hi[2], hi[3]); t2f[it][ks] = __builtin_bit_cast(bf16x8, w); }
        const bf16* ktp = kvt + (size_t)ch * 16384 + lane * 8;
#pragma unroll 1
        for (int dt = 0; dt < 4; ++dt) {
            f32x16 w0 = zero16(), w1 = zero16();
#pragma unroll
            for (int ks = 0; ks < 4; ++ks) {
                v4u kd = (v4u){0u, 0u, 0u, 0u};
                if (ks < nks) {
                    float kt[8], ke[8], kf[8]; unpack8(*(const v4u*)(ktp + (dt * 4 + ks) * 512), kt);
                    const f32x4 ea = *(const f32x4*)(tab + 128 + 16 * ks + 4 * hf), eb = *(const f32x4*)(tab + 128 + 16 * ks + 8 + 4 * hf);
                    const f32x4 fa = *(const f32x4*)(tab + 192 + 16 * ks + 4 * hf), fb = *(const f32x4*)(tab + 192 + 16 * ks + 8 + 4 * hf);
#pragma unroll
                    for (int c = 0; c < 4; ++c) { ke[c] = kt[c] * ea[c]; ke[4 + c] = kt[4 + c] * eb[c]; kf[c] = kt[c] * fa[c]; kf[4 + c] = kt[4 + c] * fb[c]; }
                    const bf16x8 aop = __builtin_bit_cast(bf16x8, pack8(ke));
                    kd = pack8(kf);
                    w1 = MFMA32(aop, t2f[1][ks], w1);
                    if (ks < 2) w0 = MFMA32(aop, t2f[0][ks], w0);
                }
                *(v4u*)(rec + R_KDEC + (dt * 4 + ks) * 1024 + lane * 16) = kd;
            }
#pragma unroll
            for (int i = 0; i < 16; ++i) { w0[i] = -w0[i]; w1[i] = -w1[i]; }
#pragma unroll
            for (int s = 0; s < 2; ++s) { *(bf16x8*)(rec + R_NEGW + (0 * 8 + 2 * dt + s) * 1024 + lane * 16) = pack_regs(w0, s);
                                          *(bf16x8*)(rec + R_NEGW + (1 * 8 + 2 * dt + s) * 1024 + lane * 16) = pack_regs(w1, s); }
        }
        const bf16* vtp = kvt + (size_t)ch * 16384 + 8192 + lane * 8;
#pragma unroll 1
        for (int et = 0; et < 4; ++et) {
            f32x16 u0 = zero16(), u1 = zero16();
#pragma unroll
            for (int ks = 0; ks < 4; ++ks) {
                if (ks < nks) { const bf16x8 vb = *(const bf16x8*)(vtp + (et * 4 + ks) * 512);
                    u1 = MFMA32(t2f[1][ks], vb, u1);
                    if (ks < 2) u0 = MFMA32(t2f[0][ks], vb, u0); }
            }
            *(f32x16*)(rec + R_U + ((et * 2 + 0) * 64 + lane) * 64) = u0;
            *(f32x16*)(rec + R_U + ((et * 2 + 1) * 64 + lane) * 64) = u1;
        }
        if (lane == 0) *(float*)(rec + R_EGL) = expf(gl);
    }
}

constexpr int OT_OFF = 2 * R_OPS;
static_assert(OT_OFF + 64 * 128 * 4 <= LDS_BYTES, "scan LDS");
__device__ __forceinline__ void scan_epilogue(const Args& a, const unsigned char* lds, int hw, int lane, int grow0, int hh, int ntok, const float (&wn)[8]) {
    const bf16* zg = (const bf16*)(a.ws + WS_ZG); bf16* mix = (bf16*)(a.ws + WS_XB);
    const float* ot = (const float*)(lds + OT_OFF);
    const int e0 = 8 * (lane & 15);
#pragma unroll
    for (int gq = 0; gq < 4; ++gq) {
        const int row = 16 * hw + 4 * gq + (lane >> 4);
        const f32x4 o0 = *(const f32x4*)(ot + row * 128 + e0), o1 = *(const f32x4*)(ot + row * 128 + e0 + 4);
        float o[8] = {o0[0], o0[1], o0[2], o0[3], o1[0], o1[1], o1[2], o1[3]};
        float ss = 0.f;
#pragma unroll
        for (int c = 0; c < 8; ++c) ss += o[c] * o[c];
        ss += __shfl_xor(ss, 1); ss += __shfl_xor(ss, 2); ss += __shfl_xor(ss, 4); ss += __shfl_xor(ss, 8);
        if (row < ntok) {
            const size_t grow = (size_t)(grow0 + row);
            float z[8]; unpack8(*(const v4u*)(zg + grow * 512 + hh * HD + e0), z);
            const float rs = 1.0f / sqrtf(ss * (1.0f / HD) + RMS_EPS);
            float y[8];
#pragma unroll
            for (int c = 0; c < 8; ++c) y[c] = o[c] * rs * wn[c] * silu_f(z[c]);
            *(v4u*)(mix + grow * D + 512 + hh * HD + e0) = pack8(y);
        }
    }
}
__device__ __forceinline__ void phase4(const Args& a, unsigned char* lds, int G) {
    const int tid = threadIdx.x, lane = tid & 63, wave = __builtin_amdgcn_readfirstlane(tid >> 6);
    unsigned char* ws = a.ws;
    const int r = lane & 31, hf = lane >> 5;
    for (int sq = blockIdx.x; sq < NB * NH + NBS * NH; sq += G) {
        const bool smp = sq >= NB * NH;
        const int sl = smp ? sq - NB * NH : sq, hh = sl & 3;
        const int ch0 = smp ? NB * NH * 64 + sl : sq * 64, nch = smp ? 1 : 64, ntok = smp ? DSEQ : 64;
        const int rbase = smp ? MP + (sl >> 2) * DSEQ : (sl >> 2) * SEQ;
        const unsigned char* rec0 = ws + WS_PREP + (size_t)ch0 * REC;
        __syncthreads();
        if (wave >= 4) {
            const int hw = wave - 4;
            float wn[8];
#pragma unroll
            for (int c = 0; c < 8; ++c) wn[c] = a.in[11][8 * (lane & 15) + c];
#pragma unroll 1
            for (int blk = hw; blk < 56; blk += 4)
                __builtin_amdgcn_global_load_lds((const unsigned*)(rec0 + blk * 1024 + lane * 16), (LAS unsigned*)(lds + blk * 1024), 16, 0, 0);
            asm volatile("s_waitcnt vmcnt(0)" ::: "memory");
            __builtin_amdgcn_s_barrier(); asm volatile("" ::: "memory");
#pragma unroll 1
            for (int n = 0; n < nch; ++n) {
                if (n + 1 < nch) { const unsigned char* rn = rec0 + (size_t)(n + 1) * REC; unsigned char* dst = lds + ((n + 1) & 1) * R_OPS;
#pragma unroll 1
                    for (int blk = hw; blk < 56; blk += 4)
                        __builtin_amdgcn_global_load_lds((const unsigned*)(rn + blk * 1024 + lane * 16), (LAS unsigned*)(dst + blk * 1024), 16, 0, 0); }
                if (n >= 1) scan_epilogue(a, lds, hw, lane, rbase + (n - 1) * 64, hh, ntok, wn);
                asm volatile("s_waitcnt lgkmcnt(0)" ::: "memory");
                __builtin_amdgcn_s_barrier(); asm volatile("" ::: "memory");
                asm volatile("s_waitcnt vmcnt(0)" ::: "memory");
                __builtin_amdgcn_s_barrier(); asm volatile("" ::: "memory");
            }
            scan_epilogue(a, lds, hw, lane, rbase + (nch - 1) * 64, hh, ntok, wn);
        } else {
            const int w = wave;
            f32x16 S[4];
            if (smp) { const float* sp = a.in[4] + (size_t)sl * HD * HD + 32 * w + r;
#pragma unroll
                for (int dt = 0; dt < 4; ++dt)
#pragma unroll
                    for (int i = 0; i < 16; ++i) S[dt][i] = sp[(size_t)(32 * dt + (i & 3) + 8 * (i >> 2) + 4 * hf) * HD]; }
            else {
#pragma unroll
                for (int dt = 0; dt < 4; ++dt) S[dt] = zero16(); }
            f32x16 un0 = *(const f32x16*)(rec0 + R_U + ((w * 2 + 0) * 64 + lane) * 64), un1 = *(const f32x16*)(rec0 + R_U + ((w * 2 + 1) * 64 + lane) * 64);
            float egn = *(const float*)(rec0 + R_EGL);
            __builtin_amdgcn_s_barrier(); asm volatile("" ::: "memory");
#pragma unroll 1
            for (int n = 0; n < nch; ++n) {
                const unsigned char* op = lds + (n & 1) * R_OPS + lane * 16;
                f32x16 av0 = un0, av1 = un1, ao0 = zero16(), ao1 = zero16();
                const float eg = egn;
                if (n + 1 < nch) { const unsigned char* rn = rec0 + (size_t)(n + 1) * REC;
                    un0 = *(const f32x16*)(rn + R_U + ((w * 2 + 0) * 64 + lane) * 64); un1 = *(const f32x16*)(rn + R_U + ((w * 2 + 1) * 64 + lane) * 64); egn = *(const float*)(rn + R_EGL); }
#pragma unroll
                for (int dt = 0; dt < 4; ++dt)
#pragma unroll
                    for (int s = 0; s < 2; ++s) { const int ks = 2 * dt + s; const bf16x8 B = pack_regs(S[dt], s);
                        av0 = MFMA32(*(const bf16x8*)(op + R_NEGW + (0 * 8 + ks) * 1024), B, av0); av1 = MFMA32(*(const bf16x8*)(op + R_NEGW + (1 * 8 + ks) * 1024), B, av1);
                        ao0 = MFMA32(*(const bf16x8*)(op + R_QG + (0 * 8 + ks) * 1024), B, ao0);   ao1 = MFMA32(*(const bf16x8*)(op + R_QG + (1 * 8 + ks) * 1024), B, ao1); }
#pragma unroll
                for (int dt = 0; dt < 4; ++dt)
#pragma unroll
                    for (int i = 0; i < 16; ++i) S[dt][i] *= eg;
#pragma unroll
                for (int jt = 0; jt < 2; ++jt)
#pragma unroll
                    for (int s = 0; s < 2; ++s) { const int ks = 2 * jt + s; const bf16x8 Bv = pack_regs(jt ? av1 : av0, s);
                        if (jt == 0) ao0 = MFMA32(*(const bf16x8*)(op + R_ATTN + (0 * 4 + ks) * 1024), Bv, ao0);
                        ao1 = MFMA32(*(const bf16x8*)(op + R_ATTN + (1 * 4 + ks) * 1024), Bv, ao1);
#pragma unroll
                        for (int dt = 0; dt < 4; ++dt) S[dt] = MFMA32(*(const bf16x8*)(op + R_KDEC + (dt * 4 + ks) * 1024), Bv, S[dt]); }
                asm volatile("s_waitcnt lgkmcnt(0)" ::: "memory");
                __builtin_amdgcn_s_barrier(); asm volatile("" ::: "memory");
                float* ot = (float*)(lds + OT_OFF) + 32 * w + r;
#pragma unroll
                for (int i = 0; i < 16; ++i) { const int row = (i & 3) + 8 * (i >> 2) + 4 * hf; ot[row * 128] = ao0[i]; ot[(32 + row) * 128] = ao1[i]; }
                asm volatile("s_waitcnt lgkmcnt(0)" ::: "memory");
                __builtin_amdgcn_s_barrier(); asm volatile("" ::: "memory");
            }
            float* so = a.out + (smp ? O_ST_S : O_ST_P) + (size_t)sl * HD * HD + 32 * w + r;
#pragma unroll
            for (int dt = 0; dt < 4; ++dt)
#pragma unroll
                for (int i = 0; i < 16; ++i) so[(size_t)(32 * dt + (i & 3) + 8 * (i >> 2) + 4 * hf) * HD] = S[dt][i];
        }
    }
}

__device__ __forceinline__ void phase6(const Args& a, int G) {
    const int tid = threadIdx.x, lane = tid & 63, wave = tid >> 6;
    const int gw = blockIdx.x * NWAVES + wave, NGW = G * NWAVES;
    const float* outb = (const float*)(a.ws + WS_OUT); const float* ln_post = a.in[13];
    f32x4 lw[4];
#pragma unroll
    for (int i = 0; i < 4; ++i) lw[i] = *((const f32x4*)ln_post + 64 * i + lane);
    for (int r = gw; r < MT; r += NGW) {
        const float* xrow = (r < MP) ? a.in[0] + (size_t)r * D : a.in[1] + (size_t)(r - MP) * D;
        f32x4 v[4], xv[4]; float ss = 0.f;
#pragma unroll
        for (int i = 0; i < 4; ++i) { v[i] = *((const f32x4*)(outb + (size_t)r * D) + 64 * i + lane); xv[i] = *((const f32x4*)xrow + 64 * i + lane);
            ss += (v[i][0] * v[i][0] + v[i][1] * v[i][1]) + (v[i][2] * v[i][2] + v[i][3] * v[i][3]); }
        ss = wave_sum(ss);
        const float rs = 1.0f / sqrtf(ss * (1.0f / D) + RMS_EPS);
#pragma unroll
        for (int i = 0; i < 4; ++i) *((f32x4*)(a.out + O_Y + (size_t)r * D) + 64 * i + lane) = xv[i] + v[i] * rs * lw[i];
    }
}

constexpr int NPHASES = 7;
__global__ void __launch_bounds__(NTHREADS, 2) fwd(Args args) {
    extern __shared__ __attribute__((aligned(16))) unsigned char lds[];
    const int G = gridDim.x;
    const int lo = args.ph_lo, hi = args.ph_hi;
#if ONE_LAUNCH
    cg::grid_group grid = cg::this_grid();
#define SEAM() grid.sync()
#else
#define SEAM() do {} while (0)
#endif
#define IN(k) (lo <= (k) && (k) < hi)
    if (IN(0)) { phase0(args, lds, G); if (IN(1)) SEAM(); }
    if (IN(1)) {
        pg8::Gemm g{(const pg8::bf16_t*)(args.ws + WS_XB), (const pg8::bf16_t*)(args.ws + WS_WB1), MT, NP, D};
        pg8::StaticOrder S; S.init(MT, NP, G, (int)blockIdx.x);
        pg8::EpiProj E{(pg8::bf16_t*)(args.ws + WS_PA), (pg8::bf16_t*)(args.ws + WS_PQ), (pg8::bf16_t*)(args.ws + WS_ZG), (const float*)(args.ws + WS_RSTD)};
        pg8::gemm_phase<pg8::EpiProj, pg8::StaticOrder, true, true>((LAS unsigned char*)lds, g, S, E);
        if (IN(2)) SEAM();
    }
    if (IN(2)) { phase2(args, G); if (IN(3)) SEAM(); }
    if (IN(3)) { phase3(args, lds, G); if (IN(4)) SEAM(); }
    if (IN(4)) { phase4(args, lds, G); if (IN(5)) SEAM(); }
    if (IN(5)) {
        pg8::Gemm g{(const pg8::bf16_t*)(args.ws + WS_XB), (const pg8::bf16_t*)(args.ws + WS_WB2), MT, D, D};
        pg8::StaticOrder S; S.init(MT, D, G, (int)blockIdx.x);
        pg8::EpiF32 E{(float*)(args.ws + WS_OUT), D};
        pg8::gemm_phase<pg8::EpiF32, pg8::StaticOrder, true, true>((LAS unsigned char*)lds, g, S, E);
        if (IN(6)) SEAM();
    }
    if (IN(6)) { phase6(args, G); }
#undef IN
}

extern "C" void kernel_launch(void* const* d_in, const int* in_sizes, int n_in, void* d_out, int out_size, void* d_ws, size_t ws_size, hipStream_t stream) {
    static int grid = 0;
    if (grid == 0) {
        if (n_in != 14 || in_sizes[0] != MP * D || (size_t)out_size != O_END || ws_size < WS_END) {
            fprintf(stderr, "kernel_launch: unexpected shapes: n_in %d in0 %d out %d (want %zu) ws %zu (want >= %zu)\n", n_in, n_in > 0 ? in_sizes[0] : -1, out_size, (size_t)O_END, ws_size, (size_t)WS_END); grid = -1; return; }
        int dev = 0, cus = 0, per_cu = 0;
        (void)hipGetDevice(&dev); (void)hipDeviceGetAttribute(&cus, hipDeviceAttributeMultiprocessorCount, dev);
        if (hipFuncSetAttribute((const void*)fwd, hipFuncAttributeMaxDynamicSharedMemorySize, LDS_BYTES) != hipSuccess) { fprintf(stderr, "kernel_launch: hipFuncSetAttribute failed\n"); grid = -1; return; }
        (void)hipOccupancyMaxActiveBlocksPerMultiprocessor(&per_cu, (const void*)fwd, NTHREADS, LDS_BYTES);
        if (per_cu < 1) { fprintf(stderr, "kernel_launch: occupancy query says %d blocks per CU\n", per_cu); per_cu = 1; }
        (void)hipGetLastError();
        grid = cus * 1;
        fprintf(stderr, "kernel_launch: cus %d per_cu %d grid %d\n", cus, per_cu, grid);
    }
    if (grid < 0) return;
    Args a{};
    for (int i = 0; i < 14; ++i) a.in[i] = (const float*)d_in[i];
    a.out = (float*)d_out; a.ws = (unsigned char*)d_ws;
#if ONE_LAUNCH
    a.ph_lo = 0; a.ph_hi = NPHASES;
    void* kargs[] = {&a};
    hipError_t e = hipLaunchCooperativeKernel((const void*)fwd, dim3(grid), dim3(NTHREADS), kargs, LDS_BYTES, stream);
    if (e != hipSuccess) fprintf(stderr, "kernel_launch: cooperative launch failed: %s (grid %d)\n", hipGetErrorString(e), grid);
#else
    for (int p = 0; p < NPHASES; ++p) { a.ph_lo = p; a.ph_hi = p + 1;
        hipLaunchKernelGGL(fwd, dim3(grid), dim3(NTHREADS), LDS_BYTES, stream, a);
        const hipError_t le = hipPeekAtLastError();
        if (le != hipSuccess) { fprintf(stderr, "kernel_launch: launch %d failed: %s\n", p, hipGetErrorName(le)); break; } }
#endif
}
```

```cpp
#include <hip/hip_runtime.h>
#include <hip/hip_cooperative_groups.h>
#include <cstdio>
#include <cstdint>
namespace cg = cooperative_groups;
#ifndef ONE_LAUNCH
#define ONE_LAUNCH 1
#define REP_PHASE -1
#define P3REP_SUB 1
#define P3REP_56 1
#endif
namespace pg8 {
#define PG8_LAS __attribute__((address_space(3)))
typedef unsigned short bf16_t;
typedef short bf16x8 __attribute__((ext_vector_type(8)));
typedef float f32x4 __attribute__((ext_vector_type(4)));
typedef unsigned u32x4 __attribute__((ext_vector_type(4)));
constexpr int BM = 256, BK = 64, HALF = 128, HTB = HALF * BK * 2  , STAGE_BYTES = 8 * HTB, NXCD = 8, WGM = 8;

__host__ __device__ __forceinline__ int lds_byte(int r, int c) { const int st = (r >> 4) * 2 + (c >> 5), rr = r & 15, cc = c & 31, ob = rr * 64 + cc * 2; return st * 1024 + (ob ^ (((ob >> 9) & 1) << 5)); }
__host__ __device__ __forceinline__ void stage_rc(int b, int& R, int& C) { const int st = b / 1024, sb = b % 1024, swz = sb ^ (((sb >> 9) & 1) << 5); R = (st >> 1) * 16 + swz / 64; C = (st & 1) * 32 + (swz % 64) / 2; }
__host__ __device__ __forceinline__ int perm32(int rho) { const int n = rho >> 4, i = rho & 15; return 8 * (i >> 2) + 4 * n + (i & 3); }

struct Unit { int pm, pn; };
struct Gemm { const bf16_t* A; const bf16_t* Bt; int M, N, K; };

struct StaticOrder {
    int nM, nN, nwg, G, c;
    __host__ __device__ void init(int M, int N, int G_, int c_) { nM = M / BM; nN = N / BM; nwg = nM * nN; G = G_; c = c_; }
    __host__ __device__ bool next(int i, Unit& u) const {
        const long L = (long)i * G + c; if (L >= nwg) return false;
        int wgid = (int)L; { const int q = nwg / NXCD, r = nwg % NXCD, xcd = wgid % NXCD, off = wgid / NXCD; wgid = (xcd < r ? xcd * (q + 1) : r * (q + 1) + (xcd - r) * q) + off; }
        const int nig = WGM * nN, gid = wgid / nig, fm = gid * WGM, gsz = (nM - fm) < WGM ? (nM - fm) : WGM;
        u.pm = fm + ((wgid % nig) % gsz); u.pn = (wgid % nig) / gsz; return true;
    }
    __device__ __forceinline__ void a_ready(const Unit&) const {}
    __device__ __forceinline__ void done(const Unit&) const {}
};
__device__ __forceinline__ unsigned cvt_pk_bf16(float lo, float hi) { unsigned r; asm volatile("v_cvt_pk_bf16_f32 %0, %1, %2" : "=v"(r) : "v"(lo), "v"(hi)); return r; }

struct EpiProj {
    static constexpr bool PERM = true, AFTER_DRAIN = false;
    bf16_t* OA; bf16_t* OQ; bf16_t* OZ; const float* rstd;
    __device__ __forceinline__ void operator()(const f32x4 (&acc)[2][2][4][2], const Unit& u, int wr, int wc, int fr, int fq) const {
        const int row0 = u.pm * BM + wr * 64 + fr; int colt = u.pn * BM; bf16_t* base; int ldc;
        if (colt < 2048) { base = OA; ldc = 2048; } else if (colt < 3584) { base = OQ; ldc = 1536; colt -= 2048; } else { base = OZ; ldc = 512; colt -= 3584; }
        const int col0 = colt + wc * 32 + 8 * fq;
#pragma unroll
        for (int ai = 0; ai < 2; ++ai)
#pragma unroll
            for (int m = 0; m < 4; ++m) { const int r = row0 + ai * HALF + m * 16; const float sc = rstd[r]; bf16_t* rowp = base + (size_t)r * ldc + col0;
#pragma unroll
                for (int bj = 0; bj < 2; ++bj) { const f32x4 v0 = acc[ai][bj][m][0] * sc, v1 = acc[ai][bj][m][1] * sc;
                    u32x4 w; w.x = cvt_pk_bf16(v0[0], v0[1]); w.y = cvt_pk_bf16(v0[2], v0[3]); w.z = cvt_pk_bf16(v1[0], v1[1]); w.w = cvt_pk_bf16(v1[2], v1[3]);
                    *(u32x4*)(rowp + bj * HALF) = w; } }
    }
};
struct EpiF32 {
    static constexpr bool PERM = false, AFTER_DRAIN = false;
    float* C; int ldc;
    __device__ __forceinline__ void operator()(const f32x4 (&acc)[2][2][4][2], const Unit& u, int wr, int wc, int fr, int fq) const {
        const int row0 = u.pm * BM + wr * 64 + fr, col0 = u.pn * BM + wc * 32 + 4 * fq;
#pragma unroll
        for (int ai = 0; ai < 2; ++ai)
#pragma unroll
            for (int m = 0; m < 4; ++m) { float* rowp = C + (size_t)(row0 + ai * HALF + m * 16) * ldc + col0;
#pragma unroll
                for (int bj = 0; bj < 2; ++bj)
#pragma unroll
                    for (int n = 0; n < 2; ++n) *(f32x4*)(rowp + bj * HALF + n * 16) = acc[ai][bj][m][n]; }
    }
};
template <class Epi, class Sched, bool ALIGN_EPI = false, bool SP2 = false>
__device__ __forceinline__ void gemm_phase(PG8_LAS unsigned char* lds, const Gemm g, const Sched& S, const Epi& E) {
    const int tid = threadIdx.x, wid = __builtin_amdgcn_readfirstlane(tid >> 6), lane = tid & 63, wr = wid >> 2, wc = wid & 3, fr = lane & 15, fq = lane >> 4;
    const int K = g.K, nt = K / BK;
    unsigned voffA[2], voffB[2];
#pragma unroll
    for (int i = 0; i < 2; ++i) { int R, C; stage_rc(tid * 16 + i * 8192, R, C); const int Rb = Epi::PERM ? ((R & ~31) + perm32(R & 31)) : R;
        voffA[i] = (unsigned)(R * K + C) * 2u; voffB[i] = (unsigned)(Rb * K + C) * 2u; }
    const size_t kstep = (size_t)(BK * 2);
    const size_t hstep = (size_t)HALF * K * 2;
    const size_t tstep = 2 * hstep;
    const unsigned ldsw = (unsigned)wid * 1024u;
    const int aoff = lds_byte(wr * 64 + fr, fq * 8), boff = lds_byte(wc * 32 + fr, fq * 8);
#define PG8_SA(b, h) (((b) * 2 + (h)) * HTB)
#define PG8_SB(b, h) ((4 + (b) * 2 + (h)) * HTB)
#define PG8_STAGE(bufoff, gbase, voff) do { _Pragma("unroll") for (int _i = 0; _i < 2; ++_i) \
        __builtin_amdgcn_global_load_lds((const unsigned*)((const char*)(gbase) + (voff)[_i]), (PG8_LAS unsigned*)(lds + (bufoff) + ldsw + _i * 8192), 16, 0, 0); } while (0)
#define PG8_LDA(dst, b, h) do { _Pragma("unroll") for (int m = 0; m < 4; ++m) _Pragma("unroll") for (int k = 0; k < 2; ++k) dst[m][k] = *(const PG8_LAS bf16x8*)(lds + PG8_SA(b, h) + aoff + m * 2048 + k * 1024); } while (0)
#define PG8_LDB(dst, b, h) do { _Pragma("unroll") for (int n = 0; n < 2; ++n) _Pragma("unroll") for (int k = 0; k < 2; ++k) dst[n][k] = *(const PG8_LAS bf16x8*)(lds + PG8_SB(b, h) + boff + n * 2048 + k * 1024); } while (0)
#define PG8_MMA(ai, bj, At, Bt) do { __builtin_amdgcn_s_setprio(1); _Pragma("unroll") for (int m = 0; m < 4; ++m) _Pragma("unroll") for (int n = 0; n < 2; ++n) _Pragma("unroll") for (int k = 0; k < 2; ++k) \
        acc[ai][bj][m][n] = __builtin_amdgcn_mfma_f32_16x16x32_bf16(Bt[n][k], At[m][k], acc[ai][bj][m][n], 0, 0, 0); __builtin_amdgcn_s_setprio(0); } while (0)
#define PG8_WAIT_V(n) asm volatile("s_waitcnt vmcnt(" #n ")" ::: "memory")
#define PG8_WAIT_L(n) asm volatile("s_waitcnt lgkmcnt(" #n ")" ::: "memory")
#define PG8_BAR __builtin_amdgcn_s_barrier()
#define PG8_SCHED __builtin_amdgcn_sched_barrier(0)
    Unit cur, nxt; int ui = 0;
    if (!S.next(0, cur)) return;
    f32x4 acc[2][2][4][2];
#pragma unroll
    for (int a = 0; a < 2; ++a)
#pragma unroll
        for (int b = 0; b < 2; ++b)
#pragma unroll
            for (int m = 0; m < 4; ++m)
#pragma unroll
                for (int n = 0; n < 2; ++n) acc[a][b][m][n] = (f32x4){0.f, 0.f, 0.f, 0.f};
    bf16x8 At[4][2], B0[2][2], B1[2][2];
    const char* cA = (const char*)g.A + (size_t)cur.pm * tstep; const char* cB = (const char*)g.Bt + (size_t)cur.pn * tstep;
    S.a_ready(cur);
    if constexpr (SP2) {
        PG8_STAGE(PG8_SB(0, 0), cB, voffB); PG8_STAGE(PG8_SB(0, 1), cB + hstep, voffB); PG8_STAGE(PG8_SA(0, 0), cA, voffA); PG8_STAGE(PG8_SA(0, 1), cA + hstep, voffA);
        if (wr == 1) PG8_BAR;
        PG8_WAIT_V(2); PG8_BAR;
        PG8_STAGE(PG8_SB(1, 0), cB + kstep, voffB); PG8_STAGE(PG8_SA(1, 0), cA + kstep, voffA); PG8_STAGE(PG8_SB(1, 1), cB + hstep + kstep, voffB);
        PG8_WAIT_V(6); PG8_BAR;
    } else {
        PG8_STAGE(PG8_SB(0, 0), cB, voffB); PG8_STAGE(PG8_SA(0, 0), cA, voffA); PG8_STAGE(PG8_SB(0, 1), cB + hstep, voffB); PG8_STAGE(PG8_SA(0, 1), cA + hstep, voffA);
        if (wr == 1) PG8_BAR;
        PG8_WAIT_V(4); PG8_BAR;
        PG8_STAGE(PG8_SB(1, 0), cB + kstep, voffB); PG8_STAGE(PG8_SA(1, 0), cA + kstep, voffA); PG8_STAGE(PG8_SB(1, 1), cB + hstep + kstep, voffB);
        PG8_WAIT_V(6); PG8_BAR;
    }
    for (;;) {
        const bool has_next = S.next(ui + 1, nxt);
        const char* nA = has_next ? (const char*)g.A + (size_t)nxt.pm * tstep : cA; const char* nB = has_next ? (const char*)g.Bt + (size_t)nxt.pn * tstep : cB;
        for (int t = 0; t < nt; t += 2) {
            const bool last = (t == nt - 2);
            const char* a1 = cA + (size_t)(t + 1) * kstep;
            const char* a2 = last ? nA : cA + (size_t)(t + 2) * kstep; const char* b2 = last ? nB : cB + (size_t)(t + 2) * kstep;
            const char* a3 = a2 + kstep; const char* b3 = b2 + kstep;
            if (last && has_next) S.a_ready(nxt);
            if constexpr (SP2) {
            PG8_LDB(B0, 0, 0); PG8_LDB(B1, 0, 1); PG8_SCHED; PG8_LDA(At, 0, 0); PG8_STAGE(PG8_SA(1, 1), a1 + hstep, voffA);
            PG8_WAIT_V(8); PG8_WAIT_L(0); PG8_BAR; PG8_MMA(0, 0, At, B0); PG8_MMA(0, 1, At, B1); PG8_BAR; PG8_SCHED;
            PG8_LDA(At, 0, 1); PG8_STAGE(PG8_SB(0, 0), b2, voffB); PG8_STAGE(PG8_SB(0, 1), b2 + hstep, voffB); PG8_STAGE(PG8_SA(0, 0), a2, voffA);
            PG8_WAIT_V(8); PG8_WAIT_L(0); PG8_BAR; PG8_MMA(1, 0, At, B0); PG8_MMA(1, 1, At, B1); PG8_BAR; PG8_SCHED;
            PG8_LDB(B0, 1, 0); PG8_LDB(B1, 1, 1); PG8_SCHED; PG8_LDA(At, 1, 0); PG8_STAGE(PG8_SA(0, 1), a2 + hstep, voffA);
            PG8_WAIT_V(8); PG8_WAIT_L(0); PG8_BAR; PG8_MMA(0, 0, At, B0); PG8_MMA(0, 1, At, B1); PG8_BAR; PG8_SCHED;
            PG8_LDA(At, 1, 1); PG8_STAGE(PG8_SB(1, 0), b3, voffB); PG8_STAGE(PG8_SB(1, 1), b3 + hstep, voffB); PG8_STAGE(PG8_SA(1, 0), a3, voffA);
            PG8_WAIT_V(8); PG8_WAIT_L(0); PG8_BAR; PG8_MMA(1, 0, At, B0); PG8_MMA(1, 1, At, B1); PG8_BAR; PG8_SCHED;
            } else {
            PG8_LDB(B0, 0, 0); PG8_SCHED; PG8_LDA(At, 0, 0); PG8_STAGE(PG8_SA(1, 1), a1 + hstep, voffA);
            PG8_WAIT_L(8); PG8_BAR; PG8_WAIT_L(0); PG8_MMA(0, 0, At, B0); PG8_BAR; PG8_SCHED;
            PG8_LDB(B1, 0, 1); PG8_STAGE(PG8_SB(0, 0), b2, voffB);
            PG8_BAR; PG8_WAIT_L(0); PG8_MMA(0, 1, At, B1); PG8_BAR;
            PG8_LDA(At, 0, 1); PG8_STAGE(PG8_SA(0, 0), a2, voffA);
            PG8_BAR; PG8_WAIT_L(0); PG8_MMA(1, 0, At, B0); PG8_BAR; PG8_SCHED;
            PG8_STAGE(PG8_SB(0, 1), b2 + hstep, voffB);
            PG8_WAIT_V(6); PG8_BAR; PG8_MMA(1, 1, At, B1); PG8_BAR;
            PG8_LDB(B0, 1, 0); PG8_SCHED; PG8_LDA(At, 1, 0); PG8_STAGE(PG8_SA(0, 1), a2 + hstep, voffA);
            PG8_WAIT_L(8); PG8_BAR; PG8_WAIT_L(0); PG8_MMA(0, 0, At, B0); PG8_BAR; PG8_SCHED;
            PG8_LDB(B1, 1, 1); PG8_STAGE(PG8_SB(1, 0), b3, voffB);
            PG8_BAR; PG8_WAIT_L(0); PG8_MMA(0, 1, At, B1); PG8_BAR;
            PG8_LDA(At, 1, 1); PG8_STAGE(PG8_SA(1, 0), a3, voffA);
            PG8_BAR; PG8_WAIT_L(0); PG8_MMA(1, 0, At, B0); PG8_BAR; PG8_SCHED;
            PG8_STAGE(PG8_SB(1, 1), b3 + hstep, voffB);
            PG8_WAIT_V(6); PG8_BAR; PG8_MMA(1, 1, At, B1); PG8_BAR;
            }
        }
        if constexpr (ALIGN_EPI) { if (wr == 0) PG8_BAR; }
        if constexpr (!Epi::AFTER_DRAIN) { E(acc, cur, wr, wc, fr, fq); S.done(cur); }
        if (!has_next) break;
#pragma unroll
        for (int a = 0; a < 2; ++a)
#pragma unroll
            for (int b = 0; b < 2; ++b)
#pragma unroll
                for (int m = 0; m < 4; ++m)
#pragma unroll
                    for (int n = 0; n < 2; ++n) acc[a][b][m][n] = (f32x4){0.f, 0.f, 0.f, 0.f};
        cur = nxt; cA = nA; cB = nB; ++ui;
        if constexpr (ALIGN_EPI) { if (wr == 1) PG8_BAR; }
    }
    PG8_WAIT_V(0);
    if constexpr (!ALIGN_EPI) { if (wr == 0) PG8_BAR; }
    PG8_BAR;
    if constexpr (Epi::AFTER_DRAIN) { E.fused(acc, cur, wr, wc, fr, fq, lds, wid, lane); S.done(cur); }
#undef PG8_SA
#undef PG8_SB
#undef PG8_STAGE
#undef PG8_LDA
#undef PG8_LDB
#undef PG8_MMA
#undef PG8_WAIT_V
#undef PG8_WAIT_L
#undef PG8_BAR
#undef PG8_SCHED
}
}

#define LAS __attribute__((address_space(3)))
typedef unsigned short bf16;
typedef unsigned v4u __attribute__((ext_vector_type(4)));
typedef unsigned v2u __attribute__((ext_vector_type(2)));
typedef float f32x4 __attribute__((ext_vector_type(4)));

constexpr int D = 1024, MP = 16 * 4096, MS = 32 * 32, MT = MP + MS, SEQ = 4096, DSEQ = 32, NB = 16, NBS = 32;
constexpr int NPROJ = 4104, NP = 4096, DC = 512, DQKV = 1536, NH = 4, HD = 128;
constexpr int C_BA = 0, C_CA = 512, C_XA = 1024, C_ZA = 1536, C_QKV = 2048, C_ZG = 3584;
constexpr float RMS_EPS = 1e-6f, L2_EPS = 1e-6f;
constexpr int NWAVES = 8, NTHREADS = 512;
constexpr int LDS_PHASE = 144 * 1024;
constexpr int LDS_BYTES = LDS_PHASE + 256;

constexpr size_t O_Y = 0;
constexpr size_t O_CA_P = (size_t)MT * D;
constexpr size_t O_CQ_P = O_CA_P + 16 * 2 * 512;
constexpr size_t O_ST_P = O_CQ_P + 16 * 3 * 1536;
constexpr size_t O_CA_S = O_ST_P + (size_t)16 * 4 * 128 * 128;
constexpr size_t O_CQ_S = O_CA_S + 32 * 2 * 512;
constexpr size_t O_ST_S = O_CQ_S + 32 * 3 * 1536;
constexpr size_t O_END = O_ST_S + (size_t)32 * 4 * 128 * 128;

constexpr int NCH = NB * NH * 64 + NBS * NH;
constexpr int REC = 90368;
constexpr int R_NEGW = 0, R_QG = 16384, R_ATTN = 32768, R_KDEC = 40960, R_U = 57344, R_EGL = 90112, R_OPS = 57344;
constexpr size_t WS_XB = 0;
constexpr size_t WS_ZG = WS_XB + (size_t)MT * D * 2;
constexpr size_t WS_PA = WS_ZG + (size_t)MT * 512 * 2;
constexpr size_t WS_PQ = WS_PA + (size_t)MT * 2048 * 2;
constexpr size_t WS_QKR = WS_PQ + (size_t)MT * DQKV * 2;
constexpr size_t WS_KVT = WS_QKR + (size_t)MT * 1024 * 2;
constexpr size_t WS_WB1 = WS_KVT + (size_t)NCH * 32768;
constexpr size_t WS_WB2 = WS_WB1 + (size_t)NP * D * 2;
constexpr size_t WS_RSTD = WS_WB2 + (size_t)D * D * 2;
constexpr size_t WS_AB = WS_RSTD + (size_t)MT * 4;
constexpr size_t WS_GB = WS_AB + (size_t)MT * 8 * 4;
constexpr size_t WS_BAR = WS_GB + (size_t)MT * 8 * 4;
constexpr size_t WS_END = WS_BAR + 16384;
constexpr size_t WS_PREP = WS_PA, WS_OUT = WS_PA;
static_assert(WS_PREP + (size_t)NCH * REC <= WS_QKR, "PREP must fit in the dead projection regions");
static_assert(WS_END <= ((size_t)1 << 30), "workspace map exceeds 1 GiB");

struct Args { const float* in[14]; float* out; unsigned char* ws; int ph_lo, ph_hi; };

__device__ __forceinline__ unsigned f2bf(float f) { unsigned u = __builtin_bit_cast(unsigned, f); return (u + 0x7fffu + ((u >> 16) & 1u)) >> 16; }
typedef float f32x2_t __attribute__((ext_vector_type(2)));
typedef __bf16 bf16x2_t __attribute__((ext_vector_type(2)));
__device__ __forceinline__ unsigned pk2(float lo, float hi) { const f32x2_t v = {lo, hi}; return __builtin_bit_cast(unsigned, __builtin_convertvector(v, bf16x2_t)); }
__device__ __forceinline__ float bflo(unsigned w) { return __builtin_bit_cast(float, w << 16); }
__device__ __forceinline__ float bfhi(unsigned w) { return __builtin_bit_cast(float, w & 0xffff0000u); }
__device__ __forceinline__ void unpack8(const v4u w, float (&f)[8]) { f[0] = bflo(w.x); f[1] = bfhi(w.x); f[2] = bflo(w.y); f[3] = bfhi(w.y); f[4] = bflo(w.z); f[5] = bfhi(w.z); f[6] = bflo(w.w); f[7] = bfhi(w.w); }
__device__ __forceinline__ v4u pack8(const float (&f)[8]) { v4u w; w.x = pk2(f[0], f[1]); w.y = pk2(f[2], f[3]); w.z = pk2(f[4], f[5]); w.w = pk2(f[6], f[7]); return w; }
__device__ __forceinline__ float wave_sum(float v) {
#pragma unroll
    for (int o = 1; o < 64; o <<= 1) v += __shfl_xor(v, o);
    return v;
}
__device__ __forceinline__ float silu_f(float x) { return x * __builtin_amdgcn_rcpf(1.0f + __expf(-x)); }
__device__ __forceinline__ float sigmoid_f(float x) { return 1.0f / (1.0f + expf(-x)); }
__device__ __forceinline__ float softplus_f(float x) { return x > 20.f ? x : log1pf(expf(x)); }

__device__ __forceinline__ void p0_transpose_item(const float* W, int K, int ldw, int N, const float* sc, bf16* WT, float* scr, int item, int lane) {
    const int nblk = N / 32, kb = item / nblk, nb = item % nblk, k0 = 64 * kb, n0 = 32 * nb;
#pragma unroll 8
    for (int i = 0; i < 32; ++i) { const int kk = 2 * i + (lane >> 5); const float s = sc ? sc[k0 + kk] : 1.0f; scr[kk * 33 + (lane & 31)] = W[(size_t)(k0 + kk) * ldw + n0 + (lane & 31)] * s; }
    asm volatile("s_waitcnt lgkmcnt(0)" ::: "memory");
    const int c = lane & 7;
#pragma unroll
    for (int j = 0; j < 4; ++j) { const int n = (lane >> 3) + 8 * j; const float* s = scr + (8 * c) * 33 + n;
        v4u o; o.x = pk2(s[0 * 33], s[1 * 33]); o.y = pk2(s[2 * 33], s[3 * 33]); o.z = pk2(s[4 * 33], s[5 * 33]); o.w = pk2(s[6 * 33], s[7 * 33]);
        *(v4u*)(WT + (size_t)(n0 + n) * K + k0 + 8 * c) = o; }
    asm volatile("s_waitcnt lgkmcnt(0)" ::: "memory");
}
__device__ __forceinline__ void phase0(const Args& a, unsigned char* lds, int G) {
    const int tid = threadIdx.x, lane = tid & 63, wave = tid >> 6;
    const int gw = blockIdx.x * NWAVES + wave, NGW = G * NWAVES;
    unsigned char* ws = a.ws;
    const float* ln_pre = a.in[5]; const float* w_in = a.in[6]; const float* w_out = a.in[12];
    float* scr = (float*)(lds + wave * 16384);
    constexpr int I1 = (D / 64) * (NP / 32), I2 = (D / 64) * (D / 32);
    for (int it = gw; it < I1 + I2; it += NGW) {
        if (it < I1) p0_transpose_item(w_in, D, NPROJ, NP, ln_pre, (bf16*)(ws + WS_WB1), scr, it, lane);
        else p0_transpose_item(w_out, D, D, D, nullptr, (bf16*)(ws + WS_WB2), scr, it - I1, lane);
    }
    float wx[4][4][8];
#pragma unroll
    for (int i = 0; i < 4; ++i)
#pragma unroll
        for (int c = 0; c < 4; ++c) { const int k = 256 * i + 4 * lane + c; const float s = ln_pre[k];
            const f32x4 w0 = *(const f32x4*)(w_in + (size_t)k * NPROJ + NP), w1 = *(const f32x4*)(w_in + (size_t)k * NPROJ + NP + 4);
#pragma unroll
            for (int j = 0; j < 4; ++j) { wx[i][c][j] = w0[j] * s; wx[i][c][4 + j] = w1[j] * s; } }
    float* rstd = (float*)(ws + WS_RSTD); float* ab = (float*)(ws + WS_AB); bf16* xb = (bf16*)(ws + WS_XB);
    for (int r = gw; r < MT; r += NGW) {
        const float* xrow = (r < MP) ? a.in[0] + (size_t)r * D : a.in[1] + (size_t)(r - MP) * D;
        f32x4 v[4]; float ss = 0.f; float dot[8];
#pragma unroll
        for (int j = 0; j < 8; ++j) dot[j] = 0.f;
#pragma unroll
        for (int i = 0; i < 4; ++i) { v[i] = *((const f32x4*)xrow + 64 * i + lane);
#pragma unroll
            for (int c = 0; c < 4; ++c) { ss += v[i][c] * v[i][c];
#pragma unroll
                for (int j = 0; j < 8; ++j) dot[j] += v[i][c] * wx[i][c][j]; } }
        ss = wave_sum(ss);
#pragma unroll
        for (int j = 0; j < 8; ++j) dot[j] = wave_sum(dot[j]);
        const float rs = 1.0f / sqrtf(ss * (1.0f / D) + RMS_EPS);
        unsigned long long* o8 = (unsigned long long*)(xb + (size_t)r * D) + lane;
#pragma unroll
        for (int i = 0; i < 4; ++i) o8[64 * i] = (unsigned long long)pk2(v[i][0], v[i][1]) | ((unsigned long long)pk2(v[i][2], v[i][3]) << 32);
        if (lane == 0) rstd[r] = rs;
        if (lane < 8) { float d = dot[0];
#pragma unroll
            for (int j = 1; j < 8; ++j) d = (lane == j) ? dot[j] : d;
            ab[(size_t)r * 8 + lane] = d * rs; }
    }
}

#define XB_TMO      128
#define XB_XCNT(j)  (256  + 64 * (j))
#define XB_XSUB(j)  (1280 + 64 * (j))
#define XB_XGEN(j)  (2304 + 64 * (j))
#define XB_TOP      3328
#define XB_TOPGEN   3392
#define XCD_BAR_WORDS 3456
#define XB_SPIN_CAP (1u << 18)

__device__ __forceinline__ unsigned xb_ld(unsigned* p)              { return __hip_atomic_load(p, __ATOMIC_RELAXED, __HIP_MEMORY_SCOPE_AGENT); }
__device__ __forceinline__ unsigned xb_add(unsigned* p, unsigned v) { return __hip_atomic_fetch_add(p, v, __ATOMIC_RELAXED, __HIP_MEMORY_SCOPE_AGENT); }
__device__ __forceinline__ unsigned xb_xcc_id() { return (unsigned)__builtin_amdgcn_s_getreg((3 << 11) | 20) & 0xFu; }
#define XB_SPIN(cond, bar) do { unsigned _sp = 0; while (cond) { __builtin_amdgcn_s_sleep(1); \
    if ((++_sp & 255u) == 0u) { if (xb_ld(&(bar)[XB_TMO])) break; if (_sp > XB_SPIN_CAP) { atomicAdd(&(bar)[XB_TMO], 1u); break; } } } } while (0)
struct XcdBarrier {
    unsigned* bar; unsigned x;
    volatile LAS unsigned* st;
};

__device__ __forceinline__ XcdBarrier xcd_barrier_post(unsigned* bar, volatile LAS unsigned* st) {
    XcdBarrier b; b.bar = bar; b.x = xb_xcc_id(); b.st = st;
    if (threadIdx.x == 0) (void)xb_add(&bar[XB_XCNT(b.x)], 1u);
    return b;
}
__device__ __forceinline__ void xcd_barrier_complete(unsigned* bar, unsigned x, unsigned& nloc, unsigned& nx) {
    const unsigned G = gridDim.x * gridDim.y * gridDim.z;
    unsigned sum, cnt, mine, sp = 0u;
    for (;;) {
        sum = 0u; cnt = 0u; mine = 0u;
#pragma unroll
        for (unsigned j = 0; j < 16; ++j) { const unsigned c = xb_ld(&bar[XB_XCNT(j)]); sum += c; cnt += (c > 0u) ? 1u : 0u; mine = (j == x) ? c : mine; }
        if (sum == G) break;
        __builtin_amdgcn_s_sleep(1);
        if ((++sp & 255u) == 0u) { if (xb_ld(&bar[XB_TMO])) break; if (sp > XB_SPIN_CAP) { atomicAdd(&bar[XB_TMO], 1u); break; } }
    }
    nloc = mine > 0u ? mine : 1u; nx = cnt > 0u ? cnt : 1u;
}

__device__ __forceinline__ void xcd_barrier(const XcdBarrier& b) {
    asm volatile("s_waitcnt vmcnt(0)" ::: "memory");
    __syncthreads();
    if (threadIdx.x == 0) {
        unsigned* bar = b.bar;
        __builtin_amdgcn_s_waitcnt(0);
        unsigned nloc = b.st[0], nx = b.st[1];
        if (nloc == 0u) { xcd_barrier_complete(bar, b.x, nloc, nx); b.st[0] = nloc; b.st[1] = nx; }
        const unsigned old = xb_add(&bar[XB_XSUB(b.x)], 1u);
        const unsigned gen = old / nloc;
        if (old + 1u == (gen + 1u) * nloc) {
            __builtin_amdgcn_fence(__ATOMIC_RELEASE, "agent");
            asm volatile("s_waitcnt vmcnt(0)" ::: "memory");
            const unsigned og = xb_add(&bar[XB_TOP], 1u);
            const unsigned tg = og / nx;
            if (og + 1u == (tg + 1u) * nx) xb_add(&bar[XB_TOPGEN], 1u);
            else XB_SPIN(xb_ld(&bar[XB_TOPGEN]) == tg, bar);
            __builtin_amdgcn_fence(__ATOMIC_ACQUIRE, "agent");
            xb_add(&bar[XB_XGEN(b.x)], 1u);
            asm volatile("s_waitcnt vmcnt(0)" ::: "memory");
        } else {
            XB_SPIN(xb_ld(&bar[XB_XGEN(b.x)]) == gen, bar);
            __builtin_amdgcn_fence(__ATOMIC_ACQUIRE, "agent");
            asm volatile("s_waitcnt vmcnt(0)" ::: "memory");
        }
    }
    __syncthreads();
}

__device__ __forceinline__ void phase2(const Args& a, int G) {
    const int tid = threadIdx.x, lane = tid & 63, wave = tid >> 6;
    const int gw = blockIdx.x * NWAVES + wave, NGW = G * NWAVES;
    unsigned char* ws = a.ws;
    const bf16* pa = (const bf16*)(ws + WS_PA); const bf16* pq = (const bf16*)(ws + WS_PQ);
    bf16* mix = (bf16*)(ws + WS_XB); bf16* qkr = (bf16*)(ws + WS_QKR); bf16* kvt = (bf16*)(ws + WS_KVT);
    const float* ab = (const float*)(ws + WS_AB); float* gbv = (float*)(ws + WS_GB);
    const float* cache_a = a.in[2]; const float* cache_q = a.in[3]; const float* cw_a = a.in[7]; const float* cw_q = a.in[8];
    const float* a_log = a.in[9]; const float* dt_bias = a.in[10];
    float* out = a.out;
    const int c8 = 8 * lane;
    const int hh = lane >> 4, dl = 8 * (lane & 15);
    constexpr int RB = 8;
    for (int blk = gw; blk < MT / RB; blk += NGW) {
        const int r0 = blk * RB;
        const bool smp = r0 >= MP;
        const int b = smp ? (r0 - MP) / DSEQ : r0 / SEQ;
        const int t0 = smp ? (r0 - MP) % DSEQ : r0 % SEQ;
        const int T = smp ? DSEQ : SEQ;
        {
            float w[3][8];
#pragma unroll
            for (int j = 0; j < 3; ++j) { const f32x4 x0 = *(const f32x4*)(cw_a + j * DC + c8), x1 = *(const f32x4*)(cw_a + j * DC + c8 + 4);
#pragma unroll
                for (int c = 0; c < 4; ++c) { w[j][c] = x0[c]; w[j][4 + c] = x1[c]; } }
            float um2[8], um1[8];
            if (t0 == 0) {
                if (smp) { const float* cp = cache_a + (size_t)b * 2 * DC + c8;
#pragma unroll
                    for (int c = 0; c < 8; ++c) { um2[c] = cp[c]; um1[c] = cp[DC + c]; } }
                else {
#pragma unroll
                    for (int c = 0; c < 8; ++c) { um2[c] = 0.f; um1[c] = 0.f; } }
            } else {
                float ca[8], xa[8];
                unpack8(*(const v4u*)(pa + (size_t)(r0 - 2) * 2048 + C_CA + c8), ca); unpack8(*(const v4u*)(pa + (size_t)(r0 - 2) * 2048 + C_XA + c8), xa);
#pragma unroll
                for (int c = 0; c < 8; ++c) um2[c] = ca[c] * xa[c];
                unpack8(*(const v4u*)(pa + (size_t)(r0 - 1) * 2048 + C_CA + c8), ca); unpack8(*(const v4u*)(pa + (size_t)(r0 - 1) * 2048 + C_XA + c8), xa);
#pragma unroll
                for (int c = 0; c < 8; ++c) um1[c] = ca[c] * xa[c];
            }
#pragma unroll 2
            for (int i = 0; i < RB; ++i) {
                const int r = r0 + i, t = t0 + i;
                const bf16* pr = pa + (size_t)r * 2048 + c8;
                float ba[8], ca[8], xa[8], za[8], y[8], u[8];
                unpack8(*(const v4u*)(pr + C_BA), ba); unpack8(*(const v4u*)(pr + C_CA), ca); unpack8(*(const v4u*)(pr + C_XA), xa); unpack8(*(const v4u*)(pr + C_ZA), za);
#pragma unroll
                for (int c = 0; c < 8; ++c) { u[c] = ca[c] * xa[c]; const float cv = w[0][c] * um2[c] + w[1][c] * um1[c] + w[2][c] * u[c]; y[c] = ba[c] * cv * silu_f(za[c]); um2[c] = um1[c]; um1[c] = u[c]; }
                *(v4u*)(mix + (size_t)r * D + c8) = pack8(y);
                if (t >= T - 2) { float* op = out + (smp ? O_CA_S : O_CA_P) + ((size_t)b * 2 + (t - (T - 2))) * DC + c8;
                    *(f32x4*)op = (f32x4){u[0], u[1], u[2], u[3]}; *(f32x4*)(op + 4) = (f32x4){u[4], u[5], u[6], u[7]}; }
            }
        }
        const int ch = smp ? NB * NH * 64 + b * NH + hh : (b * NH + hh) * 64 + t0 / 64;
        const int tq = smp ? t0 : (t0 & 63);
        const int ks = tq >> 4, jj0 = (tq & 8) >> 1;
#pragma unroll 1
        for (int seg = 0; seg < 3; ++seg) {
            const int cc = seg * 512 + c8;
            float w[4][8];
#pragma unroll
            for (int j = 0; j < 4; ++j) { const f32x4 x0 = *(const f32x4*)(cw_q + j * DQKV + cc), x1 = *(const f32x4*)(cw_q + j * DQKV + cc + 4);
#pragma unroll
                for (int c = 0; c < 4; ++c) { w[j][c] = x0[c]; w[j][4 + c] = x1[c]; } }
            float xm3[8], xm2[8], xm1[8];
            if (t0 == 0) {
                if (smp) { const float* cp = cache_q + (size_t)b * 3 * DQKV + cc;
#pragma unroll
                    for (int c = 0; c < 8; ++c) { xm3[c] = cp[c]; xm2[c] = cp[DQKV + c]; xm1[c] = cp[2 * DQKV + c]; } }
                else {
#pragma unroll
                    for (int c = 0; c < 8; ++c) { xm3[c] = 0.f; xm2[c] = 0.f; xm1[c] = 0.f; } }
            } else {
                unpack8(*(const v4u*)(pq + (size_t)(r0 - 3) * DQKV + cc), xm3);
                unpack8(*(const v4u*)(pq + (size_t)(r0 - 2) * DQKV + cc), xm2);
                unpack8(*(const v4u*)(pq + (size_t)(r0 - 1) * DQKV + cc), xm1);
            }
            unsigned tkp[8][4];
#pragma unroll
            for (int i = 0; i < RB; ++i) {
                const int r = r0 + i, t = t0 + i;
                float x[8], s[8]; unpack8(*(const v4u*)(pq + (size_t)r * DQKV + cc), x);
                float ss = 0.f;
#pragma unroll
                for (int c = 0; c < 8; ++c) { const float cv = w[0][c] * xm3[c] + w[1][c] * xm2[c] + w[2][c] * xm1[c] + w[3][c] * x[c]; s[c] = silu_f(cv); ss += s[c] * s[c]; xm3[c] = xm2[c]; xm2[c] = xm1[c]; xm1[c] = x[c]; }
                if (seg < 2) {
                    ss += __shfl_xor(ss, 1); ss += __shfl_xor(ss, 2); ss += __shfl_xor(ss, 4); ss += __shfl_xor(ss, 8);
                    float inv = 1.0f / sqrtf(ss + L2_EPS); if (seg == 0) inv *= 0.08838834764831845f;
#pragma unroll
                    for (int c = 0; c < 8; ++c) s[c] *= inv;
                    bf16* qp = qkr + (size_t)r * 1024 + seg * 512 + hh * HD + (dl & ~15) + 4 * (lane & 1);
                    *(v2u*)qp = (v2u){pk2(s[0], s[1]), pk2(s[2], s[3])};
                    *(v2u*)(qp + 8) = (v2u){pk2(s[4], s[5]), pk2(s[6], s[7])};
                }
                if (seg >= 1) {
#pragma unroll
                    for (int c = 0; c < 8; ++c) { const unsigned bv = pk2(s[c], 0.f) & 0xffffu; if (i & 1) tkp[c][i >> 1] |= bv << 16; else tkp[c][i >> 1] = bv; }
                }
                if (t >= T - 3) { float* op = out + (smp ? O_CQ_S : O_CQ_P) + ((size_t)b * 3 + (t - (T - 3))) * DQKV + cc;
                    *(f32x4*)op = (f32x4){x[0], x[1], x[2], x[3]}; *(f32x4*)(op + 4) = (f32x4){x[4], x[5], x[6], x[7]}; }
            }
            if (seg >= 1) {
                bf16* base = kvt + (size_t)ch * 16384 + (seg - 1) * 8192;
#pragma unroll
                for (int c = 0; c < 8; ++c) { const int d = dl + c, dt = d >> 5, rr = d & 31;
                    bf16* bp = base + (dt * 4 + ks) * 512 + rr * 8 + jj0;
                    *(v2u*)bp = (v2u){tkp[c][0], tkp[c][1]};
                    *(v2u*)(bp + 256) = (v2u){tkp[c][2], tkp[c][3]}; }
            }
        }
        if (lane < RB * NH) { const int i = lane >> 2, h = lane & 3, r = r0 + i;
            const float ad = ab[(size_t)r * 8 + h], bb = ab[(size_t)r * 8 + 4 + h];
            gbv[(size_t)r * 8 + h] = -expf(a_log[h]) * softplus_f(ad + dt_bias[h]);
            gbv[(size_t)r * 8 + 4 + h] = sigmoid_f(bb); }
    }
}

typedef short bf16x8 __attribute__((ext_vector_type(8)));
typedef float f32x16 __attribute__((ext_vector_type(16)));
#define MFMA32(a, b, c) __builtin_amdgcn_mfma_f32_32x32x16_bf16((a), (b), (c), 0, 0, 0)
__device__ __forceinline__ bf16x8 pack_regs(const f32x16& x, int s) {
    v4u w; w.x = pk2(x[8 * s + 0], x[8 * s + 1]); w.y = pk2(x[8 * s + 2], x[8 * s + 3]); w.z = pk2(x[8 * s + 4], x[8 * s + 5]); w.w = pk2(x[8 * s + 6], x[8 * s + 7]);
    return __builtin_bit_cast(bf16x8, w);
}
__device__ __forceinline__ f32x16 zero16() { f32x16 z;
#pragma unroll
    for (int i = 0; i < 16; ++i) z[i] = 0.f;
    return z; }
constexpr int AP = 68;
constexpr int SLOT_BYTES = 64 * AP * 4 + 1024;
static_assert(SLOT_BYTES * NWAVES <= LDS_PHASE, "chunk-prep LDS");

__device__ __forceinline__ void phase3(const Args& a, unsigned char* lds, int G) {
    const int tid = threadIdx.x, lane = tid & 63, wave = __builtin_amdgcn_readfirstlane(tid >> 6);
    const int gw = blockIdx.x * NWAVES + wave, NGW = G * NWAVES;
    unsigned char* ws = a.ws;
    const bf16* qkr = (const bf16*)(ws + WS_QKR); const bf16* kvt = (const bf16*)(ws + WS_KVT); const float* gbv = (const float*)(ws + WS_GB);
    float* Am = (float*)(lds + wave * SLOT_BYTES);
    float* tab = Am + 64 * AP;
    const int r = lane & 31, hf = lane >> 5;
    for (int ch = gw; ch < NCH; ch += NGW) {
        const bool smp = ch >= NB * NH * 64;
        int rbase, hh, ntok;
        if (smp) { const int sl = ch - NB * NH * 64; rbase = MP + (sl >> 2) * DSEQ; hh = sl & 3; ntok = DSEQ; }
        else { const int sq = ch >> 6, n = ch & 63; rbase = (sq >> 2) * SEQ + n * 64; hh = sq & 3; ntok = 64; }
        const int nks = ntok >> 4;
        unsigned char* rec = ws + WS_PREP + (size_t)ch * REC;
        float g = 0.f, bt = 0.f;
        if (lane < ntok) { g = gbv[(size_t)(rbase + lane) * 8 + hh]; bt = gbv[(size_t)(rbase + lane) * 8 + 4 + hh]; }
        float gb = g;
#pragma unroll
        for (int o = 1; o < 64; o <<= 1) { const float t = __shfl_up(gb, o); if (lane >= o) gb += t; }
        const float gl = __shfl(gb, 63);
        tab[lane] = gb; tab[64 + lane] = bt; tab[128 + lane] = expf(gb); tab[192 + lane] = expf(gl - gb);
        asm volatile("s_waitcnt lgkmcnt(0)" ::: "memory");
        const int row0 = r & (ntok - 1), row1 = (32 + r) & (ntok - 1);
        const bf16* q0p = qkr + (size_t)(rbase + row0) * 1024 + hh * HD + 8 * hf; const bf16* q1p = qkr + (size_t)(rbase + row1) * 1024 + hh * HD + 8 * hf;
        f32x16 at00 = zero16(), at01 = zero16(), at11 = zero16(), ak00 = zero16(), ak10 = zero16(), ak11 = zero16();
        const float e0 = tab[128 + r], e1 = tab[160 + r];
#pragma unroll
        for (int ks8 = 0; ks8 < 8; ++ks8) {
            const v4u qf0 = *(const v4u*)(q0p + 16 * ks8), qf1 = *(const v4u*)(q1p + 16 * ks8), kf0 = *(const v4u*)(q0p + 512 + 16 * ks8), kf1 = *(const v4u*)(q1p + 512 + 16 * ks8);
            const bf16x8 q0 = __builtin_bit_cast(bf16x8, qf0), q1 = __builtin_bit_cast(bf16x8, qf1), k0 = __builtin_bit_cast(bf16x8, kf0), k1 = __builtin_bit_cast(bf16x8, kf1);
            at00 = MFMA32(k0, q0, at00); at01 = MFMA32(k0, q1, at01); at11 = MFMA32(k1, q1, at11);
            ak00 = MFMA32(k0, k0, ak00); ak10 = MFMA32(k0, k1, ak10); ak11 = MFMA32(k1, k1, ak11);
            float f0[8], f1[8]; unpack8(qf0, f0); unpack8(qf1, f1);
#pragma unroll
            for (int c = 0; c < 8; ++c) { f0[c] *= e0; f1[c] *= e1; }
            *(v4u*)(rec + R_QG + (0 * 8 + ks8) * 1024 + lane * 16) = pack8(f0);
            *(v4u*)(rec + R_QG + (1 * 8 + ks8) * 1024 + lane * 16) = pack8(f1);
        }
        {
            const float gi0 = tab[r], gi1 = tab[32 + r];
#pragma unroll
            for (int tile = 0; tile < 3; ++tile) {
                const int jt = (tile == 2) ? 1 : 0, it = (tile == 0) ? 0 : 1;
                f32x16& acc = (tile == 0) ? at00 : (tile == 1 ? at01 : at11);
                const float gi = it ? gi1 : gi0; const int i = 32 * it + r;
#pragma unroll
                for (int gq = 0; gq < 4; ++gq) { const f32x4 gj = *(const f32x4*)(tab + 32 * jt + 8 * gq + 4 * hf);
#pragma unroll
                    for (int c = 0; c < 4; ++c) { const int j = 32 * jt + 8 * gq + 4 * hf + c; const float dcy = __expf(fminf(gi - gj[c], 0.f)); acc[4 * gq + c] = (i >= j) ? acc[4 * gq + c] * dcy : 0.f; } }
#pragma unroll
                for (int s = 0; s < 2; ++s) *(bf16x8*)(rec + R_ATTN + (it * 4 + 2 * jt + s) * 1024 + lane * 16) = pack_regs(acc, s);
            }
        }
        {
            const float gi0 = tab[r], gi1 = tab[32 + r], bi0 = tab[64 + r], bi1 = tab[96 + r];
#pragma unroll
            for (int tile = 0; tile < 3; ++tile) {
                const int jt = (tile == 2) ? 1 : 0, it = (tile == 0) ? 0 : 1;
                const f32x16& acc = (tile == 0) ? ak00 : (tile == 1 ? ak10 : ak11);
                const float gi = it ? gi1 : gi0, bi = it ? bi1 : bi0; const int i = 32 * it + r;
#pragma unroll
                for (int gq = 0; gq < 4; ++gq) { const f32x4 gj = *(const f32x4*)(tab + 32 * jt + 8 * gq + 4 * hf);
#pragma unroll
                    for (int c = 0; c < 4; ++c) { const int j = 32 * jt + 8 * gq + 4 * hf + c; Am[j * AP + i] = bi * acc[4 * gq + c] * __expf(fminf(gi - gj[c], 0.f)); } }
            }
        }
        asm volatile("s_waitcnt lgkmcnt(0)" ::: "memory");
        {
            float x0, x1, x2, x3, x4, x5, x6, x7, x8, x9, x10, x11, x12, x13, x14, x15, x16, x17, x18, x19, x20, x21, x22, x23, x24, x25, x26, x27, x28, x29, x30, x31, x32, x33, x34, x35, x36, x37, x38, x39, x40, x41, x42, x43, x44, x45, x46, x47, x48, x49, x50, x51, x52, x53, x54, x55, x56, x57, x58, x59, x60, x61, x62, x63;
            x0 = (lane == 0) ? 1.f : 0.f; x1 = (lane == 1) ? 1.f : 0.f; x2 = (lane == 2) ? 1.f : 0.f; x3 = (lane == 3) ? 1.f : 0.f; x4 = (lane == 4) ? 1.f : 0.f; x5 = (lane == 5) ? 1.f : 0.f; x6 = (lane == 6) ? 1.f : 0.f; x7 = (lane == 7) ? 1.f : 0.f; x8 = (lane == 8) ? 1.f : 0.f; x9 = (lane == 9) ? 1.f : 0.f; x10 = (lane == 10) ? 1.f : 0.f; x11 = (lane == 11) ? 1.f : 0.f; x12 = (lane == 12) ? 1.f : 0.f; x13 = (lane == 13) ? 1.f : 0.f; x14 = (lane == 14) ? 1.f : 0.f; x15 = (lane == 15) ? 1.f : 0.f; x16 = (lane == 16) ? 1.f : 0.f; x17 = (lane == 17) ? 1.f : 0.f; x18 = (lane == 18) ? 1.f : 0.f; x19 = (lane == 19) ? 1.f : 0.f; x20 = (lane == 20) ? 1.f : 0.f; x21 = (lane == 21) ? 1.f : 0.f; x22 = (lane == 22) ? 1.f : 0.f; x23 = (lane == 23) ? 1.f : 0.f; x24 = (lane == 24) ? 1.f : 0.f; x25 = (lane == 25) ? 1.f : 0.f; x26 = (lane == 26) ? 1.f : 0.f; x27 = (lane == 27) ? 1.f : 0.f; x28 = (lane == 28) ? 1.f : 0.f; x29 = (lane == 29) ? 1.f : 0.f; x30 = (lane == 30) ? 1.f : 0.f; x31 = (lane == 31) ? 1.f : 0.f; x32 = (lane == 32) ? 1.f : 0.f; x33 = (lane == 33) ? 1.f : 0.f; x34 = (lane == 34) ? 1.f : 0.f; x35 = (lane == 35) ? 1.f : 0.f; x36 = (lane == 36) ? 1.f : 0.f; x37 = (lane == 37) ? 1.f : 0.f; x38 = (lane == 38) ? 1.f : 0.f; x39 = (lane == 39) ? 1.f : 0.f; x40 = (lane == 40) ? 1.f : 0.f; x41 = (lane == 41) ? 1.f : 0.f; x42 = (lane == 42) ? 1.f : 0.f; x43 = (lane == 43) ? 1.f : 0.f; x44 = (lane == 44) ? 1.f : 0.f; x45 = (lane == 45) ? 1.f : 0.f; x46 = (lane == 46) ? 1.f : 0.f; x47 = (lane == 47) ? 1.f : 0.f; x48 = (lane == 48) ? 1.f : 0.f; x49 = (lane == 49) ? 1.f : 0.f; x50 = (lane == 50) ? 1.f : 0.f; x51 = (lane == 51) ? 1.f : 0.f; x52 = (lane == 52) ? 1.f : 0.f; x53 = (lane == 53) ? 1.f : 0.f; x54 = (lane == 54) ? 1.f : 0.f; x55 = (lane == 55) ? 1.f : 0.f; x56 = (lane == 56) ? 1.f : 0.f; x57 = (lane == 57) ? 1.f : 0.f; x58 = (lane == 58) ? 1.f : 0.f; x59 = (lane == 59) ? 1.f : 0.f; x60 = (lane == 60) ? 1.f : 0.f; x61 = (lane == 61) ? 1.f : 0.f; x62 = (lane == 62) ? 1.f : 0.f; x63 = (lane == 63) ? 1.f : 0.f;
            f32x4 ca0, cb0, ca1, cb1, ca2, cb2, ca3, cb3, ca4, cb4, ca5, cb5, ca6, cb6, ca7, cb7;
            ca0 = *(const f32x4*)(Am + 0 * AP + 0);
            ca1 = *(const f32x4*)(Am + 0 * AP + 4);
            ca2 = *(const f32x4*)(Am + 0 * AP + 8);
            ca3 = *(const f32x4*)(Am + 0 * AP + 12);
            ca4 = *(const f32x4*)(Am + 0 * AP + 16);
            ca5 = *(const f32x4*)(Am + 0 * AP + 20);
            ca6 = *(const f32x4*)(Am + 0 * AP + 24);
            ca7 = *(const f32x4*)(Am + 0 * AP + 28);
            cb0 = *(const f32x4*)(Am + 0 * AP + 32);
            cb1 = *(const f32x4*)(Am + 0 * AP + 36);
            cb2 = *(const f32x4*)(Am + 0 * AP + 40);
            cb3 = *(const f32x4*)(Am + 0 * AP + 44);
            cb4 = *(const f32x4*)(Am + 0 * AP + 48);
            cb5 = *(const f32x4*)(Am + 0 * AP + 52);
            cb6 = *(const f32x4*)(Am + 0 * AP + 56);
            cb7 = *(const f32x4*)(Am + 0 * AP + 60);
            __builtin_amdgcn_sched_barrier(0);
            x1 -= ca0[1] * x0; x2 -= ca0[2] * x0; x3 -= ca0[3] * x0; x4 -= ca1[0] * x0; x5 -= ca1[1] * x0; x6 -= ca1[2] * x0; x7 -= ca1[3] * x0; x8 -= ca2[0] * x0; x9 -= ca2[1] * x0; x10 -= ca2[2] * x0; x11 -= ca2[3] * x0; x12 -= ca3[0] * x0; x13 -= ca3[1] * x0; x14 -= ca3[2] * x0; x15 -= ca3[3] * x0; x16 -= ca4[0] * x0; x17 -= ca4[1] * x0; x18 -= ca4[2] * x0; x19 -= ca4[3] * x0; x20 -= ca5[0] * x0; x21 -= ca5[1] * x0; x22 -= ca5[2] * x0; x23 -= ca5[3] * x0; x24 -= ca6[0] * x0; x25 -= ca6[1] * x0; x26 -= ca6[2] * x0; x27 -= ca6[3] * x0; x28 -= ca7[0] * x0; x29 -= ca7[1] * x0; x30 -= ca7[2] * x0; x31 -= ca7[3] * x0;
            __builtin_amdgcn_sched_barrier(0);
            ca0 = *(const f32x4*)(Am + 1 * AP + 0);
            ca1 = *(const f32x4*)(Am + 1 * AP + 4);
            ca2 = *(const f32x4*)(Am + 1 * AP + 8);
            ca3 = *(const f32x4*)(Am + 1 * AP + 12);
            ca4 = *(const f32x4*)(Am + 1 * AP + 16);
            ca5 = *(const f32x4*)(Am + 1 * AP + 20);
            ca6 = *(const f32x4*)(Am + 1 * AP + 24);
            ca7 = *(const f32x4*)(Am + 1 * AP + 28);
            __builtin_amdgcn_sched_barrier(0);
            x32 -= cb0[0] * x0; x33 -= cb0[1] * x0; x34 -= cb0[2] * x0; x35 -= cb0[3] * x0; x36 -= cb1[0] * x0; x37 -= cb1[1] * x0; x38 -= cb1[2] * x0; x39 -= cb1[3] * x0; x40 -= cb2[0] * x0; x41 -= cb2[1] * x0; x42 -= cb2[2] * x0; x43 -= cb2[3] * x0; x44 -= cb3[0] * x0; x45 -= cb3[1] * x0; x46 -= cb3[2] * x0; x47 -= cb3[3] * x0; x48 -= cb4[0] * x0; x49 -= cb4[1] * x0; x50 -= cb4[2] * x0; x51 -= cb4[3] * x0; x52 -= cb5[0] * x0; x53 -= cb5[1] * x0; x54 -= cb5[2] * x0; x55 -= cb5[3] * x0; x56 -= cb6[0] * x0; x57 -= cb6[1] * x0; x58 -= cb6[2] * x0; x59 -= cb6[3] * x0; x60 -= cb7[0] * x0; x61 -= cb7[1] * x0; x62 -= cb7[2] * x0; x63 -= cb7[3] * x0;
            __builtin_amdgcn_sched_barrier(0);
            cb0 = *(const f32x4*)(Am + 1 * AP + 32);
            cb1 = *(const f32x4*)(Am + 1 * AP + 36);
            cb2 = *(const f32x4*)(Am + 1 * AP + 40);
            cb3 = *(const f32x4*)(Am + 1 * AP + 44);
            cb4 = *(const f32x4*)(Am + 1 * AP + 48);
            cb5 = *(const f32x4*)(Am + 1 * AP + 52);
            cb6 = *(const f32x4*)(Am + 1 * AP + 56);
            cb7 = *(const f32x4*)(Am + 1 * AP + 60);
            __builtin_amdgcn_sched_barrier(0);
            x2 -= ca0[2] * x1; x3 -= ca0[3] * x1; x4 -= ca1[0] * x1; x5 -= ca1[1] * x1; x6 -= ca1[2] * x1; x7 -= ca1[3] * x1; x8 -= ca2[0] * x1; x9 -= ca2[1] * x1; x10 -= ca2[2] * x1; x11 -= ca2[3] * x1; x12 -= ca3[0] * x1; x13 -= ca3[1] * x1; x14 -= ca3[2] * x1; x15 -= ca3[3] * x1; x16 -= ca4[0] * x1; x17 -= ca4[1] * x1; x18 -= ca4[2] * x1; x19 -= ca4[3] * x1; x20 -= ca5[0] * x1; x21 -= ca5[1] * x1; x22 -= ca5[2] * x1; x23 -= ca5[3] * x1; x24 -= ca6[0] * x1; x25 -= ca6[1] * x1; x26 -= ca6[2] * x1; x27 -= ca6[3] * x1; x28 -= ca7[0] * x1; x29 -= ca7[1] * x1; x30 -= ca7[2] * x1; x31 -= ca7[3] * x1;
            __builtin_amdgcn_sched_barrier(0);
            ca0 = *(const f32x4*)(Am + 2 * AP + 0);
            ca1 = *(const f32x4*)(Am + 2 * AP + 4);
            ca2 = *(const f32x4*)(Am + 2 * AP + 8);
            ca3 = *(const f32x4*)(Am + 2 * AP + 12);
            ca4 = *(const f32x4*)(Am + 2 * AP + 16);
            ca5 = *(const f32x4*)(Am + 2 * AP + 20);
            ca6 = *(const f32x4*)(Am + 2 * AP + 24);
            ca7 = *(const f32x4*)(Am + 2 * AP + 28);
            __builtin_amdgcn_sched_barrier(0);
            x32 -= cb0[0] * x1; x33 -= cb0[1] * x1; x34 -= cb0[2] * x1; x35 -= cb0[3] * x1; x36 -= cb1[0] * x1; x37 -= cb1[1] * x1; x38 -= cb1[2] * x1; x39 -= cb1[3] * x1; x40 -= cb2[0] * x1; x41 -= cb2[1] * x1; x42 -= cb2[2] * x1; x43 -= cb2[3] * x1; x44 -= cb3[0] * x1; x45 -= cb3[1] * x1; x46 -= cb3[2] * x1; x47 -= cb3[3] * x1; x48 -= cb4[0] * x1; x49 -= cb4[1] * x1; x50 -= cb4[2] * x1; x51 -= cb4[3] * x1; x52 -= cb5[0] * x1; x53 -= cb5[1] * x1; x54 -= cb5[2] * x1; x55 -= cb5[3] * x1; x56 -= cb6[0] * x1; x57 -= cb6[1] * x1; x58 -= cb6[2] * x1; x59 -= cb6[3] * x1; x60 -= cb7[0] * x1; x61 -= cb7[1] * x1; x62 -= cb7[2] * x1; x63 -= cb7[3] * x1;
            __builtin_amdgcn_sched_barrier(0);
            cb0 = *(const f32x4*)(Am + 2 * AP + 32);
            cb1 = *(const f32x4*)(Am + 2 * AP + 36);
            cb2 = *(const f32x4*)(Am + 2 * AP + 40);
            cb3 = *(const f32x4*)(Am + 2 * AP + 44);
            cb4 = *(const f32x4*)(Am + 2 * AP + 48);
            cb5 = *(const f32x4*)(Am + 2 * AP + 52);
            cb6 = *(const f32x4*)(Am + 2 * AP + 56);
            cb7 = *(const f32x4*)(Am + 2 * AP + 60);
            __builtin_amdgcn_sched_barrier(0);
            x3 -= ca0[3] * x2; x4 -= ca1[0] * x2; x5 -= ca1[1] * x2; x6 -= ca1[2] * x2; x7 -= ca1[3] * x2; x8 -= ca2[0] * x2; x9 -= ca2[1] * x2; x10 -= ca2[2] * x2; x11 -= ca2[3] * x2; x12 -= ca3[0] * x2; x13 -= ca3[1] * x2; x14 -= ca3[2] * x2; x15 -= ca3[3] * x2; x16 -= ca4[0] * x2; x17 -= ca4[1] * x2; x18 -= ca4[2] * x2; x19 -= ca4[3] * x2; x20 -= ca5[0] * x2; x21 -= ca5[1] * x2; x22 -= ca5[2] * x2; x23 -= ca5[3] * x2; x24 -= ca6[0] * x2; x25 -= ca6[1] * x2; x26 -= ca6[2] * x2; x27 -= ca6[3] * x2; x28 -= ca7[0] * x2; x29 -= ca7[1] * x2; x30 -= ca7[2] * x2; x31 -= ca7[3] * x2;
            __builtin_amdgcn_sched_barrier(0);
            ca1 = *(const f32x4*)(Am + 3 * AP + 4);
            ca2 = *(const f32x4*)(Am + 3 * AP + 8);
            ca3 = *(const f32x4*)(Am + 3 * AP + 12);
            ca4 = *(const f32x4*)(Am + 3 * AP + 16);
            ca5 = *(const f32x4*)(Am + 3 * AP + 20);
            ca6 = *(const f32x4*)(Am + 3 * AP + 24);
            ca7 = *(const f32x4*)(Am + 3 * AP + 28);
            __builtin_amdgcn_sched_barrier(0);
            x32 -= cb0[0] * x2; x33 -= cb0[1] * x2; x34 -= cb0[2] * x2; x35 -= cb0[3] * x2; x36 -= cb1[0] * x2; x37 -= cb1[1] * x2; x38 -= cb1[2] * x2; x39 -= cb1[3] * x2; x40 -= cb2[0] * x2; x41 -= cb2[1] * x2; x42 -= cb2[2] * x2; x43 -= cb2[3] * x2; x44 -= cb3[0] * x2; x45 -= cb3[1] * x2; x46 -= cb3[2] * x2; x47 -= cb3[3] * x2; x48 -= cb4[0] * x2; x49 -= cb4[1] * x2; x50 -= cb4[2] * x2; x51 -= cb4[3] * x2; x52 -= cb5[0] * x2; x53 -= cb5[1] * x2; x54 -= cb5[2] * x2; x55 -= cb5[3] * x2; x56 -= cb6[0] * x2; x57 -= cb6[1] * x2; x58 -= cb6[2] * x2; x59 -= cb6[3] * x2; x60 -= cb7[0] * x2; x61 -= cb7[1] * x2; x62 -= cb7[2] * x2; x63 -= cb7[3] * x2;
            __builtin_amdgcn_sched_barrier(0);
            cb0 = *(const f32x4*)(Am + 3 * AP + 32);
            cb1 = *(const f32x4*)(Am + 3 * AP + 36);
            cb2 = *(const f32x4*)(Am + 3 * AP + 40);
            cb3 = *(const f32x4*)(Am + 3 * AP + 44);
            cb4 = *(const f32x4*)(Am + 3 * AP + 48);
            cb5 = *(const f32x4*)(Am + 3 * AP + 52);
            cb6 = *(const f32x4*)(Am + 3 * AP + 56);
            cb7 = *(const f32x4*)(Am + 3 * AP + 60);
            __builtin_amdgcn_sched_barrier(0);
            x4 -= ca1[0] * x3; x5 -= ca1[1] * x3; x6 -= ca1[2] * x3; x7 -= ca1[3] * x3; x8 -= ca2[0] * x3; x9 -= ca2[1] * x3; x10 -= ca2[2] * x3; x11 -= ca2[3] * x3; x12 -= ca3[0] * x3; x13 -= ca3[1] * x3; x14 -= ca3[2] * x3; x15 -= ca3[3] * x3; x16 -= ca4[0] * x3; x17 -= ca4[1] * x3; x18 -= ca4[2] * x3; x19 -= ca4[3] * x3; x20 -= ca5[0] * x3; x21 -= ca5[1] * x3; x22 -= ca5[2] * x3; x23 -= ca5[3] * x3; x24 -= ca6[0] * x3; x25 -= ca6[1] * x3; x26 -= ca6[2] * x3; x27 -= ca6[3] * x3; x28 -= ca7[0] * x3; x29 -= ca7[1] * x3; x30 -= ca7[2] * x3; x31 -= ca7[3] * x3;
            __builtin_amdgcn_sched_barrier(0);
            ca1 = *(const f32x4*)(Am + 4 * AP + 4);
            ca2 = *(const f32x4*)(Am + 4 * AP + 8);
            ca3 = *(const f32x4*)(Am + 4 * AP + 12);
            ca4 = *(const f32x4*)(Am + 4 * AP + 16);
            ca5 = *(const f32x4*)(Am + 4 * AP + 20);
            ca6 = *(const f32x4*)(Am + 4 * AP + 24);
            ca7 = *(const f32x4*)(Am + 4 * AP + 28);
            __builtin_amdgcn_sched_barrier(0);
            x32 -= cb0[0] * x3; x33 -= cb0[1] * x3; x34 -= cb0[2] * x3; x35 -= cb0[3] * x3; x36 -= cb1[0] * x3; x37 -= cb1[1] * x3; x38 -= cb1[2] * x3; x39 -= cb1[3] * x3; x40 -= cb2[0] * x3; x41 -= cb2[1] * x3; x42 -= cb2[2] * x3; x43 -= cb2[3] * x3; x44 -= cb3[0] * x3; x45 -= cb3[1] * x3; x46 -= cb3[2] * x3; x47 -= cb3[3] * x3; x48 -= cb4[0] * x3; x49 -= cb4[1] * x3; x50 -= cb4[2] * x3; x51 -= cb4[3] * x3; x52 -= cb5[0] * x3; x53 -= cb5[1] * x3; x54 -= cb5[2] * x3; x55 -= cb5[3] * x3; x56 -= cb6[0] * x3; x57 -= cb6[1] * x3; x58 -= cb6[2] * x3; x59 -= cb6[3] * x3; x60 -= cb7[0] * x3; x61 -= cb7[1] * x3; x62 -= cb7[2] * x3; x63 -= cb7[3] * x3;
            __builtin_amdgcn_sched_barrier(0);
            cb0 = *(const f32x4*)(Am + 4 * AP + 32);
            cb1 = *(const f32x4*)(Am + 4 * AP + 36);
            cb2 = *(const f32x4*)(Am + 4 * AP + 40);
            cb3 = *(const f32x4*)(Am + 4 * AP + 44);
            cb4 = *(const f32x4*)(Am + 4 * AP + 48);
            cb5 = *(const f32x4*)(Am + 4 * AP + 52);
            cb6 = *(const f32x4*)(Am + 4 * AP + 56);
            cb7 = *(const f32x4*)(Am + 4 * AP + 60);
            __builtin_amdgcn_sched_barrier(0);
            x5 -= ca1[1] * x4; x6 -= ca1[2] * x4; x7 -= ca1[3] * x4; x8 -= ca2[0] * x4; x9 -= ca2[1] * x4; x10 -= ca2[2] * x4; x11 -= ca2[3] * x4; x12 -= ca3[0] * x4; x13 -= ca3[1] * x4; x14 -= ca3[2] * x4; x15 -= ca3[3] * x4; x16 -= ca4[0] * x4; x17 -= ca4[1] * x4; x18 -= ca4[2] * x4; x19 -= ca4[3] * x4; x20 -= ca5[0] * x4; x21 -= ca5[1] * x4; x22 -= ca5[2] * x4; x23 -= ca5[3] * x4; x24 -= ca6[0] * x4; x25 -= ca6[1] * x4; x26 -= ca6[2] * x4; x27 -= ca6[3] * x4; x28 -= ca7[0] * x4; x29 -= ca7[1] * x4; x30 -= ca7[2] * x4; x31 -= ca7[3] * x4;
            __builtin_amdgcn_sched_barrier(0);
            ca1 = *(const f32x4*)(Am + 5 * AP + 4);
            ca2 = *(const f32x4*)(Am + 5 * AP + 8);
            ca3 = *(const f32x4*)(Am + 5 * AP + 12);
            ca4 = *(const f32x4*)(Am + 5 * AP + 16);
            ca5 = *(const f32x4*)(Am + 5 * AP + 20);
            ca6 = *(const f32x4*)(Am + 5 * AP + 24);
            ca7 = *(const f32x4*)(Am + 5 * AP + 28);
            __builtin_amdgcn_sched_barrier(0);
            x32 -= cb0[0] * x4; x33 -= cb0[1] * x4; x34 -= cb0[2] * x4; x35 -= cb0[3] * x4; x36 -= cb1[0] * x4; x37 -= cb1[1] * x4; x38 -= cb1[2] * x4; x39 -= cb1[3] * x4; x40 -= cb2[0] * x4; x41 -= cb2[1] * x4; x42 -= cb2[2] * x4; x43 -= cb2[3] * x4; x44 -= cb3[0] * x4; x45 -= cb3[1] * x4; x46 -= cb3[2] * x4; x47 -= cb3[3] * x4; x48 -= cb4[0] * x4; x49 -= cb4[1] * x4; x50 -= cb4[2] * x4; x51 -= cb4[3] * x4; x52 -= cb5[0] * x4; x53 -= cb5[1] * x4; x54 -= cb5[2] * x4; x55 -= cb5[3] * x4; x56 -= cb6[0] * x4; x57 -= cb6[1] * x4; x58 -= cb6[2] * x4; x59 -= cb6[3] * x4; x60 -= cb7[0] * x4; x61 -= cb7[1] * x4; x62 -= cb7[2] * x4; x63 -= cb7[3] * x4;
            __builtin_amdgcn_sched_barrier(0);
            cb0 = *(const f32x4*)(Am + 5 * AP + 32);
            cb1 = *(const f32x4*)(Am + 5 * AP + 36);
            cb2 = *(const f32x4*)(Am + 5 * AP + 40);
            cb3 = *(const f32x4*)(Am + 5 * AP + 44);
            cb4 = *(const f32x4*)(Am + 5 * AP + 48);
            cb5 = *(const f32x4*)(Am + 5 * AP + 52);
            cb6 = *(const f32x4*)(Am + 5 * AP + 56);
            cb7 = *(const f32x4*)(Am + 5 * AP + 60);
            __builtin_amdgcn_sched_barrier(0);
            x6 -= ca1[2] * x5; x7 -= ca1[3] * x5; x8 -= ca2[0] * x5; x9 -= ca2[1] * x5; x10 -= ca2[2] * x5; x11 -= ca2[3] * x5; x12 -= ca3[0] * x5; x13 -= ca3[1] * x5; x14 -= ca3[2] * x5; x15 -= ca3[3] * x5; x16 -= ca4[0] * x5; x17 -= ca4[1] * x5; x18 -= ca4[2] * x5; x19 -= ca4[3] * x5; x20 -= ca5[0] * x5; x21 -= ca5[1] * x5; x22 -= ca5[2] * x5; x23 -= ca5[3] * x5; x24 -= ca6[0] * x5; x25 -= ca6[1] * x5; x26 -= ca6[2] * x5; x27 -= ca6[3] * x5; x28 -= ca7[0] * x5; x29 -= ca7[1] * x5; x30 -= ca7[2] * x5; x31 -= ca7[3] * x5;
            __builtin_amdgcn_sched_barrier(0);
            ca1 = *(const f32x4*)(Am + 6 * AP + 4);
            ca2 = *(const f32x4*)(Am + 6 * AP + 8);
            ca3 = *(const f32x4*)(Am + 6 * AP + 12);
            ca4 = *(const f32x4*)(Am + 6 * AP + 16);
            ca5 = *(const f32x4*)(Am + 6 * AP + 20);
            ca6 = *(const f32x4*)(Am + 6 * AP + 24);
            ca7 = *(const f32x4*)(Am + 6 * AP + 28);
            __builtin_amdgcn_sched_barrier(0);
            x32 -= cb0[0] * x5; x33 -= cb0[1] * x5; x34 -= cb0[2] * x5; x35 -= cb0[3] * x5; x36 -= cb1[0] * x5; x37 -= cb1[1] * x5; x38 -= cb1[2] * x5; x39 -= cb1[3] * x5; x40 -= cb2[0] * x5; x41 -= cb2[1] * x5; x42 -= cb2[2] * x5; x43 -= cb2[3] * x5; x44 -= cb3[0] * x5; x45 -= cb3[1] * x5; x46 -= cb3[2] * x5; x47 -= cb3[3] * x5; x48 -= cb4[0] * x5; x49 -= cb4[1] * x5; x50 -= cb4[2] * x5; x51 -= cb4[3] * x5; x52 -= cb5[0] * x5; x53 -= cb5[1] * x5; x54 -= cb5[2] * x5; x55 -= cb5[3] * x5; x56 -= cb6[0] * x5; x57 -= cb6[1] * x5; x58 -= cb6[2] * x5; x59 -= cb6[3] * x5; x60 -= cb7[0] * x5; x61 -= cb7[1] * x5; x62 -= cb7[2] * x5; x63 -= cb7[3] * x5;
            __builtin_amdgcn_sched_barrier(0);
            cb0 = *(const f32x4*)(Am + 6 * AP + 32);
            cb1 = *(const f32x4*)(Am + 6 * AP + 36);
            cb2 = *(const f32x4*)(Am + 6 * AP + 40);
            cb3 = *(const f32x4*)(Am + 6 * AP + 44);
            cb4 = *(const f32x4*)(Am + 6 * AP + 48);
            cb5 = *(const f32x4*)(Am + 6 * AP + 52);
            cb6 = *(const f32x4*)(Am + 6 * AP + 56);
            cb7 = *(const f32x4*)(Am + 6 * AP + 60);
            __builtin_amdgcn_sched_barrier(0);
            x7 -= ca1[3] * x6; x8 -= ca2[0] * x6; x9 -= ca2[1] * x6; x10 -= ca2[2] * x6; x11 -= ca2[3] * x6; x12 -= ca3[0] * x6; x13 -= ca3[1] * x6; x14 -= ca3[2] * x6; x15 -= ca3[3] * x6; x16 -= ca4[0] * x6; x17 -= ca4[1] * x6; x18 -= ca4[2] * x6; x19 -= ca4[3] * x6; x20 -= ca5[0] * x6; x21 -= ca5[1] * x6; x22 -= ca5[2] * x6; x23 -= ca5[3] * x6; x24 -= ca6[0] * x6; x25 -= ca6[1] * x6; x26 -= ca6[2] * x6; x27 -= ca6[3] * x6; x28 -= ca7[0] * x6; x29 -= ca7[1] * x6; x30 -= ca7[2] * x6; x31 -= ca7[3] * x6;
            __builtin_amdgcn_sched_barrier(0);
            ca2 = *(const f32x4*)(Am + 7 * AP + 8);
            ca3 = *(const f32x4*)(Am + 7 * AP + 12);
            ca4 = *(const f32x4*)(Am + 7 * AP + 16);
            ca5 = *(const f32x4*)(Am + 7 * AP + 20);
            ca6 = *(const f32x4*)(Am + 7 * AP + 24);
            ca7 = *(const f32x4*)(Am + 7 * AP + 28);
            __builtin_amdgcn_sched_barrier(0);
            x32 -= cb0[0] * x6; x33 -= cb0[1] * x6; x34 -= cb0[2] * x6; x35 -= cb0[3] * x6; x36 -= cb1[0] * x6; x37 -= cb1[1] * x6; x38 -= cb1[2] * x6; x39 -= cb1[3] * x6; x40 -= cb2[0] * x6; x41 -= cb2[1] * x6; x42 -= cb2[2] * x6; x43 -= cb2[3] * x6; x44 -= cb3[0] * x6; x45 -= cb3[1] * x6; x46 -= cb3[2] * x6; x47 -= cb3[3] * x6; x48 -= cb4[0] * x6; x49 -= cb4[1] * x6; x50 -= cb4[2] * x6; x51 -= cb4[3] * x6; x52 -= cb5[0] * x6; x53 -= cb5[1] * x6; x54 -= cb5[2] * x6; x55 -= cb5[3] * x6; x56 -= cb6[0] * x6; x57 -= cb6[1] * x6; x58 -= cb6[2] * x6; x59 -= cb6[3] * x6; x60 -= cb7[0] * x6; x61 -= cb7[1] * x6; x62 -= cb7[2] * x6; x63 -= cb7[3] * x6;
            __builtin_amdgcn_sched_barrier(0);
            cb0 = *(const f32x4*)(Am + 7 * AP + 32);
            cb1 = *(const f32x4*)(Am + 7 * AP + 36);
            cb2 = *(const f32x4*)(Am + 7 * AP + 40);
            cb3 = *(const f32x4*)(Am + 7 * AP + 44);
            cb4 = *(const f32x4*)(Am + 7 * AP + 48);
            cb5 = *(const f32x4*)(Am + 7 * AP + 52);
            cb6 = *(const f32x4*)(Am + 7 * AP + 56);
            cb7 = *(const f32x4*)(Am + 7 * AP + 60);
            __builtin_amdgcn_sched_barrier(0);
            x8 -= ca2[0] * x7; x9 -= ca2[1] * x7; x10 -= ca2[2] * x7; x11 -= ca2[3] * x7; x12 -= ca3[0] * x7; x13 -= ca3[1] * x7; x14 -= ca3[2] * x7; x15 -= ca3[3] * x7; x16 -= ca4[0] * x7; x17 -= ca4[1] * x7; x18 -= ca4[2] * x7; x19 -= ca4[3] * x7; x20 -= ca5[0] * x7; x21 -= ca5[1] * x7; x22 -= ca5[2] * x7; x23 -= ca5[3] * x7; x24 -= ca6[0] * x7; x25 -= ca6[1] * x7; x26 -= ca6[2] * x7; x27 -= ca6[3] * x7; x28 -= ca7[0] * x7; x29 -= ca7[1] * x7; x30 -= ca7[2] * x7; x31 -= ca7[3] * x7;
            __builtin_amdgcn_sched_barrier(0);
            ca2 = *(const f32x4*)(Am + 8 * AP + 8);
            ca3 = *(const f32x4*)(Am + 8 * AP + 12);
            ca4 = *(const f32x4*)(Am + 8 * AP + 16);
            ca5 = *(const f32x4*)(Am + 8 * AP + 20);
            ca6 = *(const f32x4*)(Am + 8 * AP + 24);
            ca7 = *(const f32x4*)(Am + 8 * AP + 28);
            __builtin_amdgcn_sched_barrier(0);
            x32 -= cb0[0] * x7; x33 -= cb0[1] * x7; x34 -= cb0[2] * x7; x35 -= cb0[3] * x7; x36 -= cb1[0] * x7; x37 -= cb1[1] * x7; x38 -= cb1[2] * x7; x39 -= cb1[3] * x7; x40 -= cb2[0] * x7; x41 -= cb2[1] * x7; x42 -= cb2[2] * x7; x43 -= cb2[3] * x7; x44 -= cb3[0] * x7; x45 -= cb3[1] * x7; x46 -= cb3[2] * x7; x47 -= cb3[3] * x7; x48 -= cb4[0] * x7; x49 -= cb4[1] * x7; x50 -= cb4[2] * x7; x51 -= cb4[3] * x7; x52 -= cb5[0] * x7; x53 -= cb5[1] * x7; x54 -= cb5[2] * x7; x55 -= cb5[3] * x7; x56 -= cb6[0] * x7; x57 -= cb6[1] * x7; x58 -= cb6[2] * x7; x59 -= cb6[3] * x7; x60 -= cb7[0] * x7; x61 -= cb7[1] * x7; x62 -= cb7[2] * x7; x63 -= cb7[3] * x7;
            __builtin_amdgcn_sched_barrier(0);
            cb0 = *(const f32x4*)(Am + 8 * AP + 32);
            cb1 = *(const f32x4*)(Am + 8 * AP + 36);
            cb2 = *(const f32x4*)(Am + 8 * AP + 40);
            cb3 = *(const f32x4*)(Am + 8 * AP + 44);
            cb4 = *(const f32x4*)(Am + 8 * AP + 48);
            cb5 = *(const f32x4*)(Am + 8 * AP + 52);
            cb6 = *(const f32x4*)(Am + 8 * AP + 56);
            cb7 = *(const f32x4*)(Am + 8 * AP + 60);
            __builtin_amdgcn_sched_barrier(0);
            x9 -= ca2[1] * x8; x10 -= ca2[2] * x8; x11 -= ca2[3] * x8; x12 -= ca3[0] * x8; x13 -= ca3[1] * x8; x14 -= ca3[2] * x8; x15 -= ca3[3] * x8; x16 -= ca4[0] * x8; x17 -= ca4[1] * x8; x18 -= ca4[2] * x8; x19 -= ca4[3] * x8; x20 -= ca5[0] * x8; x21 -= ca5[1] * x8; x22 -= ca5[2] * x8; x23 -= ca5[3] * x8; x24 -= ca6[0] * x8; x25 -= ca6[1] * x8; x26 -= ca6[2] * x8; x27 -= ca6[3] * x8; x28 -= ca7[0] * x8; x29 -= ca7[1] * x8; x30 -= ca7[2] * x8; x31 -= ca7[3] * x8;
            __builtin_amdgcn_sched_barrier(0);
            ca2 = *(const f32x4*)(Am + 9 * AP + 8);
            ca3 = *(const f32x4*)(Am + 9 * AP + 12);
            ca4 = *(const f32x4*)(Am + 9 * AP + 16);
            ca5 = *(const f32x4*)(Am + 9 * AP + 20);
            ca6 = *(const f32x4*)(Am + 9 * AP + 24);
            ca7 = *(const f32x4*)(Am + 9 * AP + 28);
            __builtin_amdgcn_sched_barrier(0);
            x32 -= cb0[0] * x8; x33 -= cb0[1] * x8; x34 -= cb0[2] * x8; x35 -= cb0[3] * x8; x36 -= cb1[0] * x8; x37 -= cb1[1] * x8; x38 -= cb1[2] * x8; x39 -= cb1[3] * x8; x40 -= cb2[0] * x8; x41 -= cb2[1] * x8; x42 -= cb2[2] * x8; x43 -= cb2[3] * x8; x44 -= cb3[0] * x8; x45 -= cb3[1] * x8; x46 -= cb3[2] * x8; x47 -= cb3[3] * x8; x48 -= cb4[0] * x8; x49 -= cb4[1] * x8; x50 -= cb4[2] * x8; x51 -= cb4[3] * x8; x52 -= cb5[0] * x8; x53 -= cb5[1] * x8; x54 -= cb5[2] * x8; x55 -= cb5[3] * x8; x56 -= cb6[0] * x8; x57 -= cb6[1] * x8; x58 -= cb6[2] * x8; x59 -= cb6[3] * x8; x60 -= cb7[0] * x8; x61 -= cb7[1] * x8; x62 -= cb7[2] * x8; x63 -= cb7[3] * x8;
            __builtin_amdgcn_sched_barrier(0);
            cb0 = *(const f32x4*)(Am + 9 * AP + 32);
            cb1 = *(const f32x4*)(Am + 9 * AP + 36);
            cb2 = *(const f32x4*)(Am + 9 * AP + 40);
            cb3 = *(const f32x4*)(Am + 9 * AP + 44);
            cb4 = *(const f32x4*)(Am + 9 * AP + 48);
            cb5 = *(const f32x4*)(Am + 9 * AP + 52);
            cb6 = *(const f32x4*)(Am + 9 * AP + 56);
            cb7 = *(const f32x4*)(Am + 9 * AP + 60);
            __builtin_amdgcn_sched_barrier(0);
            x10 -= ca2[2] * x9; x11 -= ca2[3] * x9; x12 -= ca3[0] * x9; x13 -= ca3[1] * x9; x14 -= ca3[2] * x9; x15 -= ca3[3] * x9; x16 -= ca4[0] * x9; x17 -= ca4[1] * x9; x18 -= ca4[2] * x9; x19 -= ca4[3] * x9; x20 -= ca5[0] * x9; x21 -= ca5[1] * x9; x22 -= ca5[2] * x9; x23 -= ca5[3] * x9; x24 -= ca6[0] * x9; x25 -= ca6[1] * x9; x26 -= ca6[2] * x9; x27 -= ca6[3] * x9; x28 -= ca7[0] * x9; x29 -= ca7[1] * x9; x30 -= ca7[2] * x9; x31 -= ca7[3] * x9;
            __builtin_amdgcn_sched_barrier(0);
            ca2 = *(const f32x4*)(Am + 10 * AP + 8);
            ca3 = *(const f32x4*)(Am + 10 * AP + 12);
            ca4 = *(const f32x4*)(Am + 10 * AP + 16);
            ca5 = *(const f32x4*)(Am + 10 * AP + 20);
            ca6 = *(const f32x4*)(Am + 10 * AP + 24);
            ca7 = *(const f32x4*)(Am + 10 * AP + 28);
            __builtin_amdgcn_sched_barrier(0);
            x32 -= cb0[0] * x9; x33 -= cb0[1] * x9; x34 -= cb0[2] * x9; x35 -= cb0[3] * x9; x36 -= cb1[0] * x9; x37 -= cb1[1] * x9; x38 -= cb1[2] * x9; x39 -= cb1[3] * x9; x40 -= cb2[0] * x9; x41 -= cb2[1] * x9; x42 -= cb2[2] * x9; x43 -= cb2[3] * x9; x44 -= cb3[0] * x9; x45 -= cb3[1] * x9; x46 -= cb3[2] * x9; x47 -= cb3[3] * x9; x48 -= cb4[0] * x9; x49 -= cb4[1] * x9; x50 -= cb4[2] * x9; x51 -= cb4[3] * x9; x52 -= cb5[0] * x9; x53 -= cb5[1] * x9; x54 -= cb5[2] * x9; x55 -= cb5[3] * x9; x56 -= cb6[0] * x9; x57 -= cb6[1] * x9; x58 -= cb6[2] * x9; x59 -= cb6[3] * x9; x60 -= cb7[0] * x9; x61 -= cb7[1] * x9; x62 -= cb7[2] * x9; x63 -= cb7[3] * x9;
            __builtin_amdgcn_sched_barrier(0);
            cb0 = *(const f32x4*)(Am + 10 * AP + 32);
            cb1 = *(const f32x4*)(Am + 10 * AP + 36);
            cb2 = *(const f32x4*)(Am + 10 * AP + 40);
            cb3 = *(const f32x4*)(Am + 10 * AP + 44);
            cb4 = *(const f32x4*)(Am + 10 * AP + 48);
            cb5 = *(const f32x4*)(Am + 10 * AP + 52);
            cb6 = *(const f32x4*)(Am + 10 * AP + 56);
            cb7 = *(const f32x4*)(Am + 10 * AP + 60);
            __builtin_amdgcn_sched_barrier(0);
            x11 -= ca2[3] * x10; x12 -= ca3[0] * x10; x13 -= ca3[1] * x10; x14 -= ca3[2] * x10; x15 -= ca3[3] * x10; x16 -= ca4[0] * x10; x17 -= ca4[1] * x10; x18 -= ca4[2] * x10; x19 -= ca4[3] * x10; x20 -= ca5[0] * x10; x21 -= ca5[1] * x10; x22 -= ca5[2] * x10; x23 -= ca5[3] * x10; x24 -= ca6[0] * x10; x25 -= ca6[1] * x10; x26 -= ca6[2] * x10; x27 -= ca6[3] * x10; x28 -= ca7[0] * x10; x29 -= ca7[1] * x10; x30 -= ca7[2] * x10; x31 -= ca7[3] * x10;
            __builtin_amdgcn_sched_barrier(0);
            ca3 = *(const f32x4*)(Am + 11 * AP + 12);
            ca4 = *(const f32x4*)(Am + 11 * AP + 16);
            ca5 = *(const f32x4*)(Am + 11 * AP + 20);
            ca6 = *(const f32x4*)(Am + 11 * AP + 24);
            ca7 = *(const f32x4*)(Am + 11 * AP + 28);
            __builtin_amdgcn_sched_barrier(0);
            x32 -= cb0[0] * x10; x33 -= cb0[1] * x10; x34 -= cb0[2] * x10; x35 -= cb0[3] * x10; x36 -= cb1[0] * x10; x37 -= cb1[1] * x10; x38 -= cb1[2] * x10; x39 -= cb1[3] * x10; x40 -= cb2[0] * x10; x41 -= cb2[1] * x10; x42 -= cb2[2] * x10; x43 -= cb2[3] * x10; x44 -= cb3[0] * x10; x45 -= cb3[1] * x10; x46 -= cb3[2] * x10; x47 -= cb3[3] * x10; x48 -= cb4[0] * x10; x49 -= cb4[1] * x10; x50 -= cb4[2] * x10; x51 -= cb4[3] * x10; x52 -= cb5[0] * x10; x53 -= cb5[1] * x10; x54 -= cb5[2] * x10; x55 -= cb5[3] * x10; x56 -= cb6[0] * x10; x57 -= cb6[1] * x10; x58 -= cb6[2] * x10; x59 -= cb6[3] * x10; x60 -= cb7[0] * x10; x61 -= cb7[1] * x10; x62 -= cb7[2] * x10; x63 -= cb7[3] * x10;
            __builtin_amdgcn_sched_barrier(0);
            cb0 = *(const f32x4*)(Am + 11 * AP + 32);
            cb1 = *(const f32x4*)(Am + 11 * AP + 36);
            cb2 = *(const f32x4*)(Am + 11 * AP + 40);
            cb3 = *(const f32x4*)(Am + 11 * AP + 44);
            cb4 = *(const f32x4*)(Am + 11 * AP + 48);
            cb5 = *(const f32x4*)(Am + 11 * AP + 52);
            cb6 = *(const f32x4*)(Am + 11 * AP + 56);
            cb7 = *(const f32x4*)(Am + 11 * AP + 60);
            __builtin_amdgcn_sched_barrier(0);
            x12 -= ca3[0] * x11; x13 -= ca3[1] * x11; x14 -= ca3[2] * x11; x15 -= ca3[3] * x11; x16 -= ca4[0] * x11; x17 -= ca4[1] * x11; x18 -= ca4[2] * x11; x19 -= ca4[3] * x11; x20 -= ca5[0] * x11; x21 -= ca5[1] * x11; x22 -= ca5[2] * x11; x23 -= ca5[3] * x11; x24 -= ca6[0] * x11; x25 -= ca6[1] * x11; x26 -= ca6[2] * x11; x27 -= ca6[3] * x11; x28 -= ca7[0] * x11; x29 -= ca7[1] * x11; x30 -= ca7[2] * x11; x31 -= ca7[3] * x11;
            __builtin_amdgcn_sched_barrier(0);
            ca3 = *(const f32x4*)(Am + 12 * AP + 12);
            ca4 = *(const f32x4*)(Am + 12 * AP + 16);
            ca5 = *(const f32x4*)(Am + 12 * AP + 20);
            ca6 = *(const f32x4*)(Am + 12 * AP + 24);
            ca7 = *(const f32x4*)(Am + 12 * AP + 28);
            __builtin_amdgcn_sched_barrier(0);
            x32 -= cb0[0] * x11; x33 -= cb0[1] * x11; x34 -= cb0[2] * x11; x35 -= cb0[3] * x11; x36 -= cb1[0] * x11; x37 -= cb1[1] * x11; x38 -= cb1[2] * x11; x39 -= cb1[3] * x11; x40 -= cb2[0] * x11; x41 -= cb2[1] * x11; x42 -= cb2[2] * x11; x43 -= cb2[3] * x11; x44 -= cb3[0] * x11; x45 -= cb3[1] * x11; x46 -= cb3[2] * x11; x47 -= cb3[3] * x11; x48 -= cb4[0] * x11; x49 -= cb4[1] * x11; x50 -= cb4[2] * x11; x51 -= cb4[3] * x11; x52 -= cb5[0] * x11; x53 -= cb5[1] * x11; x54 -= cb5[2] * x11; x55 -= cb5[3] * x11; x56 -= cb6[0] * x11; x57 -= cb6[1] * x11; x58 -= cb6[2] * x11; x59 -= cb6[3] * x11; x60 -= cb7[0] * x11; x61 -= cb7[1] * x11; x62 -= cb7[2] * x11; x63 -= cb7[3] * x11;
            __builtin_amdgcn_sched_barrier(0);
            cb0 = *(const f32x4*)(Am + 12 * AP + 32);
            cb1 = *(const f32x4*)(Am + 12 * AP + 36);
            cb2 = *(const f32x4*)(Am + 12 * AP + 40);
            cb3 = *(const f32x4*)(Am + 12 * AP + 44);
            cb4 = *(const f32x4*)(Am + 12 * AP + 48);
            cb5 = *(const f32x4*)(Am + 12 * AP + 52);
            cb6 = *(const f32x4*)(Am + 12 * AP + 56);
            cb7 = *(const f32x4*)(Am + 12 * AP + 60);
            __builtin_amdgcn_sched_barrier(0);
            x13 -= ca3[1] * x12; x14 -= ca3[2] * x12; x15 -= ca3[3] * x12; x16 -= ca4[0] * x12; x17 -= ca4[1] * x12; x18 -= ca4[2] * x12; x19 -= ca4[3] * x12; x20 -= ca5[0] * x12; x21 -= ca5[1] * x12; x22 -= ca5[2] * x12; x23 -= ca5[3] * x12; x24 -= ca6[0] * x12; x25 -= ca6[1] * x12; x26 -= ca6[2] * x12; x27 -= ca6[3] * x12; x28 -= ca7[0] * x12; x29 -= ca7[1] * x12; x30 -= ca7[2] * x12; x31 -= ca7[3] * x12;
            __builtin_amdgcn_sched_barrier(0);
            ca3 = *(const f32x4*)(Am + 13 * AP + 12);
            ca4 = *(const f32x4*)(Am + 13 * AP + 16);
            ca5 = *(const f32x4*)(Am + 13 * AP + 20);
            ca6 = *(const f32x4*)(Am + 13 * AP + 24);
            ca7 = *(const f32x4*)(Am + 13 * AP + 28);
            __builtin_amdgcn_sched_barrier(0);
            x32 -= cb0[0] * x12; x33 -= cb0[1] * x12; x34 -= cb0[2] * x12; x35 -= cb0[3] * x12; x36 -= cb1[0] * x12; x37 -= cb1[1] * x12; x38 -= cb1[2] * x12; x39 -= cb1[3] * x12; x40 -= cb2[0] * x12; x41 -= cb2[1] * x12; x42 -= cb2[2] * x12; x43 -= cb2[3] * x12; x44 -= cb3[0] * x12; x45 -= cb3[1] * x12; x46 -= cb3[2] * x12; x47 -= cb3[3] * x12; x48 -= cb4[0] * x12; x49 -= cb4[1] * x12; x50 -= cb4[2] * x12; x51 -= cb4[3] * x12; x52 -= cb5[0] * x12; x53 -= cb5[1] * x12; x54 -= cb5[2] * x12; x55 -= cb5[3] * x12; x56 -= cb6[0] * x12; x57 -= cb6[1] * x12; x58 -= cb6[2] * x12; x59 -= cb6[3] * x12; x60 -= cb7[0] * x12; x61 -= cb7[1] * x12; x62 -= cb7[2] * x12; x63 -= cb7[3] * x12;
            __builtin_amdgcn_sched_barrier(0);
            cb0 = *(const f32x4*)(Am + 13 * AP + 32);
            cb1 = *(const f32x4*)(Am + 13 * AP + 36);
            cb2 = *(const f32x4*)(Am + 13 * AP + 40);
            cb3 = *(const f32x4*)(Am + 13 * AP + 44);
            cb4 = *(const f32x4*)(Am + 13 * AP + 48);
            cb5 = *(const f32x4*)(Am + 13 * AP + 52);
            cb6 = *(const f32x4*)(Am + 13 * AP + 56);
            cb7 = *(const f32x4*)(Am + 13 * AP + 60);
            __builtin_amdgcn_sched_barrier(0);
            x14 -= ca3[2] * x13; x15 -= ca3[3] * x13; x16 -= ca4[0] * x13; x17 -= ca4[1] * x13; x18 -= ca4[2] * x13; x19 -= ca4[3] * x13; x20 -= ca5[0] * x13; x21 -= ca5[1] * x13; x22 -= ca5[2] * x13; x23 -= ca5[3] * x13; x24 -= ca6[0] * x13; x25 -= ca6[1] * x13; x26 -= ca6[2] * x13; x27 -= ca6[3] * x13; x28 -= ca7[0] * x13; x29 -= ca7[1] * x13; x30 -= ca7[2] * x13; x31 -= ca7[3] * x13;
            __builtin_amdgcn_sched_barrier(0);
            ca3 = *(const f32x4*)(Am + 14 * AP + 12);
            ca4 = *(const f32x4*)(Am + 14 * AP + 16);
            ca5 = *(const f32x4*)(Am + 14 * AP + 20);
            ca6 = *(const f32x4*)(Am + 14 * AP + 24);
            ca7 = *(const f32x4*)(Am + 14 * AP + 28);
            __builtin_amdgcn_sched_barrier(0);
            x32 -= cb0[0] * x13; x33 -= cb0[1] * x13; x34 -= cb0[2] * x13; x35 -= cb0[3] * x13; x36 -= cb1[0] * x13; x37 -= cb1[1] * x13; x38 -= cb1[2] * x13; x39 -= cb1[3] * x13; x40 -= cb2[0] * x13; x41 -= cb2[1] * x13; x42 -= cb2[2] * x13; x43 -= cb2[3] * x13; x44 -= cb3[0] * x13; x45 -= cb3[1] * x13; x46 -= cb3[2] * x13; x47 -= cb3[3] * x13; x48 -= cb4[0] * x13; x49 -= cb4[1] * x13; x50 -= cb4[2] * x13; x51 -= cb4[3] * x13; x52 -= cb5[0] * x13; x53 -= cb5[1] * x13; x54 -= cb5[2] * x13; x55 -= cb5[3] * x13; x56 -= cb6[0] * x13; x57 -= cb6[1] * x13; x58 -= cb6[2] * x13; x59 -= cb6[3] * x13; x60 -= cb7[0] * x13; x61 -= cb7[1] * x13; x62 -= cb7[2] * x13; x63 -= cb7[3] * x13;
            __builtin_amdgcn_sched_barrier(0);
            cb0 = *(const f32x4*)(Am + 14 * AP + 32);
            cb1 = *(const f32x4*)(Am + 14 * AP + 36);
            cb2 = *(const f32x4*)(Am + 14 * AP + 40);
            cb3 = *(const f32x4*)(Am + 14 * AP + 44);
            cb4 = *(const f32x4*)(Am + 14 * AP + 48);
            cb5 = *(const f32x4*)(Am + 14 * AP + 52);
            cb6 = *(const f32x4*)(Am + 14 * AP + 56);
            cb7 = *(const f32x4*)(Am + 14 * AP + 60);
            __builtin_amdgcn_sched_barrier(0);
            x15 -= ca3[3] * x14; x16 -= ca4[0] * x14; x17 -= ca4[1] * x14; x18 -= ca4[2] * x14; x19 -= ca4[3] * x14; x20 -= ca5[0] * x14; x21 -= ca5[1] * x14; x22 -= ca5[2] * x14; x23 -= ca5[3] * x14; x24 -= ca6[0] * x14; x25 -= ca6[1] * x14; x26 -= ca6[2] * x14; x27 -= ca6[3] * x14; x28 -= ca7[0] * x14; x29 -= ca7[1] * x14; x30 -= ca7[2] * x14; x31 -= ca7[3] * x14;
            __builtin_amdgcn_sched_barrier(0);
            ca4 = *(const f32x4*)(Am + 15 * AP + 16);
            ca5 = *(const f32x4*)(Am + 15 * AP + 20);
            ca6 = *(const f32x4*)(Am + 15 * AP + 24);
            ca7 = *(const f32x4*)(Am + 15 * AP + 28);
            __builtin_amdgcn_sched_barrier(0);
            x32 -= cb0[0] * x14; x33 -= cb0[1] * x14; x34 -= cb0[2] * x14; x35 -= cb0[3] * x14; x36 -= cb1[0] * x14; x37 -= cb1[1] * x14; x38 -= cb1[2] * x14; x39 -= cb1[3] * x14; x40 -= cb2[0] * x14; x41 -= cb2[1] * x14; x42 -= cb2[2] * x14; x43 -= cb2[3] * x14; x44 -= cb3[0] * x14; x45 -= cb3[1] * x14; x46 -= cb3[2] * x14; x47 -= cb3[3] * x14; x48 -= cb4[0] * x14; x49 -= cb4[1] * x14; x50 -= cb4[2] * x14; x51 -= cb4[3] * x14; x52 -= cb5[0] * x14; x53 -= cb5[1] * x14; x54 -= cb5[2] * x14; x55 -= cb5[3] * x14; x56 -= cb6[0] * x14; x57 -= cb6[1] * x14; x58 -= cb6[2] * x14; x59 -= cb6[3] * x14; x60 -= cb7[0] * x14; x61 -= cb7[1] * x14; x62 -= cb7[2] * x14; x63 -= cb7[3] * x14;
            __builtin_amdgcn_sched_barrier(0);
            cb0 = *(const f32x4*)(Am + 15 * AP + 32);
            cb1 = *(const f32x4*)(Am + 15 * AP + 36);
            cb2 = *(const f32x4*)(Am + 15 * AP + 40);
            cb3 = *(const f32x4*)(Am + 15 * AP + 44);
            cb4 = *(const f32x4*)(Am + 15 * AP + 48);
            cb5 = *(const f32x4*)(Am + 15 * AP + 52);
            cb6 = *(const f32x4*)(Am + 15 * AP + 56);
            cb7 = *(const f32x4*)(Am + 15 * AP + 60);
            __builtin_amdgcn_sched_barrier(0);
            x16 -= ca4[0] * x15; x17 -= ca4[1] * x15; x18 -= ca4[2] * x15; x19 -= ca4[3] * x15; x20 -= ca5[0] * x15; x21 -= ca5[1] * x15; x22 -= ca5[2] * x15; x23 -= ca5[3] * x15; x24 -= ca6[0] * x15; x25 -= ca6[1] * x15; x26 -= ca6[2] * x15; x27 -= ca6[3] * x15; x28 -= ca7[0] * x15; x29 -= ca7[1] * x15; x30 -= ca7[2] * x15; x31 -= ca7[3] * x15;
            __builtin_amdgcn_sched_barrier(0);
            ca4 = *(const f32x4*)(Am + 16 * AP + 16);
            ca5 = *(const f32x4*)(Am + 16 * AP + 20);
            ca6 = *(const f32x4*)(Am + 16 * AP + 24);
            ca7 = *(const f32x4*)(Am + 16 * AP + 28);
            __builtin_amdgcn_sched_barrier(0);
            x32 -= cb0[0] * x15; x33 -= cb0[1] * x15; x34 -= cb0[2] * x15; x35 -= cb0[3] * x15; x36 -= cb1[0] * x15; x37 -= cb1[1] * x15; x38 -= cb1[2] * x15; x39 -= cb1[3] * x15; x40 -= cb2[0] * x15; x41 -= cb2[1] * x15; x42 -= cb2[2] * x15; x43 -= cb2[3] * x15; x44 -= cb3[0] * x15; x45 -= cb3[1] * x15; x46 -= cb3[2] * x15; x47 -= cb3[3] * x15; x48 -= cb4[0] * x15; x49 -= cb4[1] * x15; x50 -= cb4[2] * x15; x51 -= cb4[3] * x15; x52 -= cb5[0] * x15; x53 -= cb5[1] * x15; x54 -= cb5[2] * x15; x55 -= cb5[3] * x15; x56 -= cb6[0] * x15; x57 -= cb6[1] * x15; x58 -= cb6[2] * x15; x59 -= cb6[3] * x15; x60 -= cb7[0] * x15; x61 -= cb7[1] * x15; x62 -= cb7[2] * x15; x63 -= cb7[3] * x15;
            __builtin_amdgcn_sched_barrier(0);
            cb0 = *(const f32x4*)(Am + 16 * AP + 32);
            cb1 = *(const f32x4*)(Am + 16 * AP + 36);
            cb2 = *(const f32x4*)(Am + 16 * AP + 40);
            cb3 = *(const f32x4*)(Am + 16 * AP + 44);
            cb4 = *(const f32x4*)(Am + 16 * AP + 48);
            cb5 = *(const f32x4*)(Am + 16 * AP + 52);
            cb6 = *(const f32x4*)(Am + 16 * AP + 56);
            cb7 = *(const f32x4*)(Am + 16 * AP + 60);
            __builtin_amdgcn_sched_barrier(0);
            x17 -= ca4[1] * x16; x18 -= ca4[2] * x16; x19 -= ca4[3] * x16; x20 -= ca5[0] * x16; x21 -= ca5[1] * x16; x22 -= ca5[2] * x16; x23 -= ca5[3] * x16; x24 -= ca6[0] * x16; x25 -= ca6[1] * x16; x26 -= ca6[2] * x16; x27 -= ca6[3] * x16; x28 -= ca7[0] * x16; x29 -= ca7[1] * x16; x30 -= ca7[2] * x16; x31 -= ca7[3] * x16;
            __builtin_amdgcn_sched_barrier(0);
            ca4 = *(const f32x4*)(Am + 17 * AP + 16);
            ca5 = *(const f32x4*)(Am + 17 * AP + 20);
            ca6 = *(const f32x4*)(Am + 17 * AP + 24);
            ca7 = *(const f32x4*)(Am + 17 * AP + 28);
            __builtin_amdgcn_sched_barrier(0);
            x32 -= cb0[0] * x16; x33 -= cb0[1] * x16; x34 -= cb0[2] * x16; x35 -= cb0[3] * x16; x36 -= cb1[0] * x16; x37 -= cb1[1] * x16; x38 -= cb1[2] * x16; x39 -= cb1[3] * x16; x40 -= cb2[0] * x16; x41 -= cb2[1] * x16; x42 -= cb2[2] * x16; x43 -= cb2[3] * x16; x44 -= cb3[0] * x16; x45 -= cb3[1] * x16; x46 -= cb3[2] * x16; x47 -= cb3[3] * x16; x48 -= cb4[0] * x16; x49 -= cb4[1] * x16; x50 -= cb4[2] * x16; x51 -= cb4[3] * x16; x52 -= cb5[0] * x16; x53 -= cb5[1] * x16; x54 -= cb5[2] * x16; x55 -= cb5[3] * x16; x56 -= cb6[0] * x16; x57 -= cb6[1] * x16; x58 -= cb6[2] * x16; x59 -= cb6[3] * x16; x60 -= cb7[0] * x16; x61 -= cb7[1] * x16; x62 -= cb7[2] * x16; x63 -= cb7[3] * x16;
            __builtin_amdgcn_sched_barrier(0);
            cb0 = *(const f32x4*)(Am + 17 * AP + 32);
            cb1 = *(const f32x4*)(Am + 17 * AP + 36);
            cb2 = *(const f32x4*)(Am + 17 * AP + 40);
            cb3 = *(const f32x4*)(Am + 17 * AP + 44);
            cb4 = *(const f32x4*)(Am + 17 * AP + 48);
            cb5 = *(const f32x4*)(Am + 17 * AP + 52);
            cb6 = *(const f32x4*)(Am + 17 * AP + 56);
            cb7 = *(const f32x4*)(Am + 17 * AP + 60);
            __builtin_amdgcn_sched_barrier(0);
            x18 -= ca4[2] * x17; x19 -= ca4[3] * x17; x20 -= ca5[0] * x17; x21 -= ca5[1] * x17; x22 -= ca5[2] * x17; x23 -= ca5[3] * x17; x24 -= ca6[0] * x17; x25 -= ca6[1] * x17; x26 -= ca6[2] * x17; x27 -= ca6[3] * x17; x28 -= ca7[0] * x17; x29 -= ca7[1] * x17; x30 -= ca7[2] * x17; x31 -= ca7[3] * x17;
            __builtin_amdgcn_sched_barrier(0);
            ca4 = *(const f32x4*)(Am + 18 * AP + 16);
            ca5 = *(const f32x4*)(Am + 18 * AP + 20);
            ca6 = *(const f32x4*)(Am + 18 * AP + 24);
            ca7 = *(const f32x4*)(Am + 18 * AP + 28);
            __builtin_amdgcn_sched_barrier(0);
            x32 -= cb0[0] * x17; x33 -= cb0[1] * x17; x34 -= cb0[2] * x17; x35 -= cb0[3] * x17; x36 -= cb1[0] * x17; x37 -= cb1[1] * x17; x38 -= cb1[2] * x17; x39 -= cb1[3] * x17; x40 -= cb2[0] * x17; x41 -= cb2[1] * x17; x42 -= cb2[2] * x17; x43 -= cb2[3] * x17; x44 -= cb3[0] * x17; x45 -= cb3[1] * x17; x46 -= cb3[2] * x17; x47 -= cb3[3] * x17; x48 -= cb4[0] * x17; x49 -= cb4[1] * x17; x50 -= cb4[2] * x17; x51 -= cb4[3] * x17; x52 -= cb5[0] * x17; x53 -= cb5[1] * x17; x54 -= cb5[2] * x17; x55 -= cb5[3] * x17; x56 -= cb6[0] * x17; x57 -= cb6[1] * x17; x58 -= cb6[2] * x17; x59 -= cb6[3] * x17; x60 -= cb7[0] * x17; x61 -= cb7[1] * x17; x62 -= cb7[2] * x17; x63 -= cb7[3] * x17;
            __builtin_amdgcn_sched_barrier(0);
            cb0 = *(const f32x4*)(Am + 18 * AP + 32);
            cb1 = *(const f32x4*)(Am + 18 * AP + 36);
            cb2 = *(const f32x4*)(Am + 18 * AP + 40);
            cb3 = *(const f32x4*)(Am + 18 * AP + 44);
            cb4 = *(const f32x4*)(Am + 18 * AP + 48);
            cb5 = *(const f32x4*)(Am + 18 * AP + 52);
            cb6 = *(const f32x4*)(Am + 18 * AP + 56);
            cb7 = *(const f32x4*)(Am + 18 * AP + 60);
            __builtin_amdgcn_sched_barrier(0);
            x19 -= ca4[3] * x18; x20 -= ca5[0] * x18; x21 -= ca5[1] * x18; x22 -= ca5[2] * x18; x23 -= ca5[3] * x18; x24 -= ca6[0] * x18; x25 -= ca6[1] * x18; x26 -= ca6[2] * x18; x27 -= ca6[3] * x18; x28 -= ca7[0] * x18; x29 -= ca7[1] * x18; x30 -= ca7[2] * x18; x31 -= ca7[3] * x18;
            __builtin_amdgcn_sched_barrier(0);
            ca5 = *(const f32x4*)(Am + 19 * AP + 20);
            ca6 = *(const f32x4*)(Am + 19 * AP + 24);
            ca7 = *(const f32x4*)(Am + 19 * AP + 28);
            __builtin_amdgcn_sched_barrier(0);
            x32 -= cb0[0] * x18; x33 -= cb0[1] * x18; x34 -= cb0[2] * x18; x35 -= cb0[3] * x18; x36 -= cb1[0] * x18; x37 -= cb1[1] * x18; x38 -= cb1[2] * x18; x39 -= cb1[3] * x18; x40 -= cb2[0] * x18; x41 -= cb2[1] * x18; x42 -= cb2[2] * x18; x43 -= cb2[3] * x18; x44 -= cb3[0] * x18; x45 -= cb3[1] * x18; x46 -= cb3[2] * x18; x47 -= cb3[3] * x18; x48 -= cb4[0] * x18; x49 -= cb4[1] * x18; x50 -= cb4[2] * x18; x51 -= cb4[3] * x18; x52 -= cb5[0] * x18; x53 -= cb5[1] * x18; x54 -= cb5[2] * x18; x55 -= cb5[3] * x18; x56 -= cb6[0] * x18; x57 -= cb6[1] * x18; x58 -= cb6[2] * x18; x59 -= cb6[3] * x18; x60 -= cb7[0] * x18; x61 -= cb7[1] * x18; x62 -= cb7[2] * x18; x63 -= cb7[3] * x18;
            __builtin_amdgcn_sched_barrier(0);
            cb0 = *(const f32x4*)(Am + 19 * AP + 32);
            cb1 = *(const f32x4*)(Am + 19 * AP + 36);
            cb2 = *(const f32x4*)(Am + 19 * AP + 40);
            cb3 = *(const f32x4*)(Am + 19 * AP + 44);
            cb4 = *(const f32x4*)(Am + 19 * AP + 48);
            cb5 = *(const f32x4*)(Am + 19 * AP + 52);
            cb6 = *(const f32x4*)(Am + 19 * AP + 56);
            cb7 = *(const f32x4*)(Am + 19 * AP + 60);
            __builtin_amdgcn_sched_barrier(0);
            x20 -= ca5[0] * x19; x21 -= ca5[1] * x19; x22 -= ca5[2] * x19; x23 -= ca5[3] * x19; x24 -= ca6[0] * x19; x25 -= ca6[1] * x19; x26 -= ca6[2] * x19; x27 -= ca6[3] * x19; x28 -= ca7[0] * x19; x29 -= ca7[1] * x19; x30 -= ca7[2] * x19; x31 -= ca7[3] * x19;
            __builtin_amdgcn_sched_barrier(0);
            ca5 = *(const f32x4*)(Am + 20 * AP + 20);
            ca6 = *(const f32x4*)(Am + 20 * AP + 24);
            ca7 = *(const f32x4*)(Am + 20 * AP + 28);
            __builtin_amdgcn_sched_barrier(0);
            x32 -= cb0[0] * x19; x33 -= cb0[1] * x19; x34 -= cb0[2] * x19; x35 -= cb0[3] * x19; x36 -= cb1[0] * x19; x37 -= cb1[1] * x19; x38 -= cb1[2] * x19; x39 -= cb1[3] * x19; x40 -= cb2[0] * x19; x41 -= cb2[1] * x19; x42 -= cb2[2] * x19; x43 -= cb2[3] * x19; x44 -= cb3[0] * x19; x45 -= cb3[1] * x19; x46 -= cb3[2] * x19; x47 -= cb3[3] * x19; x48 -= cb4[0] * x19; x49 -= cb4[1] * x19; x50 -= cb4[2] * x19; x51 -= cb4[3] * x19; x52 -= cb5[0] * x19; x53 -= cb5[1] * x19; x54 -= cb5[2] * x19; x55 -= cb5[3] * x19; x56 -= cb6[0] * x19; x57 -= cb6[1] * x19; x58 -= cb6[2] * x19; x59 -= cb6[3] * x19; x60 -= cb7[0] * x19; x61 -= cb7[1] * x19; x62 -= cb7[2] * x19; x63 -= cb7[3] * x19;
            __builtin_amdgcn_sched_barrier(0);
            cb0 = *(const f32x4*)(Am + 20 * AP + 32);
            cb1 = *(const f32x4*)(Am + 20 * AP + 36);
            cb2 = *(const f32x4*)(Am + 20 * AP + 40);
            cb3 = *(const f32x4*)(Am + 20 * AP + 44);
            cb4 = *(const f32x4*)(Am + 20 * AP + 48);
            cb5 = *(const f32x4*)(Am + 20 * AP + 52);
            cb6 = *(const f32x4*)(Am + 20 * AP + 56);
            cb7 = *(const f32x4*)(Am + 20 * AP + 60);
            __builtin_amdgcn_sched_barrier(0);
            x21 -= ca5[1] * x20; x22 -= ca5[2] * x20; x23 -= ca5[3] * x20; x24 -= ca6[0] * x20; x25 -= ca6[1] * x20; x26 -= ca6[2] * x20; x27 -= ca6[3] * x20; x28 -= ca7[0] * x20; x29 -= ca7[1] * x20; x30 -= ca7[2] * x20; x31 -= ca7[3] * x20;
            __builtin_amdgcn_sched_barrier(0);
            ca5 = *(const f32x4*)(Am + 21 * AP + 20);
            ca6 = *(const f32x4*)(Am + 21 * AP + 24);
            ca7 = *(const f32x4*)(Am + 21 * AP + 28);
            __builtin_amdgcn_sched_barrier(0);
            x32 -= cb0[0] * x20; x33 -= cb0[1] * x20; x34 -= cb0[2] * x20; x35 -= cb0[3] * x20; x36 -= cb1[0] * x20; x37 -= cb1[1] * x20; x38 -= cb1[2] * x20; x39 -= cb1[3] * x20; x40 -= cb2[0] * x20; x41 -= cb2[1] * x20; x42 -= cb2[2] * x20; x43 -= cb2[3] * x20; x44 -= cb3[0] * x20; x45 -= cb3[1] * x20; x46 -= cb3[2] * x20; x47 -= cb3[3] * x20; x48 -= cb4[0] * x20; x49 -= cb4[1] * x20; x50 -= cb4[2] * x20; x51 -= cb4[3] * x20; x52 -= cb5[0] * x20; x53 -= cb5[1] * x20; x54 -= cb5[2] * x20; x55 -= cb5[3] * x20; x56 -= cb6[0] * x20; x57 -= cb6[1] * x20; x58 -= cb6[2] * x20; x59 -= cb6[3] * x20; x60 -= cb7[0] * x20; x61 -= cb7[1] * x20; x62 -= cb7[2] * x20; x63 -= cb7[3] * x20;
            __builtin_amdgcn_sched_barrier(0);
            cb0 = *(const f32x4*)(Am + 21 * AP + 32);
            cb1 = *(const f32x4*)(Am + 21 * AP + 36);
            cb2 = *(const f32x4*)(Am + 21 * AP + 40);
            cb3 = *(const f32x4*)(Am + 21 * AP + 44);
            cb4 = *(const f32x4*)(Am + 21 * AP + 48);
            cb5 = *(const f32x4*)(Am + 21 * AP + 52);
            cb6 = *(const f32x4*)(Am + 21 * AP + 56);
            cb7 = *(const f32x4*)(Am + 21 * AP + 60);
            __builtin_amdgcn_sched_barrier(0);
            x22 -= ca5[2] * x21; x23 -= ca5[3] * x21; x24 -= ca6[0] * x21; x25 -= ca6[1] * x21; x26 -= ca6[2] * x21; x27 -= ca6[3] * x21; x28 -= ca7[0] * x21; x29 -= ca7[1] * x21; x30 -= ca7[2] * x21; x31 -= ca7[3] * x21;
            __builtin_amdgcn_sched_barrier(0);
            ca5 = *(const f32x4*)(Am + 22 * AP + 20);
            ca6 = *(const f32x4*)(Am + 22 * AP + 24);
            ca7 = *(const f32x4*)(Am + 22 * AP + 28);
            __builtin_amdgcn_sched_barrier(0);
            x32 -= cb0[0] * x21; x33 -= cb0[1] * x21; x34 -= cb0[2] * x21; x35 -= cb0[3] * x21; x36 -= cb1[0] * x21; x37 -= cb1[1] * x21; x38 -= cb1[2] * x21; x39 -= cb1[3] * x21; x40 -= cb2[0] * x21; x41 -= cb2[1] * x21; x42 -= cb2[2] * x21; x43 -= cb2[3] * x21; x44 -= cb3[0] * x21; x45 -= cb3[1] * x21; x46 -= cb3[2] * x21; x47 -= cb3[3] * x21; x48 -= cb4[0] * x21; x49 -= cb4[1] * x21; x50 -= cb4[2] * x21; x51 -= cb4[3] * x21; x52 -= cb5[0] * x21; x53 -= cb5[1] * x21; x54 -= cb5[2] * x21; x55 -= cb5[3] * x21; x56 -= cb6[0] * x21; x57 -= cb6[1] * x21; x58 -= cb6[2] * x21; x59 -= cb6[3] * x21; x60 -= cb7[0] * x21; x61 -= cb7[1] * x21; x62 -= cb7[2] * x21; x63 -= cb7[3] * x21;
            __builtin_amdgcn_sched_barrier(0);
            cb0 = *(const f32x4*)(Am + 22 * AP + 32);
            cb1 = *(const f32x4*)(Am + 22 * AP + 36);
            cb2 = *(const f32x4*)(Am + 22 * AP + 40);
            cb3 = *(const f32x4*)(Am + 22 * AP + 44);
            cb4 = *(const f32x4*)(Am + 22 * AP + 48);
            cb5 = *(const f32x4*)(Am + 22 * AP + 52);
            cb6 = *(const f32x4*)(Am + 22 * AP + 56);
            cb7 = *(const f32x4*)(Am + 22 * AP + 60);
            __builtin_amdgcn_sched_barrier(0);
            x23 -= ca5[3] * x22; x24 -= ca6[0] * x22; x25 -= ca6[1] * x22; x26 -= ca6[2] * x22; x27 -= ca6[3] * x22; x28 -= ca7[0] * x22; x29 -= ca7[1] * x22; x30 -= ca7[2] * x22; x31 -= ca7[3] * x22;
            __builtin_amdgcn_sched_barrier(0);
            ca6 = *(const f32x4*)(Am + 23 * AP + 24);
            ca7 = *(const f32x4*)(Am + 23 * AP + 28);
            __builtin_amdgcn_sched_barrier(0);
            x32 -= cb0[0] * x22; x33 -= cb0[1] * x22; x34 -= cb0[2] * x22; x35 -= cb0[3] * x22; x36 -= cb1[0] * x22; x37 -= cb1[1] * x22; x38 -= cb1[2] * x22; x39 -= cb1[3] * x22; x40 -= cb2[0] * x22; x41 -= cb2[1] * x22; x42 -= cb2[2] * x22; x43 -= cb2[3] * x22; x44 -= cb3[0] * x22; x45 -= cb3[1] * x22; x46 -= cb3[2] * x22; x47 -= cb3[3] * x22; x48 -= cb4[0] * x22; x49 -= cb4[1] * x22; x50 -= cb4[2] * x22; x51 -= cb4[3] * x22; x52 -= cb5[0] * x22; x53 -= cb5[1] * x22; x54 -= cb5[2] * x22; x55 -= cb5[3] * x22; x56 -= cb6[0] * x22; x57 -= cb6[1] * x22; x58 -= cb6[2] * x22; x59 -= cb6[3] * x22; x60 -= cb7[0] * x22; x61 -= cb7[1] * x22; x62 -= cb7[2] * x22; x63 -= cb7[3] * x22;
            __builtin_amdgcn_sched_barrier(0);
            cb0 = *(const f32x4*)(Am + 23 * AP + 32);
            cb1 = *(const f32x4*)(Am + 23 * AP + 36);
            cb2 = *(const f32x4*)(Am + 23 * AP + 40);
            cb3 = *(const f32x4*)(Am + 23 * AP + 44);
            cb4 = *(const f32x4*)(Am + 23 * AP + 48);
            cb5 = *(const f32x4*)(Am + 23 * AP + 52);
            cb6 = *(const f32x4*)(Am + 23 * AP + 56);
            cb7 = *(const f32x4*)(Am + 23 * AP + 60);
            __builtin_amdgcn_sched_barrier(0);
            x24 -= ca6[0] * x23; x25 -= ca6[1] * x23; x26 -= ca6[2] * x23; x27 -= ca6[3] * x23; x28 -= ca7[0] * x23; x29 -= ca7[1] * x23; x30 -= ca7[2] * x23; x31 -= ca7[3] * x23;
            __builtin_amdgcn_sched_barrier(0);
            ca6 = *(const f32x4*)(Am + 24 * AP + 24);
            ca7 = *(const f32x4*)(Am + 24 * AP + 28);
            __builtin_amdgcn_sched_barrier(0);
            x32 -= cb0[0] * x23; x33 -= cb0[1] * x23; x34 -= cb0[2] * x23; x35 -= cb0[3] * x23; x36 -= cb1[0] * x23; x37 -= cb1[1] * x23; x38 -= cb1[2] * x23; x39 -= cb1[3] * x23; x40 -= cb2[0] * x23; x41 -= cb2[1] * x23; x42 -= cb2[2] * x23; x43 -= cb2[3] * x23; x44 -= cb3[0] * x23; x45 -= cb3[1] * x23; x46 -= cb3[2] * x23; x47 -= cb3[3] * x23; x48 -= cb4[0] * x23; x49 -= cb4[1] * x23; x50 -= cb4[2] * x23; x51 -= cb4[3] * x23; x52 -= cb5[0] * x23; x53 -= cb5[1] * x23; x54 -= cb5[2] * x23; x55 -= cb5[3] * x23; x56 -= cb6[0] * x23; x57 -= cb6[1] * x23; x58 -= cb6[2] * x23; x59 -= cb6[3] * x23; x60 -= cb7[0] * x23; x61 -= cb7[1] * x23; x62 -= cb7[2] * x23; x63 -= cb7[3] * x23;
            __builtin_amdgcn_sched_barrier(0);
            cb0 = *(const f32x4*)(Am + 24 * AP + 32);
            cb1 = *(const f32x4*)(Am + 24 * AP + 36);
            cb2 = *(const f32x4*)(Am + 24 * AP + 40);
            cb3 = *(const f32x4*)(Am + 24 * AP + 44);
            cb4 = *(const f32x4*)(Am + 24 * AP + 48);
            cb5 = *(const f32x4*)(Am + 24 * AP + 52);
            cb6 = *(const f32x4*)(Am + 24 * AP + 56);
            cb7 = *(const f32x4*)(Am + 24 * AP + 60);
            __builtin_amdgcn_sched_barrier(0);
            x25 -= ca6[1] * x24; x26 -= ca6[2] * x24; x27 -= ca6[3] * x24; x28 -= ca7[0] * x24; x29 -= ca7[1] * x24; x30 -= ca7[2] * x24; x31 -= ca7[3] * x24;
            __builtin_amdgcn_sched_barrier(0);
            ca6 = *(const f32x4*)(Am + 25 * AP + 24);
            ca7 = *(const f32x4*)(Am + 25 * AP + 28);
            __builtin_amdgcn_sched_barrier(0);
            x32 -= cb0[0] * x24; x33 -= cb0[1] * x24; x34 -= cb0[2] * x24; x35 -= cb0[3] * x24; x36 -= cb1[0] * x24; x37 -= cb1[1] * x24; x38 -= cb1[2] * x24; x39 -= cb1[3] * x24; x40 -= cb2[0] * x24; x41 -= cb2[1] * x24; x42 -= cb2[2] * x24; x43 -= cb2[3] * x24; x44 -= cb3[0] * x24; x45 -= cb3[1] * x24; x46 -= cb3[2] * x24; x47 -= cb3[3] * x24; x48 -= cb4[0] * x24; x49 -= cb4[1] * x24; x50 -= cb4[2] * x24; x51 -= cb4[3] * x24; x52 -= cb5[0] * x24; x53 -= cb5[1] * x24; x54 -= cb5[2] * x24; x55 -= cb5[3] * x24; x56 -= cb6[0] * x24; x57 -= cb6[1] * x24; x58 -= cb6[2] * x24; x59 -= cb6[3] * x24; x60 -= cb7[0] * x24; x61 -= cb7[1] * x24; x62 -= cb7[2] * x24; x63 -= cb7[3] * x24;
            __builtin_amdgcn_sched_barrier(0);
            cb0 = *(const f32x4*)(Am + 25 * AP + 32);
            cb1 = *(const f32x4*)(Am + 25 * AP + 36);
            cb2 = *(const f32x4*)(Am + 25 * AP + 40);
            cb3 = *(const f32x4*)(Am + 25 * AP + 44);
            cb4 = *(const f32x4*)(Am + 25 * AP + 48);
            cb5 = *(const f32x4*)(Am + 25 * AP + 52);
            cb6 = *(const f32x4*)(Am + 25 * AP + 56);
            cb7 = *(const f32x4*)(Am + 25 * AP + 60);
            __builtin_amdgcn_sched_barrier(0);
            x26 -= ca6[2] * x25; x27 -= ca6[3] * x25; x28 -= ca7[0] * x25; x29 -= ca7[1] * x25; x30 -= ca7[2] * x25; x31 -= ca7[3] * x25;
            __builtin_amdgcn_sched_barrier(0);
            ca6 = *(const f32x4*)(Am + 26 * AP + 24);
            ca7 = *(const f32x4*)(Am + 26 * AP + 28);
            __builtin_amdgcn_sched_barrier(0);
            x32 -= cb0[0] * x25; x33 -= cb0[1] * x25; x34 -= cb0[2] * x25; x35 -= cb0[3] * x25; x36 -= cb1[0] * x25; x37 -= cb1[1] * x25; x38 -= cb1[2] * x25; x39 -= cb1[3] * x25; x40 -= cb2[0] * x25; x41 -= cb2[1] * x25; x42 -= cb2[2] * x25; x43 -= cb2[3] * x25; x44 -= cb3[0] * x25; x45 -= cb3[1] * x25; x46 -= cb3[2] * x25; x47 -= cb3[3] * x25; x48 -= cb4[0] * x25; x49 -= cb4[1] * x25; x50 -= cb4[2] * x25; x51 -= cb4[3] * x25; x52 -= cb5[0] * x25; x53 -= cb5[1] * x25; x54 -= cb5[2] * x25; x55 -= cb5[3] * x25; x56 -= cb6[0] * x25; x57 -= cb6[1] * x25; x58 -= cb6[2] * x25; x59 -= cb6[3] * x25; x60 -= cb7[0] * x25; x61 -= cb7[1] * x25; x62 -= cb7[2] * x25; x63 -= cb7[3] * x25;
            __builtin_amdgcn_sched_barrier(0);
            cb0 = *(const f32x4*)(Am + 26 * AP + 32);
            cb1 = *(const f32x4*)(Am + 26 * AP + 36);
            cb2 = *(const f32x4*)(Am + 26 * AP + 40);
            cb3 = *(const f32x4*)(Am + 26 * AP + 44);
            cb4 = *(const f32x4*)(Am + 26 * AP + 48);
            cb5 = *(const f32x4*)(Am + 26 * AP + 52);
            cb6 = *(const f32x4*)(Am + 26 * AP + 56);
            cb7 = *(const f32x4*)(Am + 26 * AP + 60);
            __builtin_amdgcn_sched_barrier(0);
            x27 -= ca6[3] * x26; x28 -= ca7[0] * x26; x29 -= ca7[1] * x26; x30 -= ca7[2] * x26; x31 -= ca7[3] * x26;
            __builtin_amdgcn_sched_barrier(0);
            ca7 = *(const f32x4*)(Am + 27 * AP + 28);
            __builtin_amdgcn_sched_barrier(0);
            x32 -= cb0[0] * x26; x33 -= cb0[1] * x26; x34 -= cb0[2] * x26; x35 -= cb0[3] * x26; x36 -= cb1[0] * x26; x37 -= cb1[1] * x26; x38 -= cb1[2] * x26; x39 -= cb1[3] * x26; x40 -= cb2[0] * x26; x41 -= cb2[1] * x26; x42 -= cb2[2] * x26; x43 -= cb2[3] * x26; x44 -= cb3[0] * x26; x45 -= cb3[1] * x26; x46 -= cb3[2] * x26; x47 -= cb3[3] * x26; x48 -= cb4[0] * x26; x49 -= cb4[1] * x26; x50 -= cb4[2] * x26; x51 -= cb4[3] * x26; x52 -= cb5[0] * x26; x53 -= cb5[1] * x26; x54 -= cb5[2] * x26; x55 -= cb5[3] * x26; x56 -= cb6[0] * x26; x57 -= cb6[1] * x26; x58 -= cb6[2] * x26; x59 -= cb6[3] * x26; x60 -= cb7[0] * x26; x61 -= cb7[1] * x26; x62 -= cb7[2] * x26; x63 -= cb7[3] * x26;
            __builtin_amdgcn_sched_barrier(0);
            cb0 = *(const f32x4*)(Am + 27 * AP + 32);
            cb1 = *(const f32x4*)(Am + 27 * AP + 36);
            cb2 = *(const f32x4*)(Am + 27 * AP + 40);
            cb3 = *(const f32x4*)(Am + 27 * AP + 44);
            cb4 = *(const f32x4*)(Am + 27 * AP + 48);
            cb5 = *(const f32x4*)(Am + 27 * AP + 52);
            cb6 = *(const f32x4*)(Am + 27 * AP + 56);
            cb7 = *(const f32x4*)(Am + 27 * AP + 60);
            __builtin_amdgcn_sched_barrier(0);
            x28 -= ca7[0] * x27; x29 -= ca7[1] * x27; x30 -= ca7[2] * x27; x31 -= ca7[3] * x27;
            __builtin_amdgcn_sched_barrier(0);
            ca7 = *(const f32x4*)(Am + 28 * AP + 28);
            __builtin_amdgcn_sched_barrier(0);
            x32 -= cb0[0] * x27; x33 -= cb0[1] * x27; x34 -= cb0[2] * x27; x35 -= cb0[3] * x27; x36 -= cb1[0] * x27; x37 -= cb1[1] * x27; x38 -= cb1[2] * x27; x39 -= cb1[3] * x27; x40 -= cb2[0] * x27; x41 -= cb2[1] * x27; x42 -= cb2[2] * x27; x43 -= cb2[3] * x27; x44 -= cb3[0] * x27; x45 -= cb3[1] * x27; x46 -= cb3[2] * x27; x47 -= cb3[3] * x27; x48 -= cb4[0] * x27; x49 -= cb4[1] * x27; x50 -= cb4[2] * x27; x51 -= cb4[3] * x27; x52 -= cb5[0] * x27; x53 -= cb5[1] * x27; x54 -= cb5[2] * x27; x55 -= cb5[3] * x27; x56 -= cb6[0] * x27; x57 -= cb6[1] * x27; x58 -= cb6[2] * x27; x59 -= cb6[3] * x27; x60 -= cb7[0] * x27; x61 -= cb7[1] * x27; x62 -= cb7[2] * x27; x63 -= cb7[3] * x27;
            __builtin_amdgcn_sched_barrier(0);
            cb0 = *(const f32x4*)(Am + 28 * AP + 32);
            cb1 = *(const f32x4*)(Am + 28 * AP + 36);
            cb2 = *(const f32x4*)(Am + 28 * AP + 40);
            cb3 = *(const f32x4*)(Am + 28 * AP + 44);
            cb4 = *(const f32x4*)(Am + 28 * AP + 48);
            cb5 = *(const f32x4*)(Am + 28 * AP + 52);
            cb6 = *(const f32x4*)(Am + 28 * AP + 56);
            cb7 = *(const f32x4*)(Am + 28 * AP + 60);
            __builtin_amdgcn_sched_barrier(0);
            x29 -= ca7[1] * x28; x30 -= ca7[2] * x28; x31 -= ca7[3] * x28;
            __builtin_amdgcn_sched_barrier(0);
            ca7 = *(const f32x4*)(Am + 29 * AP + 28);
            __builtin_amdgcn_sched_barrier(0);
            x32 -= cb0[0] * x28; x33 -= cb0[1] * x28; x34 -= cb0[2] * x28; x35 -= cb0[3] * x28; x36 -= cb1[0] * x28; x37 -= cb1[1] * x28; x38 -= cb1[2] * x28; x39 -= cb1[3] * x28; x40 -= cb2[0] * x28; x41 -= cb2[1] * x28; x42 -= cb2[2] * x28; x43 -= cb2[3] * x28; x44 -= cb3[0] * x28; x45 -= cb3[1] * x28; x46 -= cb3[2] * x28; x47 -= cb3[3] * x28; x48 -= cb4[0] * x28; x49 -= cb4[1] * x28; x50 -= cb4[2] * x28; x51 -= cb4[3] * x28; x52 -= cb5[0] * x28; x53 -= cb5[1] * x28; x54 -= cb5[2] * x28; x55 -= cb5[3] * x28; x56 -= cb6[0] * x28; x57 -= cb6[1] * x28; x58 -= cb6[2] * x28; x59 -= cb6[3] * x28; x60 -= cb7[0] * x28; x61 -= cb7[1] * x28; x62 -= cb7[2] * x28; x63 -= cb7[3] * x28;
            __builtin_amdgcn_sched_barrier(0);
            cb0 = *(const f32x4*)(Am + 29 * AP + 32);
            cb1 = *(const f32x4*)(Am + 29 * AP + 36);
            cb2 = *(const f32x4*)(Am + 29 * AP + 40);
            cb3 = *(const f32x4*)(Am + 29 * AP + 44);
            cb4 = *(const f32x4*)(Am + 29 * AP + 48);
            cb5 = *(const f32x4*)(Am + 29 * AP + 52);
            cb6 = *(const f32x4*)(Am + 29 * AP + 56);
            cb7 = *(const f32x4*)(Am + 29 * AP + 60);
            __builtin_amdgcn_sched_barrier(0);
            x30 -= ca7[2] * x29; x31 -= ca7[3] * x29;
            __builtin_amdgcn_sched_barrier(0);
            ca7 = *(const f32x4*)(Am + 30 * AP + 28);
            __builtin_amdgcn_sched_barrier(0);
            x32 -= cb0[0] * x29; x33 -= cb0[1] * x29; x34 -= cb0[2] * x29; x35 -= cb0[3] * x29; x36 -= cb1[0] * x29; x37 -= cb1[1] * x29; x38 -= cb1[2] * x29; x39 -= cb1[3] * x29; x40 -= cb2[0] * x29; x41 -= cb2[1] * x29; x42 -= cb2[2] * x29; x43 -= cb2[3] * x29; x44 -= cb3[0] * x29; x45 -= cb3[1] * x29; x46 -= cb3[2] * x29; x47 -= cb3[3] * x29; x48 -= cb4[0] * x29; x49 -= cb4[1] * x29; x50 -= cb4[2] * x29; x51 -= cb4[3] * x29; x52 -= cb5[0] * x29; x53 -= cb5[1] * x29; x54 -= cb5[2] * x29; x55 -= cb5[3] * x29; x56 -= cb6[0] * x29; x57 -= cb6[1] * x29; x58 -= cb6[2] * x29; x59 -= cb6[3] * x29; x60 -= cb7[0] * x29; x61 -= cb7[1] * x29; x62 -= cb7[2] * x29; x63 -= cb7[3] * x29;
            __builtin_amdgcn_sched_barrier(0);
            cb0 = *(const f32x4*)(Am + 30 * AP + 32);
            cb1 = *(const f32x4*)(Am + 30 * AP + 36);
            cb2 = *(const f32x4*)(Am + 30 * AP + 40);
            cb3 = *(const f32x4*)(Am + 30 * AP + 44);
            cb4 = *(const f32x4*)(Am + 30 * AP + 48);
            cb5 = *(const f32x4*)(Am + 30 * AP + 52);
            cb6 = *(const f32x4*)(Am + 30 * AP + 56);
            cb7 = *(const f32x4*)(Am + 30 * AP + 60);
            __builtin_amdgcn_sched_barrier(0);
            x31 -= ca7[3] * x30;
            __builtin_amdgcn_sched_barrier(0);
            __builtin_amdgcn_sched_barrier(0);
            x32 -= cb0[0] * x30; x33 -= cb0[1] * x30; x34 -= cb0[2] * x30; x35 -= cb0[3] * x30; x36 -= cb1[0] * x30; x37 -= cb1[1] * x30; x38 -= cb1[2] * x30; x39 -= cb1[3] * x30; x40 -= cb2[0] * x30; x41 -= cb2[1] * x30; x42 -= cb2[2] * x30; x43 -= cb2[3] * x30; x44 -= cb3[0] * x30; x45 -= cb3[1] * x30; x46 -= cb3[2] * x30; x47 -= cb3[3] * x30; x48 -= cb4[0] * x30; x49 -= cb4[1] * x30; x50 -= cb4[2] * x30; x51 -= cb4[3] * x30; x52 -= cb5[0] * x30; x53 -= cb5[1] * x30; x54 -= cb5[2] * x30; x55 -= cb5[3] * x30; x56 -= cb6[0] * x30; x57 -= cb6[1] * x30; x58 -= cb6[2] * x30; x59 -= cb6[3] * x30; x60 -= cb7[0] * x30; x61 -= cb7[1] * x30; x62 -= cb7[2] * x30; x63 -= cb7[3] * x30;
            __builtin_amdgcn_sched_barrier(0);
            cb0 = *(const f32x4*)(Am + 31 * AP + 32);
            cb1 = *(const f32x4*)(Am + 31 * AP + 36);
            cb2 = *(const f32x4*)(Am + 31 * AP + 40);
            cb3 = *(const f32x4*)(Am + 31 * AP + 44);
            cb4 = *(const f32x4*)(Am + 31 * AP + 48);
            cb5 = *(const f32x4*)(Am + 31 * AP + 52);
            cb6 = *(const f32x4*)(Am + 31 * AP + 56);
            cb7 = *(const f32x4*)(Am + 31 * AP + 60);
            __builtin_amdgcn_sched_barrier(0);

            __builtin_amdgcn_sched_barrier(0);
            ca0 = *(const f32x4*)(Am + 32 * AP + 32);
            ca1 = *(const f32x4*)(Am + 32 * AP + 36);
            ca2 = *(const f32x4*)(Am + 32 * AP + 40);
            ca3 = *(const f32x4*)(Am + 32 * AP + 44);
            ca4 = *(const f32x4*)(Am + 32 * AP + 48);
            ca5 = *(const f32x4*)(Am + 32 * AP + 52);
            ca6 = *(const f32x4*)(Am + 32 * AP + 56);
            ca7 = *(const f32x4*)(Am + 32 * AP + 60);
            __builtin_amdgcn_sched_barrier(0);
            x32 -= cb0[0] * x31; x33 -= cb0[1] * x31; x34 -= cb0[2] * x31; x35 -= cb0[3] * x31; x36 -= cb1[0] * x31; x37 -= cb1[1] * x31; x38 -= cb1[2] * x31; x39 -= cb1[3] * x31; x40 -= cb2[0] * x31; x41 -= cb2[1] * x31; x42 -= cb2[2] * x31; x43 -= cb2[3] * x31; x44 -= cb3[0] * x31; x45 -= cb3[1] * x31; x46 -= cb3[2] * x31; x47 -= cb3[3] * x31; x48 -= cb4[0] * x31; x49 -= cb4[1] * x31; x50 -= cb4[2] * x31; x51 -= cb4[3] * x31; x52 -= cb5[0] * x31; x53 -= cb5[1] * x31; x54 -= cb5[2] * x31; x55 -= cb5[3] * x31; x56 -= cb6[0] * x31; x57 -= cb6[1] * x31; x58 -= cb6[2] * x31; x59 -= cb6[3] * x31; x60 -= cb7[0] * x31; x61 -= cb7[1] * x31; x62 -= cb7[2] * x31; x63 -= cb7[3] * x31;
            __builtin_amdgcn_sched_barrier(0);
            cb0 = *(const f32x4*)(Am + 33 * AP + 32);
            cb1 = *(const f32x4*)(Am + 33 * AP + 36);
            cb2 = *(const f32x4*)(Am + 33 * AP + 40);
            cb3 = *(const f32x4*)(Am + 33 * AP + 44);
            cb4 = *(const f32x4*)(Am + 33 * AP + 48);
            cb5 = *(const f32x4*)(Am + 33 * AP + 52);
            cb6 = *(const f32x4*)(Am + 33 * AP + 56);
            cb7 = *(const f32x4*)(Am + 33 * AP + 60);
            __builtin_amdgcn_sched_barrier(0);
            x33 -= ca0[1] * x32; x34 -= ca0[2] * x32; x35 -= ca0[3] * x32; x36 -= ca1[0] * x32; x37 -= ca1[1] * x32; x38 -= ca1[2] * x32; x39 -= ca1[3] * x32; x40 -= ca2[0] * x32; x41 -= ca2[1] * x32; x42 -= ca2[2] * x32; x43 -= ca2[3] * x32; x44 -= ca3[0] * x32; x45 -= ca3[1] * x32; x46 -= ca3[2] * x32; x47 -= ca3[3] * x32; x48 -= ca4[0] * x32; x49 -= ca4[1] * x32; x50 -= ca4[2] * x32; x51 -= ca4[3] * x32; x52 -= ca5[0] * x32; x53 -= ca5[1] * x32; x54 -= ca5[2] * x32; x55 -= ca5[3] * x32; x56 -= ca6[0] * x32; x57 -= ca6[1] * x32; x58 -= ca6[2] * x32; x59 -= ca6[3] * x32; x60 -= ca7[0] * x32; x61 -= ca7[1] * x32; x62 -= ca7[2] * x32; x63 -= ca7[3] * x32;
            __builtin_amdgcn_sched_barrier(0);
            ca0 = *(const f32x4*)(Am + 34 * AP + 32);
            ca1 = *(const f32x4*)(Am + 34 * AP + 36);
            ca2 = *(const f32x4*)(Am + 34 * AP + 40);
            ca3 = *(const f32x4*)(Am + 34 * AP + 44);
            ca4 = *(const f32x4*)(Am + 34 * AP + 48);
            ca5 = *(const f32x4*)(Am + 34 * AP + 52);
            ca6 = *(const f32x4*)(Am + 34 * AP + 56);
            ca7 = *(const f32x4*)(Am + 34 * AP + 60);
            __builtin_amdgcn_sched_barrier(0);
            x34 -= cb0[2] * x33; x35 -= cb0[3] * x33; x36 -= cb1[0] * x33; x37 -= cb1[1] * x33; x38 -= cb1[2] * x33; x39 -= cb1[3] * x33; x40 -= cb2[0] * x33; x41 -= cb2[1] * x33; x42 -= cb2[2] * x33; x43 -= cb2[3] * x33; x44 -= cb3[0] * x33; x45 -= cb3[1] * x33; x46 -= cb3[2] * x33; x47 -= cb3[3] * x33; x48 -= cb4[0] * x33; x49 -= cb4[1] * x33; x50 -= cb4[2] * x33; x51 -= cb4[3] * x33; x52 -= cb5[0] * x33; x53 -= cb5[1] * x33; x54 -= cb5[2] * x33; x55 -= cb5[3] * x33; x56 -= cb6[0] * x33; x57 -= cb6[1] * x33; x58 -= cb6[2] * x33; x59 -= cb6[3] * x33; x60 -= cb7[0] * x33; x61 -= cb7[1] * x33; x62 -= cb7[2] * x33; x63 -= cb7[3] * x33;
            __builtin_amdgcn_sched_barrier(0);
            cb1 = *(const f32x4*)(Am + 35 * AP + 36);
            cb2 = *(const f32x4*)(Am + 35 * AP + 40);
            cb3 = *(const f32x4*)(Am + 35 * AP + 44);
            cb4 = *(const f32x4*)(Am + 35 * AP + 48);
            cb5 = *(const f32x4*)(Am + 35 * AP + 52);
            cb6 = *(const f32x4*)(Am + 35 * AP + 56);
            cb7 = *(const f32x4*)(Am + 35 * AP + 60);
            __builtin_amdgcn_sched_barrier(0);
            x35 -= ca0[3] * x34; x36 -= ca1[0] * x34; x37 -= ca1[1] * x34; x38 -= ca1[2] * x34; x39 -= ca1[3] * x34; x40 -= ca2[0] * x34; x41 -= ca2[1] * x34; x42 -= ca2[2] * x34; x43 -= ca2[3] * x34; x44 -= ca3[0] * x34; x45 -= ca3[1] * x34; x46 -= ca3[2] * x34; x47 -= ca3[3] * x34; x48 -= ca4[0] * x34; x49 -= ca4[1] * x34; x50 -= ca4[2] * x34; x51 -= ca4[3] * x34; x52 -= ca5[0] * x34; x53 -= ca5[1] * x34; x54 -= ca5[2] * x34; x55 -= ca5[3] * x34; x56 -= ca6[0] * x34; x57 -= ca6[1] * x34; x58 -= ca6[2] * x34; x59 -= ca6[3] * x34; x60 -= ca7[0] * x34; x61 -= ca7[1] * x34; x62 -= ca7[2] * x34; x63 -= ca7[3] * x34;
            __builtin_amdgcn_sched_barrier(0);
            ca1 = *(const f32x4*)(Am + 36 * AP + 36);
            ca2 = *(const f32x4*)(Am + 36 * AP + 40);
            ca3 = *(const f32x4*)(Am + 36 * AP + 44);
            ca4 = *(const f32x4*)(Am + 36 * AP + 48);
            ca5 = *(const f32x4*)(Am + 36 * AP + 52);
            ca6 = *(const f32x4*)(Am + 36 * AP + 56);
            ca7 = *(const f32x4*)(Am + 36 * AP + 60);
            __builtin_amdgcn_sched_barrier(0);
            x36 -= cb1[0] * x35; x37 -= cb1[1] * x35; x38 -= cb1[2] * x35; x39 -= cb1[3] * x35; x40 -= cb2[0] * x35; x41 -= cb2[1] * x35; x42 -= cb2[2] * x35; x43 -= cb2[3] * x35; x44 -= cb3[0] * x35; x45 -= cb3[1] * x35; x46 -= cb3[2] * x35; x47 -= cb3[3] * x35; x48 -= cb4[0] * x35; x49 -= cb4[1] * x35; x50 -= cb4[2] * x35; x51 -= cb4[3] * x35; x52 -= cb5[0] * x35; x53 -= cb5[1] * x35; x54 -= cb5[2] * x35; x55 -= cb5[3] * x35; x56 -= cb6[0] * x35; x57 -= cb6[1] * x35; x58 -= cb6[2] * x35; x59 -= cb6[3] * x35; x60 -= cb7[0] * x35; x61 -= cb7[1] * x35; x62 -= cb7[2] * x35; x63 -= cb7[3] * x35;
            __builtin_amdgcn_sched_barrier(0);
            cb1 = *(const f32x4*)(Am + 37 * AP + 36);
            cb2 = *(const f32x4*)(Am + 37 * AP + 40);
            cb3 = *(const f32x4*)(Am + 37 * AP + 44);
            cb4 = *(const f32x4*)(Am + 37 * AP + 48);
            cb5 = *(const f32x4*)(Am + 37 * AP + 52);
            cb6 = *(const f32x4*)(Am + 37 * AP + 56);
            cb7 = *(const f32x4*)(Am + 37 * AP + 60);
            __builtin_amdgcn_sched_barrier(0);
            x37 -= ca1[1] * x36; x38 -= ca1[2] * x36; x39 -= ca1[3] * x36; x40 -= ca2[0] * x36; x41 -= ca2[1] * x36; x42 -= ca2[2] * x36; x43 -= ca2[3] * x36; x44 -= ca3[0] * x36; x45 -= ca3[1] * x36; x46 -= ca3[2] * x36; x47 -= ca3[3] * x36; x48 -= ca4[0] * x36; x49 -= ca4[1] * x36; x50 -= ca4[2] * x36; x51 -= ca4[3] * x36; x52 -= ca5[0] * x36; x53 -= ca5[1] * x36; x54 -= ca5[2] * x36; x55 -= ca5[3] * x36; x56 -= ca6[0] * x36; x57 -= ca6[1] * x36; x58 -= ca6[2] * x36; x59 -= ca6[3] * x36; x60 -= ca7[0] * x36; x61 -= ca7[1] * x36; x62 -= ca7[2] * x36; x63 -= ca7[3] * x36;
            __builtin_amdgcn_sched_barrier(0);
            ca1 = *(const f32x4*)(Am + 38 * AP + 36);
            ca2 = *(const f32x4*)(Am + 38 * AP + 40);
            ca3 = *(const f32x4*)(Am + 38 * AP + 44);
            ca4 = *(const f32x4*)(Am + 38 * AP + 48);
            ca5 = *(const f32x4*)(Am + 38 * AP + 52);
            ca6 = *(const f32x4*)(Am + 38 * AP + 56);
            ca7 = *(const f32x4*)(Am + 38 * AP + 60);
            __builtin_amdgcn_sched_barrier(0);
            x38 -= cb1[2] * x37; x39 -= cb1[3] * x37; x40 -= cb2[0] * x37; x41 -= cb2[1] * x37; x42 -= cb2[2] * x37; x43 -= cb2[3] * x37; x44 -= cb3[0] * x37; x45 -= cb3[1] * x37; x46 -= cb3[2] * x37; x47 -= cb3[3] * x37; x48 -= cb4[0] * x37; x49 -= cb4[1] * x37; x50 -= cb4[2] * x37; x51 -= cb4[3] * x37; x52 -= cb5[0] * x37; x53 -= cb5[1] * x37; x54 -= cb5[2] * x37; x55 -= cb5[3] * x37; x56 -= cb6[0] * x37; x57 -= cb6[1] * x37; x58 -= cb6[2] * x37; x59 -= cb6[3] * x37; x60 -= cb7[0] * x37; x61 -= cb7[1] * x37; x62 -= cb7[2] * x37; x63 -= cb7[3] * x37;
            __builtin_amdgcn_sched_barrier(0);
            cb2 = *(const f32x4*)(Am + 39 * AP + 40);
            cb3 = *(const f32x4*)(Am + 39 * AP + 44);
            cb4 = *(const f32x4*)(Am + 39 * AP + 48);
            cb5 = *(const f32x4*)(Am + 39 * AP + 52);
            cb6 = *(const f32x4*)(Am + 39 * AP + 56);
            cb7 = *(const f32x4*)(Am + 39 * AP + 60);
            __builtin_amdgcn_sched_barrier(0);
            x39 -= ca1[3] * x38; x40 -= ca2[0] * x38; x41 -= ca2[1] * x38; x42 -= ca2[2] * x38; x43 -= ca2[3] * x38; x44 -= ca3[0] * x38; x45 -= ca3[1] * x38; x46 -= ca3[2] * x38; x47 -= ca3[3] * x38; x48 -= ca4[0] * x38; x49 -= ca4[1] * x38; x50 -= ca4[2] * x38; x51 -= ca4[3] * x38; x52 -= ca5[0] * x38; x53 -= ca5[1] * x38; x54 -= ca5[2] * x38; x55 -= ca5[3] * x38; x56 -= ca6[0] * x38; x57 -= ca6[1] * x38; x58 -= ca6[2] * x38; x59 -= ca6[3] * x38; x60 -= ca7[0] * x38; x61 -= ca7[1] * x38; x62 -= ca7[2] * x38; x63 -= ca7[3] * x38;
            __builtin_amdgcn_sched_barrier(0);
            ca2 = *(const f32x4*)(Am + 40 * AP + 40);
            ca3 = *(const f32x4*)(Am + 40 * AP + 44);
            ca4 = *(const f32x4*)(Am + 40 * AP + 48);
            ca5 = *(const f32x4*)(Am + 40 * AP + 52);
            ca6 = *(const f32x4*)(Am + 40 * AP + 56);
            ca7 = *(const f32x4*)(Am + 40 * AP + 60);
            __builtin_amdgcn_sched_barrier(0);
            x40 -= cb2[0] * x39; x41 -= cb2[1] * x39; x42 -= cb2[2] * x39; x43 -= cb2[3] * x39; x44 -= cb3[0] * x39; x45 -= cb3[1] * x39; x46 -= cb3[2] * x39; x47 -= cb3[3] * x39; x48 -= cb4[0] * x39; x49 -= cb4[1] * x39; x50 -= cb4[2] * x39; x51 -= cb4[3] * x39; x52 -= cb5[0] * x39; x53 -= cb5[1] * x39; x54 -= cb5[2] * x39; x55 -= cb5[3] * x39; x56 -= cb6[0] * x39; x57 -= cb6[1] * x39; x58 -= cb6[2] * x39; x59 -= cb6[3] * x39; x60 -= cb7[0] * x39; x61 -= cb7[1] * x39; x62 -= cb7[2] * x39; x63 -= cb7[3] * x39;
            __builtin_amdgcn_sched_barrier(0);
            cb2 = *(const f32x4*)(Am + 41 * AP + 40);
            cb3 = *(const f32x4*)(Am + 41 * AP + 44);
            cb4 = *(const f32x4*)(Am + 41 * AP + 48);
            cb5 = *(const f32x4*)(Am + 41 * AP + 52);
            cb6 = *(const f32x4*)(Am + 41 * AP + 56);
            cb7 = *(const f32x4*)(Am + 41 * AP + 60);
            __builtin_amdgcn_sched_barrier(0);
            x41 -= ca2[1] * x40; x42 -= ca2[2] * x40; x43 -= ca2[3] * x40; x44 -= ca3[0] * x40; x45 -= ca3[1] * x40; x46 -= ca3[2] * x40; x47 -= ca3[3] * x40; x48 -= ca4[0] * x40; x49 -= ca4[1] * x40; x50 -= ca4[2] * x40; x51 -= ca4[3] * x40; x52 -= ca5[0] * x40; x53 -= ca5[1] * x40; x54 -= ca5[2] * x40; x55 -= ca5[3] * x40; x56 -= ca6[0] * x40; x57 -= ca6[1] * x40; x58 -= ca6[2] * x40; x59 -= ca6[3] * x40; x60 -= ca7[0] * x40; x61 -= ca7[1] * x40; x62 -= ca7[2] * x40; x63 -= ca7[3] * x40;
            __builtin_amdgcn_sched_barrier(0);
            ca2 = *(const f32x4*)(Am + 42 * AP + 40);
            ca3 = *(const f32x4*)(Am + 42 * AP + 44);
            ca4 = *(const f32x4*)(Am + 42 * AP + 48);
            ca5 = *(const f32x4*)(Am + 42 * AP + 52);
            ca6 = *(const f32x4*)(Am + 42 * AP + 56);
            ca7 = *(const f32x4*)(Am + 42 * AP + 60);
            __builtin_amdgcn_sched_barrier(0);
            x42 -= cb2[2] * x41; x43 -= cb2[3] * x41; x44 -= cb3[0] * x41; x45 -= cb3[1] * x41; x46 -= cb3[2] * x41; x47 -= cb3[3] * x41; x48 -= cb4[0] * x41; x49 -= cb4[1] * x41; x50 -= cb4[2] * x41; x51 -= cb4[3] * x41; x52 -= cb5[0] * x41; x53 -= cb5[1] * x41; x54 -= cb5[2] * x41; x55 -= cb5[3] * x41; x56 -= cb6[0] * x41; x57 -= cb6[1] * x41; x58 -= cb6[2] * x41; x59 -= cb6[3] * x41; x60 -= cb7[0] * x41; x61 -= cb7[1] * x41; x62 -= cb7[2] * x41; x63 -= cb7[3] * x41;
            __builtin_amdgcn_sched_barrier(0);
            cb3 = *(const f32x4*)(Am + 43 * AP + 44);
            cb4 = *(const f32x4*)(Am + 43 * AP + 48);
            cb5 = *(const f32x4*)(Am + 43 * AP + 52);
            cb6 = *(const f32x4*)(Am + 43 * AP + 56);
            cb7 = *(const f32x4*)(Am + 43 * AP + 60);
            __builtin_amdgcn_sched_barrier(0);
            x43 -= ca2[3] * x42; x44 -= ca3[0] * x42; x45 -= ca3[1] * x42; x46 -= ca3[2] * x42; x47 -= ca3[3] * x42; x48 -= ca4[0] * x42; x49 -= ca4[1] * x42; x50 -= ca4[2] * x42; x51 -= ca4[3] * x42; x52 -= ca5[0] * x42; x53 -= ca5[1] * x42; x54 -= ca5[2] * x42; x55 -= ca5[3] * x42; x56 -= ca6[0] * x42; x57 -= ca6[1] * x42; x58 -= ca6[2] * x42; x59 -= ca6[3] * x42; x60 -= ca7[0] * x42; x61 -= ca7[1] * x42; x62 -= ca7[2] * x42; x63 -= ca7[3] * x42;
            __builtin_amdgcn_sched_barrier(0);
            ca3 = *(const f32x4*)(Am + 44 * AP + 44);
            ca4 = *(const f32x4*)(Am + 44 * AP + 48);
            ca5 = *(const f32x4*)(Am + 44 * AP + 52);
            ca6 = *(const f32x4*)(Am + 44 * AP + 56);
            ca7 = *(const f32x4*)(Am + 44 * AP + 60);
            __builtin_amdgcn_sched_barrier(0);
            x44 -= cb3[0] * x43; x45 -= cb3[1] * x43; x46 -= cb3[2] * x43; x47 -= cb3[3] * x43; x48 -= cb4[0] * x43; x49 -= cb4[1] * x43; x50 -= cb4[2] * x43; x51 -= cb4[3] * x43; x52 -= cb5[0] * x43; x53 -= cb5[1] * x43; x54 -= cb5[2] * x43; x55 -= cb5[3] * x43; x56 -= cb6[0] * x43; x57 -= cb6[1] * x43; x58 -= cb6[2] * x43; x59 -= cb6[3] * x43; x60 -= cb7[0] * x43; x61 -= cb7[1] * x43; x62 -= cb7[2] * x43; x63 -= cb7[3] * x43;
            __builtin_amdgcn_sched_barrier(0);
            cb3 = *(const f32x4*)(Am + 45 * AP + 44);
            cb4 = *(const f32x4*)(Am + 45 * AP + 48);
            cb5 = *(const f32x4*)(Am + 45 * AP + 52);
            cb6 = *(const f32x4*)(Am + 45 * AP + 56);
            cb7 = *(const f32x4*)(Am + 45 * AP + 60);
            __builtin_amdgcn_sched_barrier(0);
            x45 -= ca3[1] * x44; x46 -= ca3[2] * x44; x47 -= ca3[3] * x44; x48 -= ca4[0] * x44; x49 -= ca4[1] * x44; x50 -= ca4[2] * x44; x51 -= ca4[3] * x44; x52 -= ca5[0] * x44; x53 -= ca5[1] * x44; x54 -= ca5[2] * x44; x55 -= ca5[3] * x44; x56 -= ca6[0] * x44; x57 -= ca6[1] * x44; x58 -= ca6[2] * x44; x59 -= ca6[3] * x44; x60 -= ca7[0] * x44; x61 -= ca7[1] * x44; x62 -= ca7[2] * x44; x63 -= ca7[3] * x44;
            __builtin_amdgcn_sched_barrier(0);
            ca3 = *(const f32x4*)(Am + 46 * AP + 44);
            ca4 = *(const f32x4*)(Am + 46 * AP + 48);
            ca5 = *(const f32x4*)(Am + 46 * AP + 52);
            ca6 = *(const f32x4*)(Am + 46 * AP + 56);
            ca7 = *(const f32x4*)(Am + 46 * AP + 60);
            __builtin_amdgcn_sched_barrier(0);
            x46 -= cb3[2] * x45; x47 -= cb3[3] * x45; x48 -= cb4[0] * x45; x49 -= cb4[1] * x45; x50 -= cb4[2] * x45; x51 -= cb4[3] * x45; x52 -= cb5[0] * x45; x53 -= cb5[1] * x45; x54 -= cb5[2] * x45; x55 -= cb5[3] * x45; x56 -= cb6[0] * x45; x57 -= cb6[1] * x45; x58 -= cb6[2] * x45; x59 -= cb6[3] * x45; x60 -= cb7[0] * x45; x61 -= cb7[1] * x45; x62 -= cb7[2] * x45; x63 -= cb7[3] * x45;
            __builtin_amdgcn_sched_barrier(0);
            cb4 = *(const f32x4*)(Am + 47 * AP + 48);
            cb5 = *(const f32x4*)(Am + 47 * AP + 52);
            cb6 = *(const f32x4*)(Am + 47 * AP + 56);
            cb7 = *(const f32x4*)(Am + 47 * AP + 60);
            __builtin_amdgcn_sched_barrier(0);
            x47 -= ca3[3] * x46; x48 -= ca4[0] * x46; x49 -= ca4[1] * x46; x50 -= ca4[2] * x46; x51 -= ca4[3] * x46; x52 -= ca5[0] * x46; x53 -= ca5[1] * x46; x54 -= ca5[2] * x46; x55 -= ca5[3] * x46; x56 -= ca6[0] * x46; x57 -= ca6[1] * x46; x58 -= ca6[2] * x46; x59 -= ca6[3] * x46; x60 -= ca7[0] * x46; x61 -= ca7[1] * x46; x62 -= ca7[2] * x46; x63 -= ca7[3] * x46;
            __builtin_amdgcn_sched_barrier(0);
            ca4 = *(const f32x4*)(Am + 48 * AP + 48);
            ca5 = *(const f32x4*)(Am + 48 * AP + 52);
            ca6 = *(const f32x4*)(Am + 48 * AP + 56);
            ca7 = *(const f32x4*)(Am + 48 * AP + 60);
            __builtin_amdgcn_sched_barrier(0);
            x48 -= cb4[0] * x47; x49 -= cb4[1] * x47; x50 -= cb4[2] * x47; x51 -= cb4[3] * x47; x52 -= cb5[0] * x47; x53 -= cb5[1] * x47; x54 -= cb5[2] * x47; x55 -= cb5[3] * x47; x56 -= cb6[0] * x47; x57 -= cb6[1] * x47; x58 -= cb6[2] * x47; x59 -= cb6[3] * x47; x60 -= cb7[0] * x47; x61 -= cb7[1] * x47; x62 -= cb7[2] * x47; x63 -= cb7[3] * x47;
            __builtin_amdgcn_sched_barrier(0);
            cb4 = *(const f32x4*)(Am + 49 * AP + 48);
            cb5 = *(const f32x4*)(Am + 49 * AP + 52);
            cb6 = *(const f32x4*)(Am + 49 * AP + 56);
            cb7 = *(const f32x4*)(Am + 49 * AP + 60);
            __builtin_amdgcn_sched_barrier(0);
            x49 -= ca4[1] * x48; x50 -= ca4[2] * x48; x51 -= ca4[3] * x48; x52 -= ca5[0] * x48; x53 -= ca5[1] * x48; x54 -= ca5[2] * x48; x55 -= ca5[3] * x48; x56 -= ca6[0] * x48; x57 -= ca6[1] * x48; x58 -= ca6[2] * x48; x59 -= ca6[3] * x48; x60 -= ca7[0] * x48; x61 -= ca7[1] * x48; x62 -= ca7[2] * x48; x63 -= ca7[3] * x48;
            __builtin_amdgcn_sched_barrier(0);
            ca4 = *(const f32x4*)(Am + 50 * AP + 48);
            ca5 = *(const f32x4*)(Am + 50 * AP + 52);
            ca6 = *(const f32x4*)(Am + 50 * AP + 56);
            ca7 = *(const f32x4*)(Am + 50 * AP + 60);
            __builtin_amdgcn_sched_barrier(0);
            x50 -= cb4[2] * x49; x51 -= cb4[3] * x49; x52 -= cb5[0] * x49; x53 -= cb5[1] * x49; x54 -= cb5[2] * x49; x55 -= cb5[3] * x49; x56 -= cb6[0] * x49; x57 -= cb6[1] * x49; x58 -= cb6[2] * x49; x59 -= cb6[3] * x49; x60 -= cb7[0] * x49; x61 -= cb7[1] * x49; x62 -= cb7[2] * x49; x63 -= cb7[3] * x49;
            __builtin_amdgcn_sched_barrier(0);
            cb5 = *(const f32x4*)(Am + 51 * AP + 52);
            cb6 = *(const f32x4*)(Am + 51 * AP + 56);
            cb7 = *(const f32x4*)(Am + 51 * AP + 60);
            __builtin_amdgcn_sched_barrier(0);
            x51 -= ca4[3] * x50; x52 -= ca5[0] * x50; x53 -= ca5[1] * x50; x54 -= ca5[2] * x50; x55 -= ca5[3] * x50; x56 -= ca6[0] * x50; x57 -= ca6[1] * x50; x58 -= ca6[2] * x50; x59 -= ca6[3] * x50; x60 -= ca7[0] * x50; x61 -= ca7[1] * x50; x62 -= ca7[2] * x50; x63 -= ca7[3] * x50;
            __builtin_amdgcn_sched_barrier(0);
            ca5 = *(const f32x4*)(Am + 52 * AP + 52);
            ca6 = *(const f32x4*)(Am + 52 * AP + 56);
            ca7 = *(const f32x4*)(Am + 52 * AP + 60);
            __builtin_amdgcn_sched_barrier(0);
            x52 -= cb5[0] * x51; x53 -= cb5[1] * x51; x54 -= cb5[2] * x51; x55 -= cb5[3] * x51; x56 -= cb6[0] * x51; x57 -= cb6[1] * x51; x58 -= cb6[2] * x51; x59 -= cb6[3] * x51; x60 -= cb7[0] * x51; x61 -= cb7[1] * x51; x62 -= cb7[2] * x51; x63 -= cb7[3] * x51;
            __builtin_amdgcn_sched_barrier(0);
            cb5 = *(const f32x4*)(Am + 53 * AP + 52);
            cb6 = *(const f32x4*)(Am + 53 * AP + 56);
            cb7 = *(const f32x4*)(Am + 53 * AP + 60);
            __builtin_amdgcn_sched_barrier(0);
            x53 -= ca5[1] * x52; x54 -= ca5[2] * x52; x55 -= ca5[3] * x52; x56 -= ca6[0] * x52; x57 -= ca6[1] * x52; x58 -= ca6[2] * x52; x59 -= ca6[3] * x52; x60 -= ca7[0] * x52; x61 -= ca7[1] * x52; x62 -= ca7[2] * x52; x63 -= ca7[3] * x52;
            __builtin_amdgcn_sched_barrier(0);
            ca5 = *(const f32x4*)(Am + 54 * AP + 52);
            ca6 = *(const f32x4*)(Am + 54 * AP + 56);
            ca7 = *(const f32x4*)(Am + 54 * AP + 60);
            __builtin_amdgcn_sched_barrier(0);
            x54 -= cb5[2] * x53; x55 -= cb5[3] * x53; x56 -= cb6[0] * x53; x57 -= cb6[1] * x53; x58 -= cb6[2] * x53; x59 -= cb6[3] * x53; x60 -= cb7[0] * x53; x61 -= cb7[1] * x53; x62 -= cb7[2] * x53; x63 -= cb7[3] * x53;
            __builtin_amdgcn_sched_barrier(0);
            cb6 = *(const f32x4*)(Am + 55 * AP + 56);
            cb7 = *(const f32x4*)(Am + 55 * AP + 60);
            __builtin_amdgcn_sched_barrier(0);
            x55 -= ca5[3] * x54; x56 -= ca6[0] * x54; x57 -= ca6[1] * x54; x58 -= ca6[2] * x54; x59 -= ca6[3] * x54; x60 -= ca7[0] * x54; x61 -= ca7[1] * x54; x62 -= ca7[2] * x54; x63 -= ca7[3] * x54;
            __builtin_amdgcn_sched_barrier(0);
            ca6 = *(const f32x4*)(Am + 56 * AP + 56);
            ca7 = *(const f32x4*)(Am + 56 * AP + 60);
            __builtin_amdgcn_sched_barrier(0);
            x56 -= cb6[0] * x55; x57 -= cb6[1] * x55; x58 -= cb6[2] * x55; x59 -= cb6[3] * x55; x60 -= cb7[0] * x55; x61 -= cb7[1] * x55; x62 -= cb7[2] * x55; x63 -= cb7[3] * x55;
            __builtin_amdgcn_sched_barrier(0);
            cb6 = *(const f32x4*)(Am + 57 * AP + 56);
            cb7 = *(const f32x4*)(Am + 57 * AP + 60);
            __builtin_amdgcn_sched_barrier(0);
            x57 -= ca6[1] * x56; x58 -= ca6[2] * x56; x59 -= ca6[3] * x56; x60 -= ca7[0] * x56; x61 -= ca7[1] * x56; x62 -= ca7[2] * x56; x63 -= ca7[3] * x56;
            __builtin_amdgcn_sched_barrier(0);
            ca6 = *(const f32x4*)(Am + 58 * AP + 56);
            ca7 = *(const f32x4*)(Am + 58 * AP + 60);
            __builtin_amdgcn_sched_barrier(0);
            x58 -= cb6[2] * x57; x59 -= cb6[3] * x57; x60 -= cb7[0] * x57; x61 -= cb7[1] * x57; x62 -= cb7[2] * x57; x63 -= cb7[3] * x57;
            __builtin_amdgcn_sched_barrier(0);
            cb7 = *(const f32x4*)(Am + 59 * AP + 60);
            __builtin_amdgcn_sched_barrier(0);
            x59 -= ca6[3] * x58; x60 -= ca7[0] * x58; x61 -= ca7[1] * x58; x62 -= ca7[2] * x58; x63 -= ca7[3] * x58;
            __builtin_amdgcn_sched_barrier(0);
            ca7 = *(const f32x4*)(Am + 60 * AP + 60);
            __builtin_amdgcn_sched_barrier(0);
            x60 -= cb7[0] * x59; x61 -= cb7[1] * x59; x62 -= cb7[2] * x59; x63 -= cb7[3] * x59;
            __builtin_amdgcn_sched_barrier(0);
            cb7 = *(const f32x4*)(Am + 61 * AP + 60);
            __builtin_amdgcn_sched_barrier(0);
            x61 -= ca7[1] * x60; x62 -= ca7[2] * x60; x63 -= ca7[3] * x60;
            __builtin_amdgcn_sched_barrier(0);
            ca7 = *(const f32x4*)(Am + 62 * AP + 60);
            __builtin_amdgcn_sched_barrier(0);
            x62 -= cb7[2] * x61; x63 -= cb7[3] * x61;
            __builtin_amdgcn_sched_barrier(0);
            __builtin_amdgcn_sched_barrier(0);
            x63 -= ca7[3] * x62;
            __builtin_amdgcn_sched_barrier(0);
            asm volatile("s_waitcnt lgkmcnt(0)" ::: "memory");
            Am[0 * AP + lane] = x0 * bt;
            Am[1 * AP + lane] = x1 * bt;
            Am[2 * AP + lane] = x2 * bt;
            Am[3 * AP + lane] = x3 * bt;
            Am[4 * AP + lane] = x4 * bt;
            Am[5 * AP + lane] = x5 * bt;
            Am[6 * AP + lane] = x6 * bt;
            Am[7 * AP + lane] = x7 * bt;
            Am[8 * AP + lane] = x8 * bt;
            Am[9 * AP + lane] = x9 * bt;
            Am[10 * AP + lane] = x10 * bt;
            Am[11 * AP + lane] = x11 * bt;
            Am[12 * AP + lane] = x12 * bt;
            Am[13 * AP + lane] = x13 * bt;
            Am[14 * AP + lane] = x14 * bt;
            Am[15 * AP + lane] = x15 * bt;
            Am[16 * AP + lane] = x16 * bt;
            Am[17 * AP + lane] = x17 * bt;
            Am[18 * AP + lane] = x18 * bt;
            Am[19 * AP + lane] = x19 * bt;
            Am[20 * AP + lane] = x20 * bt;
            Am[21 * AP + lane] = x21 * bt;
            Am[22 * AP + lane] = x22 * bt;
            Am[23 * AP + lane] = x23 * bt;
            Am[24 * AP + lane] = x24 * bt;
            Am[25 * AP + lane] = x25 * bt;
            Am[26 * AP + lane] = x26 * bt;
            Am[27 * AP + lane] = x27 * bt;
            Am[28 * AP + lane] = x28 * bt;
            Am[29 * AP + lane] = x29 * bt;
            Am[30 * AP + lane] = x30 * bt;
            Am[31 * AP + lane] = x31 * bt;
            Am[32 * AP + lane] = x32 * bt;
            Am[33 * AP + lane] = x33 * bt;
            Am[34 * AP + lane] = x34 * bt;
            Am[35 * AP + lane] = x35 * bt;
            Am[36 * AP + lane] = x36 * bt;
            Am[37 * AP + lane] = x37 * bt;
            Am[38 * AP + lane] = x38 * bt;
            Am[39 * AP + lane] = x39 * bt;
            Am[40 * AP + lane] = x40 * bt;
            Am[41 * AP + lane] = x41 * bt;
            Am[42 * AP + lane] = x42 * bt;
            Am[43 * AP + lane] = x43 * bt;
            Am[44 * AP + lane] = x44 * bt;
            Am[45 * AP + lane] = x45 * bt;
            Am[46 * AP + lane] = x46 * bt;
            Am[47 * AP + lane] = x47 * bt;
            Am[48 * AP + lane] = x48 * bt;
            Am[49 * AP + lane] = x49 * bt;
            Am[50 * AP + lane] = x50 * bt;
            Am[51 * AP + lane] = x51 * bt;
            Am[52 * AP + lane] = x52 * bt;
            Am[53 * AP + lane] = x53 * bt;
            Am[54 * AP + lane] = x54 * bt;
            Am[55 * AP + lane] = x55 * bt;
            Am[56 * AP + lane] = x56 * bt;
            Am[57 * AP + lane] = x57 * bt;
            Am[58 * AP + lane] = x58 * bt;
            Am[59 * AP + lane] = x59 * bt;
            Am[60 * AP + lane] = x60 * bt;
            Am[61 * AP + lane] = x61 * bt;
            Am[62 * AP + lane] = x62 * bt;
            Am[63 * AP + lane] = x63 * bt;
        }
        asm volatile("s_waitcnt lgkmcnt(0)" ::: "memory");
        bf16x8 t2f[2][4];
#pragma unroll
        for (int it = 0; it < 2; ++it)
#pragma unroll
            for (int ks = 0; ks < 4; ++ks) { if (it == 0 && ks >= 2) continue;
                const f32x4 lo = *(const f32x4*)(Am + (32 * it + r) * AP + 16 * ks + 4 * hf), hi = *(const f32x4*)(Am + (32 * it + r) * AP + 16 * ks + 8 + 4 * hf);
                v4u w; w.x = pk2(lo[0], lo[1]); w.y = pk2(lo[2], lo[3]); w.z = pk2(hi[0], hi[1]); w.w = pk2(hi[2], hi[3]); t2f[it][ks] = __builtin_bit_cast(bf16x8, w); }
        const bf16* ktp = kvt + (size_t)ch * 16384 + lane * 8;
#pragma unroll 1
        for (int dt = 0; dt < 4; ++dt) {
            f32x16 w0 = zero16(), w1 = zero16();
#pragma unroll
            for (int ks = 0; ks < 4; ++ks) {
                v4u kd = (v4u){0u, 0u, 0u, 0u};
                if (ks < nks) {
                    float kt[8], ke[8], kf[8]; unpack8(*(const v4u*)(ktp + (dt * 4 + ks) * 512), kt);
                    const f32x4 ea = *(const f32x4*)(tab + 128 + 16 * ks + 4 * hf), eb = *(const f32x4*)(tab + 128 + 16 * ks + 8 + 4 * hf);
                    const f32x4 fa = *(const f32x4*)(tab + 192 + 16 * ks + 4 * hf), fb = *(const f32x4*)(tab + 192 + 16 * ks + 8 + 4 * hf);
#pragma unroll
                    for (int c = 0; c < 4; ++c) { ke[c] = kt[c] * ea[c]; ke[4 + c] = kt[4 + c] * eb[c]; kf[c] = kt[c] * fa[c]; kf[4 + c] = kt[4 + c] * fb[c]; }
                    const bf16x8 aop = __builtin_bit_cast(bf16x8, pack8(ke));
                    kd = pack8(kf);
                    w1 = MFMA32(aop, t2f[1][ks], w1);
                    if (ks < 2) w0 = MFMA32(aop, t2f[0][ks], w0);
                }
                *(v4u*)(rec + R_KDEC + (dt * 4 + ks) * 1024 + lane * 16) = kd;
            }
#pragma unroll
            for (int i = 0; i < 16; ++i) { w0[i] = -w0[i]; w1[i] = -w1[i]; }
#pragma unroll
            for (int s = 0; s < 2; ++s) { *(bf16x8*)(rec + R_NEGW + (0 * 8 + 2 * dt + s) * 1024 + lane * 16) = pack_regs(w0, s);
                                          *(bf16x8*)(rec + R_NEGW + (1 * 8 + 2 * dt + s) * 1024 + lane * 16) = pack_regs(w1, s); }
        }
        const bf16* vtp = kvt + (size_t)ch * 16384 + 8192 + lane * 8;
#pragma unroll 1
        for (int et = 0; et < 4; ++et) {
            f32x16 u0 = zero16(), u1 = zero16();
#pragma unroll
            for (int ks = 0; ks < 4; ++ks) {
                if (ks < nks) { const bf16x8 vb = *(const bf16x8*)(vtp + (et * 4 + ks) * 512);
                    u1 = MFMA32(t2f[1][ks], vb, u1);
                    if (ks < 2) u0 = MFMA32(t2f[0][ks], vb, u0); }
            }
            *(f32x16*)(rec + R_U + ((et * 2 + 0) * 64 + lane) * 64) = u0;
            *(f32x16*)(rec + R_U + ((et * 2 + 1) * 64 + lane) * 64) = u1;
        }
        if (lane == 0) *(float*)(rec + R_EGL) = expf(gl);
    }
}

constexpr int OT_OFF = 2 * R_OPS;
static_assert(OT_OFF + 64 * 128 * 4 <= LDS_PHASE, "scan LDS");
__device__ __forceinline__ void scan_zload(const Args& a, int hw, int lane, int grow0, int hh, int ntok, v4u (&zr)[4]) {
    const bf16* zg = (const bf16*)(a.ws + WS_ZG); const int e0 = 8 * (lane & 15);
#pragma unroll
    for (int gq = 0; gq < 4; ++gq) { const int row = 16 * hw + 4 * gq + (lane >> 4); const int rr = row < ntok ? row : 0;
        zr[gq] = *(const v4u*)(zg + (size_t)(grow0 + rr) * 512 + hh * HD + e0); }
}
__device__ __forceinline__ void scan_epilogue(const Args& a, const unsigned char* lds, int hw, int lane, int grow0, int hh, int ntok, const float (&wn)[8], const v4u (&zr)[4]) {
    bf16* mix = (bf16*)(a.ws + WS_XB);
    const float* ot = (const float*)(lds + OT_OFF);
    const int e0 = 8 * (lane & 15);
#pragma unroll
    for (int gq = 0; gq < 4; ++gq) {
        const int row = 16 * hw + 4 * gq + (lane >> 4);
        const f32x4 o0 = *(const f32x4*)(ot + row * 128 + e0), o1 = *(const f32x4*)(ot + row * 128 + e0 + 4);
        float o[8] = {o0[0], o0[1], o0[2], o0[3], o1[0], o1[1], o1[2], o1[3]};
        float ss = 0.f;
#pragma unroll
        for (int c = 0; c < 8; ++c) ss += o[c] * o[c];
        ss += __shfl_xor(ss, 1); ss += __shfl_xor(ss, 2); ss += __shfl_xor(ss, 4); ss += __shfl_xor(ss, 8);
        if (row < ntok) {
            const size_t grow = (size_t)(grow0 + row);
            float z[8]; unpack8(zr[gq], z);
            const float rs = 1.0f / sqrtf(ss * (1.0f / HD) + RMS_EPS);
            float y[8];
#pragma unroll
            for (int c = 0; c < 8; ++c) y[c] = o[c] * rs * wn[c] * silu_f(z[c]);
            *(v4u*)(mix + grow * D + 512 + hh * HD + e0) = pack8(y);
        }
    }
}
__device__ __forceinline__ void phase4(const Args& a, unsigned char* lds, int G) {
    const int tid = threadIdx.x, lane = tid & 63, wave = __builtin_amdgcn_readfirstlane(tid >> 6);
    unsigned char* ws = a.ws;
    const int r = lane & 31, hf = lane >> 5;
    for (int sq = blockIdx.x; sq < NB * NH + NBS * NH; sq += G) {
        const bool smp = sq >= NB * NH;
        const int sl = smp ? sq - NB * NH : sq, hh = sl & 3;
        const int ch0 = smp ? NB * NH * 64 + sl : sq * 64, nch = smp ? 1 : 64, ntok = smp ? DSEQ : 64;
        const int rbase = smp ? MP + (sl >> 2) * DSEQ : (sl >> 2) * SEQ;
        const unsigned char* rec0 = ws + WS_PREP + (size_t)ch0 * REC;
        __syncthreads();
        if (wave >= 4) {
            const int hw = wave - 4;
            float wn[8];
#pragma unroll
            for (int c = 0; c < 8; ++c) wn[c] = a.in[11][8 * (lane & 15) + c];
#pragma unroll 1
            for (int blk = hw; blk < 56; blk += 4)
                __builtin_amdgcn_global_load_lds((const unsigned*)(rec0 + blk * 1024 + lane * 16), (LAS unsigned*)(lds + blk * 1024), 16, 0, 0);
            v4u zr[4];
            scan_zload(a, hw, lane, rbase, hh, ntok, zr);
            asm volatile("s_waitcnt vmcnt(0)" ::: "memory");
            __builtin_amdgcn_s_barrier(); asm volatile("" ::: "memory");
#pragma unroll 1
            for (int n = 0; n < nch; ++n) {
                if (n >= 1) { scan_epilogue(a, lds, hw, lane, rbase + (n - 1) * 64, hh, ntok, wn, zr);
                              scan_zload(a, hw, lane, rbase + n * 64, hh, ntok, zr); }
                if (n + 1 < nch) { const unsigned char* rn = rec0 + (size_t)(n + 1) * REC; unsigned char* dst = lds + ((n + 1) & 1) * R_OPS;
#pragma unroll 1
                    for (int blk = hw; blk < 56; blk += 4)
                        __builtin_amdgcn_global_load_lds((const unsigned*)(rn + blk * 1024 + lane * 16), (LAS unsigned*)(dst + blk * 1024), 16, 0, 0); }
                asm volatile("s_waitcnt lgkmcnt(0)" ::: "memory");
                __builtin_amdgcn_s_barrier(); asm volatile("" ::: "memory");
                asm volatile("s_waitcnt vmcnt(0)" ::: "memory");
                __builtin_amdgcn_s_barrier(); asm volatile("" ::: "memory");
            }
            scan_epilogue(a, lds, hw, lane, rbase + (nch - 1) * 64, hh, ntok, wn, zr);
        } else {
            const int w = wave;
            f32x16 S[4];
            if (smp) { const float* sp = a.in[4] + (size_t)sl * HD * HD + 32 * w + r;
#pragma unroll
                for (int dt = 0; dt < 4; ++dt)
#pragma unroll
                    for (int i = 0; i < 16; ++i) S[dt][i] = sp[(size_t)(32 * dt + (i & 3) + 8 * (i >> 2) + 4 * hf) * HD]; }
            else {
#pragma unroll
                for (int dt = 0; dt < 4; ++dt) S[dt] = zero16(); }
            f32x16 un0 = *(const f32x16*)(rec0 + R_U + ((w * 2 + 0) * 64 + lane) * 64), un1 = *(const f32x16*)(rec0 + R_U + ((w * 2 + 1) * 64 + lane) * 64);
            float egn = *(const float*)(rec0 + R_EGL);
            __builtin_amdgcn_s_barrier(); asm volatile("" ::: "memory");
#pragma unroll 1
            for (int n = 0; n < nch; ++n) {
                const unsigned char* op = lds + (n & 1) * R_OPS + lane * 16;
                f32x16 av0 = un0, av1 = un1, ao0 = zero16(), ao1 = zero16();
                const float eg = egn;
                if (n + 1 < nch) { const unsigned char* rn = rec0 + (size_t)(n + 1) * REC;
                    un0 = *(const f32x16*)(rn + R_U + ((w * 2 + 0) * 64 + lane) * 64); un1 = *(const f32x16*)(rn + R_U + ((w * 2 + 1) * 64 + lane) * 64); egn = *(const float*)(rn + R_EGL); }
#pragma unroll
                for (int dt = 0; dt < 4; ++dt)
#pragma unroll
                    for (int s = 0; s < 2; ++s) { const int ks = 2 * dt + s; const bf16x8 B = pack_regs(S[dt], s);
                        av0 = MFMA32(*(const bf16x8*)(op + R_NEGW + (0 * 8 + ks) * 1024), B, av0); av1 = MFMA32(*(const bf16x8*)(op + R_NEGW + (1 * 8 + ks) * 1024), B, av1);
                        ao0 = MFMA32(*(const bf16x8*)(op + R_QG + (0 * 8 + ks) * 1024), B, ao0);   ao1 = MFMA32(*(const bf16x8*)(op + R_QG + (1 * 8 + ks) * 1024), B, ao1); }
#pragma unroll
                for (int dt = 0; dt < 4; ++dt)
#pragma unroll
                    for (int i = 0; i < 16; ++i) S[dt][i] *= eg;
#pragma unroll
                for (int jt = 0; jt < 2; ++jt)
#pragma unroll
                    for (int s = 0; s < 2; ++s) { const int ks = 2 * jt + s; const bf16x8 Bv = pack_regs(jt ? av1 : av0, s);
                        if (jt == 0) ao0 = MFMA32(*(const bf16x8*)(op + R_ATTN + (0 * 4 + ks) * 1024), Bv, ao0);
                        ao1 = MFMA32(*(const bf16x8*)(op + R_ATTN + (1 * 4 + ks) * 1024), Bv, ao1);
#pragma unroll
                        for (int dt = 0; dt < 4; ++dt) S[dt] = MFMA32(*(const bf16x8*)(op + R_KDEC + (dt * 4 + ks) * 1024), Bv, S[dt]); }
                asm volatile("s_waitcnt lgkmcnt(0)" ::: "memory");
                __builtin_amdgcn_s_barrier(); asm volatile("" ::: "memory");
                float* ot = (float*)(lds + OT_OFF) + 32 * w + r;
#pragma unroll
                for (int i = 0; i < 16; ++i) { const int row = (i & 3) + 8 * (i >> 2) + 4 * hf; ot[row * 128] = ao0[i]; ot[(32 + row) * 128] = ao1[i]; }
                asm volatile("s_waitcnt lgkmcnt(0)" ::: "memory");
                __builtin_amdgcn_s_barrier(); asm volatile("" ::: "memory");
            }
            float* so = a.out + (smp ? O_ST_S : O_ST_P) + (size_t)sl * HD * HD + 32 * w + r;
#pragma unroll
            for (int dt = 0; dt < 4; ++dt)
#pragma unroll
                for (int i = 0; i < 16; ++i) so[(size_t)(32 * dt + (i & 3) + 8 * (i >> 2) + 4 * hf) * HD] = S[dt][i];
        }
    }
}

__device__ __forceinline__ void phase6(const Args& a, int G) {
    const int tid = threadIdx.x, lane = tid & 63, wave = tid >> 6;
    const int gw = blockIdx.x * NWAVES + wave, NGW = G * NWAVES;
    const float* outb = (const float*)(a.ws + WS_OUT); const float* ln_post = a.in[13];
    f32x4 lw[4];
#pragma unroll
    for (int i = 0; i < 4; ++i) lw[i] = *((const f32x4*)ln_post + 64 * i + lane);
    for (int r = gw; r < MT; r += NGW) {
        const float* xrow = (r < MP) ? a.in[0] + (size_t)r * D : a.in[1] + (size_t)(r - MP) * D;
        f32x4 v[4], xv[4]; float ss = 0.f;
#pragma unroll
        for (int i = 0; i < 4; ++i) { v[i] = *((const f32x4*)(outb + (size_t)r * D) + 64 * i + lane); xv[i] = *((const f32x4*)xrow + 64 * i + lane);
            ss += (v[i][0] * v[i][0] + v[i][1] * v[i][1]) + (v[i][2] * v[i][2] + v[i][3] * v[i][3]); }
        ss = wave_sum(ss);
        const float rs = 1.0f / sqrtf(ss * (1.0f / D) + RMS_EPS);
#pragma unroll
        for (int i = 0; i < 4; ++i) *((f32x4*)(a.out + O_Y + (size_t)r * D) + 64 * i + lane) = xv[i] + v[i] * rs * lw[i];
    }
}

constexpr int NPHASES = 7;
__global__ void __launch_bounds__(NTHREADS, 2) fwd(Args args) {
    extern __shared__ __attribute__((aligned(16))) unsigned char lds[];
    const int G = gridDim.x;
    const int lo = args.ph_lo, hi = args.ph_hi;
#if ONE_LAUNCH
    cg::grid_group grid = cg::this_grid();
    volatile LAS unsigned* xbw = (volatile LAS unsigned*)((LAS unsigned char*)lds + LDS_PHASE);
    if (threadIdx.x < 4) xbw[threadIdx.x] = 0u;
    __syncthreads();
    XcdBarrier xbar = xcd_barrier_post((unsigned*)(args.ws + WS_BAR), xbw);
#define SEAM() xcd_barrier(xbar)
#define SEAM_CG() grid.sync()
#else
#define SEAM() do {} while (0)
#define SEAM_CG() do {} while (0)
#endif
#define IN(k) (lo <= (k) && (k) < hi)
#define RUNP(k, ...) if (IN(k)) { __VA_ARGS__; if (REP_PHASE == (k)) { SEAM(); __VA_ARGS__; } if (IN((k) + 1)) { if ((k) == 0) SEAM_CG(); else SEAM(); } }
    RUNP(0, phase0(args, lds, G))
    RUNP(1, {
        pg8::Gemm g{(const pg8::bf16_t*)(args.ws + WS_XB), (const pg8::bf16_t*)(args.ws + WS_WB1), MT, NP, D};
        pg8::StaticOrder S; S.init(MT, NP, G, (int)blockIdx.x);
        pg8::EpiProj E{(pg8::bf16_t*)(args.ws + WS_PA), (pg8::bf16_t*)(args.ws + WS_PQ), (pg8::bf16_t*)(args.ws + WS_ZG), (const float*)(args.ws + WS_RSTD)};
        pg8::gemm_phase<pg8::EpiProj, pg8::StaticOrder, true, true>((LAS unsigned char*)lds, g, S, E); })
    RUNP(2, phase2(args, G))
    RUNP(3, phase3(args, lds, G))
    RUNP(4, phase4(args, lds, G))
    RUNP(5, {
        pg8::Gemm g{(const pg8::bf16_t*)(args.ws + WS_XB), (const pg8::bf16_t*)(args.ws + WS_WB2), MT, D, D};
        pg8::StaticOrder S; S.init(MT, D, G, (int)blockIdx.x);
        pg8::EpiF32 E{(float*)(args.ws + WS_OUT), D};
        pg8::gemm_phase<pg8::EpiF32, pg8::StaticOrder, true, true>((LAS unsigned char*)lds, g, S, E); })
    RUNP(6, phase6(args, G))
    if (REP_PHASE == 7) SEAM();
#undef IN
}

extern "C" void kernel_launch(void* const* d_in, const int* in_sizes, int n_in, void* d_out, int out_size, void* d_ws, size_t ws_size, hipStream_t stream) {
    static int grid = 0;
    if (grid == 0) {
        if (n_in != 14 || in_sizes[0] != MP * D || (size_t)out_size != O_END || ws_size < WS_END) {
            fprintf(stderr, "kernel_launch: unexpected shapes: n_in %d in0 %d out %d (want %zu) ws %zu (want >= %zu)\n", n_in, n_in > 0 ? in_sizes[0] : -1, out_size, (size_t)O_END, ws_size, (size_t)WS_END); grid = -1; return; }
        int dev = 0, cus = 0, per_cu = 0;
        (void)hipGetDevice(&dev); (void)hipDeviceGetAttribute(&cus, hipDeviceAttributeMultiprocessorCount, dev);
        if (hipFuncSetAttribute((const void*)fwd, hipFuncAttributeMaxDynamicSharedMemorySize, LDS_BYTES) != hipSuccess) { fprintf(stderr, "kernel_launch: hipFuncSetAttribute failed\n"); grid = -1; return; }
        (void)hipOccupancyMaxActiveBlocksPerMultiprocessor(&per_cu, (const void*)fwd, NTHREADS, LDS_BYTES);
        if (per_cu < 1) { fprintf(stderr, "kernel_launch: occupancy query says %d blocks per CU\n", per_cu); per_cu = 1; }
        (void)hipGetLastError();
        grid = cus * 1;
        fprintf(stderr, "kernel_launch: cus %d per_cu %d grid %d\n", cus, per_cu, grid);
    }
    if (grid < 0) return;
    if (hipMemsetAsync((char*)d_ws + WS_BAR, 0, 16384, stream) != hipSuccess) { fprintf(stderr, "kernel_launch: memset failed\n"); return; }
    Args a{};
    for (int i = 0; i < 14; ++i) a.in[i] = (const float*)d_in[i];
    a.out = (float*)d_out; a.ws = (unsigned char*)d_ws;
#if ONE_LAUNCH
    a.ph_lo = 0; a.ph_hi = NPHASES;
    void* kargs[] = {&a};
    hipError_t e = hipLaunchCooperativeKernel((const void*)fwd, dim3(grid), dim3(NTHREADS), kargs, LDS_BYTES, stream);
    if (e != hipSuccess) fprintf(stderr, "kernel_launch: cooperative launch failed: %s (grid %d)\n", hipGetErrorString(e), grid);
#else
    for (int p = 0; p < NPHASES; ++p) { a.ph_lo = p; a.ph_hi = p + 1;
        hipLaunchKernelGGL(fwd, dim3(grid), dim3(NTHREADS), LDS_BYTES, stream, a);
        const hipError_t le = hipPeekAtLastError();
        if (le != hipSuccess) { fprintf(stderr, "kernel_launch: launch %d failed: %s\n", p, hipGetErrorName(le)); break; } }
#endif
}
```

```cpp
#include <hip/hip_runtime.h>
#include <hip/hip_cooperative_groups.h>
#include <cstdio>
#include <cstdint>
namespace cg = cooperative_groups;
#ifndef ONE_LAUNCH
#define ONE_LAUNCH 1
#define REP_PHASE -1
#define P3REP_SUB 1
#define P3REP_56 1
#define P4REP_DMA 1
#endif
namespace pg8 {
#define PG8_LAS __attribute__((address_space(3)))
typedef unsigned short bf16_t;
typedef short bf16x8 __attribute__((ext_vector_type(8)));
typedef float f32x4 __attribute__((ext_vector_type(4)));
typedef unsigned u32x4 __attribute__((ext_vector_type(4)));
constexpr int BM = 256, BK = 64, HALF = 128, HTB = HALF * BK * 2  , STAGE_BYTES = 8 * HTB, NXCD = 8, WGM = 8;

__host__ __device__ __forceinline__ int lds_byte(int r, int c) { const int st = (r >> 4) * 2 + (c >> 5), rr = r & 15, cc = c & 31, ob = rr * 64 + cc * 2; return st * 1024 + (ob ^ (((ob >> 9) & 1) << 5)); }
__host__ __device__ __forceinline__ void stage_rc(int b, int& R, int& C) { const int st = b / 1024, sb = b % 1024, swz = sb ^ (((sb >> 9) & 1) << 5); R = (st >> 1) * 16 + swz / 64; C = (st & 1) * 32 + (swz % 64) / 2; }
__host__ __device__ __forceinline__ int perm32(int rho) { const int n = rho >> 4, i = rho & 15; return 8 * (i >> 2) + 4 * n + (i & 3); }

struct Unit { int pm, pn; };
struct Gemm { const bf16_t* A; const bf16_t* Bt; int M, N, K; };

struct StaticOrder {
    int nM, nN, nwg, G, c;
    __host__ __device__ void init(int M, int N, int G_, int c_) { nM = M / BM; nN = N / BM; nwg = nM * nN; G = G_; c = c_; }
    __host__ __device__ bool next(int i, Unit& u) const {
        const long L = (long)i * G + c; if (L >= nwg) return false;
        int wgid = (int)L; { const int q = nwg / NXCD, r = nwg % NXCD, xcd = wgid % NXCD, off = wgid / NXCD; wgid = (xcd < r ? xcd * (q + 1) : r * (q + 1) + (xcd - r) * q) + off; }
        const int nig = WGM * nN, gid = wgid / nig, fm = gid * WGM, gsz = (nM - fm) < WGM ? (nM - fm) : WGM;
        u.pm = fm + ((wgid % nig) % gsz); u.pn = (wgid % nig) / gsz; return true;
    }
    __device__ __forceinline__ void a_ready(const Unit&) const {}
    __device__ __forceinline__ void done(const Unit&) const {}
};
__device__ __forceinline__ unsigned cvt_pk_bf16(float lo, float hi) { unsigned r; asm volatile("v_cvt_pk_bf16_f32 %0, %1, %2" : "=v"(r) : "v"(lo), "v"(hi)); return r; }

struct EpiProj {
    static constexpr bool PERM = true, AFTER_DRAIN = false;
    bf16_t* OA; bf16_t* OQ; bf16_t* OZ; const float* rstd;
    __device__ __forceinline__ void operator()(const f32x4 (&acc)[2][2][4][2], const Unit& u, int wr, int wc, int fr, int fq) const {
        const int row0 = u.pm * BM + wr * 64 + fr; int colt = u.pn * BM; bf16_t* base; int ldc;
        if (colt < 2048) { base = OA; ldc = 2048; } else if (colt < 3584) { base = OQ; ldc = 1536; colt -= 2048; } else { base = OZ; ldc = 512; colt -= 3584; }
        const int col0 = colt + wc * 32 + 8 * fq;
#pragma unroll
        for (int ai = 0; ai < 2; ++ai)
#pragma unroll
            for (int m = 0; m < 4; ++m) { const int r = row0 + ai * HALF + m * 16; const float sc = rstd[r]; bf16_t* rowp = base + (size_t)r * ldc + col0;
#pragma unroll
                for (int bj = 0; bj < 2; ++bj) { const f32x4 v0 = acc[ai][bj][m][0] * sc, v1 = acc[ai][bj][m][1] * sc;
                    u32x4 w; w.x = cvt_pk_bf16(v0[0], v0[1]); w.y = cvt_pk_bf16(v0[2], v0[3]); w.z = cvt_pk_bf16(v1[0], v1[1]); w.w = cvt_pk_bf16(v1[2], v1[3]);
                    *(u32x4*)(rowp + bj * HALF) = w; } }
    }
};
struct EpiF32 {
    static constexpr bool PERM = false, AFTER_DRAIN = false;
    float* C; int ldc;
    __device__ __forceinline__ void operator()(const f32x4 (&acc)[2][2][4][2], const Unit& u, int wr, int wc, int fr, int fq) const {
        const int row0 = u.pm * BM + wr * 64 + fr, col0 = u.pn * BM + wc * 32 + 4 * fq;
#pragma unroll
        for (int ai = 0; ai < 2; ++ai)
#pragma unroll
            for (int m = 0; m < 4; ++m) { float* rowp = C + (size_t)(row0 + ai * HALF + m * 16) * ldc + col0;
#pragma unroll
                for (int bj = 0; bj < 2; ++bj)
#pragma unroll
                    for (int n = 0; n < 2; ++n) *(f32x4*)(rowp + bj * HALF + n * 16) = acc[ai][bj][m][n]; }
    }
};
template <class Epi, class Sched, bool ALIGN_EPI = false, bool SP2 = false>
__device__ __forceinline__ void gemm_phase(PG8_LAS unsigned char* lds, const Gemm g, const Sched& S, const Epi& E) {
    const int tid = threadIdx.x, wid = __builtin_amdgcn_readfirstlane(tid >> 6), lane = tid & 63, wr = wid >> 2, wc = wid & 3, fr = lane & 15, fq = lane >> 4;
    const int K = g.K, nt = K / BK;
    unsigned voffA[2], voffB[2];
#pragma unroll
    for (int i = 0; i < 2; ++i) { int R, C; stage_rc(tid * 16 + i * 8192, R, C); const int Rb = Epi::PERM ? ((R & ~31) + perm32(R & 31)) : R;
        voffA[i] = (unsigned)(R * K + C) * 2u; voffB[i] = (unsigned)(Rb * K + C) * 2u; }
    const size_t kstep = (size_t)(BK * 2);
    const size_t hstep = (size_t)HALF * K * 2;
    const size_t tstep = 2 * hstep;
    const unsigned ldsw = (unsigned)wid * 1024u;
    const int aoff = lds_byte(wr * 64 + fr, fq * 8), boff = lds_byte(wc * 32 + fr, fq * 8);
#define PG8_SA(b, h) (((b) * 2 + (h)) * HTB)
#define PG8_SB(b, h) ((4 + (b) * 2 + (h)) * HTB)
#define PG8_STAGE(bufoff, gbase, voff) do { _Pragma("unroll") for (int _i = 0; _i < 2; ++_i) \
        __builtin_amdgcn_global_load_lds((const unsigned*)((const char*)(gbase) + (voff)[_i]), (PG8_LAS unsigned*)(lds + (bufoff) + ldsw + _i * 8192), 16, 0, 0); } while (0)
#define PG8_LDA(dst, b, h) do { _Pragma("unroll") for (int m = 0; m < 4; ++m) _Pragma("unroll") for (int k = 0; k < 2; ++k) dst[m][k] = *(const PG8_LAS bf16x8*)(lds + PG8_SA(b, h) + aoff + m * 2048 + k * 1024); } while (0)
#define PG8_LDB(dst, b, h) do { _Pragma("unroll") for (int n = 0; n < 2; ++n) _Pragma("unroll") for (int k = 0; k < 2; ++k) dst[n][k] = *(const PG8_LAS bf16x8*)(lds + PG8_SB(b, h) + boff + n * 2048 + k * 1024); } while (0)
#define PG8_MMA(ai, bj, At, Bt) do { __builtin_amdgcn_s_setprio(1); _Pragma("unroll") for (int m = 0; m < 4; ++m) _Pragma("unroll") for (int n = 0; n < 2; ++n) _Pragma("unroll") for (int k = 0; k < 2; ++k) \
        acc[ai][bj][m][n] = __builtin_amdgcn_mfma_f32_16x16x32_bf16(Bt[n][k], At[m][k], acc[ai][bj][m][n], 0, 0, 0); __builtin_amdgcn_s_setprio(0); } while (0)
#define PG8_WAIT_V(n) asm volatile("s_waitcnt vmcnt(" #n ")" ::: "memory")
#define PG8_WAIT_L(n) asm volatile("s_waitcnt lgkmcnt(" #n ")" ::: "memory")
#define PG8_BAR __builtin_amdgcn_s_barrier()
#define PG8_SCHED __builtin_amdgcn_sched_barrier(0)
    Unit cur, nxt; int ui = 0;
    if (!S.next(0, cur)) return;
    f32x4 acc[2][2][4][2];
#pragma unroll
    for (int a = 0; a < 2; ++a)
#pragma unroll
        for (int b = 0; b < 2; ++b)
#pragma unroll
            for (int m = 0; m < 4; ++m)
#pragma unroll
                for (int n = 0; n < 2; ++n) acc[a][b][m][n] = (f32x4){0.f, 0.f, 0.f, 0.f};
    bf16x8 At[4][2], B0[2][2], B1[2][2];
    const char* cA = (const char*)g.A + (size_t)cur.pm * tstep; const char* cB = (const char*)g.Bt + (size_t)cur.pn * tstep;
    S.a_ready(cur);
    if constexpr (SP2) {
        PG8_STAGE(PG8_SB(0, 0), cB, voffB); PG8_STAGE(PG8_SB(0, 1), cB + hstep, voffB); PG8_STAGE(PG8_SA(0, 0), cA, voffA); PG8_STAGE(PG8_SA(0, 1), cA + hstep, voffA);
        if (wr == 1) PG8_BAR;
        PG8_WAIT_V(2); PG8_BAR;
        PG8_STAGE(PG8_SB(1, 0), cB + kstep, voffB); PG8_STAGE(PG8_SA(1, 0), cA + kstep, voffA); PG8_STAGE(PG8_SB(1, 1), cB + hstep + kstep, voffB);
        PG8_WAIT_V(6); PG8_BAR;
    } else {
        PG8_STAGE(PG8_SB(0, 0), cB, voffB); PG8_STAGE(PG8_SA(0, 0), cA, voffA); PG8_STAGE(PG8_SB(0, 1), cB + hstep, voffB); PG8_STAGE(PG8_SA(0, 1), cA + hstep, voffA);
        if (wr == 1) PG8_BAR;
        PG8_WAIT_V(4); PG8_BAR;
        PG8_STAGE(PG8_SB(1, 0), cB + kstep, voffB); PG8_STAGE(PG8_SA(1, 0), cA + kstep, voffA); PG8_STAGE(PG8_SB(1, 1), cB + hstep + kstep, voffB);
        PG8_WAIT_V(6); PG8_BAR;
    }
    for (;;) {
        const bool has_next = S.next(ui + 1, nxt);
        const char* nA = has_next ? (const char*)g.A + (size_t)nxt.pm * tstep : cA; const char* nB = has_next ? (const char*)g.Bt + (size_t)nxt.pn * tstep : cB;
        for (int t = 0; t < nt; t += 2) {
            const bool last = (t == nt - 2);
            const char* a1 = cA + (size_t)(t + 1) * kstep;
            const char* a2 = last ? nA : cA + (size_t)(t + 2) * kstep; const char* b2 = last ? nB : cB + (size_t)(t + 2) * kstep;
            const char* a3 = a2 + kstep; const char* b3 = b2 + kstep;
            if (last && has_next) S.a_ready(nxt);
            if constexpr (SP2) {
            PG8_LDB(B0, 0, 0); PG8_LDB(B1, 0, 1); PG8_SCHED; PG8_LDA(At, 0, 0); PG8_STAGE(PG8_SA(1, 1), a1 + hstep, voffA);
            PG8_WAIT_V(8); PG8_WAIT_L(0); PG8_BAR; PG8_MMA(0, 0, At, B0); PG8_MMA(0, 1, At, B1); PG8_BAR; PG8_SCHED;
            PG8_LDA(At, 0, 1); PG8_STAGE(PG8_SB(0, 0), b2, voffB); PG8_STAGE(PG8_SB(0, 1), b2 + hstep, voffB); PG8_STAGE(PG8_SA(0, 0), a2, voffA);
            PG8_WAIT_V(8); PG8_WAIT_L(0); PG8_BAR; PG8_MMA(1, 0, At, B0); PG8_MMA(1, 1, At, B1); PG8_BAR; PG8_SCHED;
            PG8_LDB(B0, 1, 0); PG8_LDB(B1, 1, 1); PG8_SCHED; PG8_LDA(At, 1, 0); PG8_STAGE(PG8_SA(0, 1), a2 + hstep, voffA);
            PG8_WAIT_V(8); PG8_WAIT_L(0); PG8_BAR; PG8_MMA(0, 0, At, B0); PG8_MMA(0, 1, At, B1); PG8_BAR; PG8_SCHED;
            PG8_LDA(At, 1, 1); PG8_STAGE(PG8_SB(1, 0), b3, voffB); PG8_STAGE(PG8_SB(1, 1), b3 + hstep, voffB); PG8_STAGE(PG8_SA(1, 0), a3, voffA);
            PG8_WAIT_V(8); PG8_WAIT_L(0); PG8_BAR; PG8_MMA(1, 0, At, B0); PG8_MMA(1, 1, At, B1); PG8_BAR; PG8_SCHED;
            } else {
            PG8_LDB(B0, 0, 0); PG8_SCHED; PG8_LDA(At, 0, 0); PG8_STAGE(PG8_SA(1, 1), a1 + hstep, voffA);
            PG8_WAIT_L(8); PG8_BAR; PG8_WAIT_L(0); PG8_MMA(0, 0, At, B0); PG8_BAR; PG8_SCHED;
            PG8_LDB(B1, 0, 1); PG8_STAGE(PG8_SB(0, 0), b2, voffB);
            PG8_BAR; PG8_WAIT_L(0); PG8_MMA(0, 1, At, B1); PG8_BAR;
            PG8_LDA(At, 0, 1); PG8_STAGE(PG8_SA(0, 0), a2, voffA);
            PG8_BAR; PG8_WAIT_L(0); PG8_MMA(1, 0, At, B0); PG8_BAR; PG8_SCHED;
            PG8_STAGE(PG8_SB(0, 1), b2 + hstep, voffB);
            PG8_WAIT_V(6); PG8_BAR; PG8_MMA(1, 1, At, B1); PG8_BAR;
            PG8_LDB(B0, 1, 0); PG8_SCHED; PG8_LDA(At, 1, 0); PG8_STAGE(PG8_SA(0, 1), a2 + hstep, voffA);
            PG8_WAIT_L(8); PG8_BAR; PG8_WAIT_L(0); PG8_MMA(0, 0, At, B0); PG8_BAR; PG8_SCHED;
            PG8_LDB(B1, 1, 1); PG8_STAGE(PG8_SB(1, 0), b3, voffB);
            PG8_BAR; PG8_WAIT_L(0); PG8_MMA(0, 1, At, B1); PG8_BAR;
            PG8_LDA(At, 1, 1); PG8_STAGE(PG8_SA(1, 0), a3, voffA);
            PG8_BAR; PG8_WAIT_L(0); PG8_MMA(1, 0, At, B0); PG8_BAR; PG8_SCHED;
            PG8_STAGE(PG8_SB(1, 1), b3 + hstep, voffB);
            PG8_WAIT_V(6); PG8_BAR; PG8_MMA(1, 1, At, B1); PG8_BAR;
            }
        }
        if constexpr (ALIGN_EPI) { if (wr == 0) PG8_BAR; }
        if constexpr (!Epi::AFTER_DRAIN) { E(acc, cur, wr, wc, fr, fq); S.done(cur); }
        if (!has_next) break;
#pragma unroll
        for (int a = 0; a < 2; ++a)
#pragma unroll
            for (int b = 0; b < 2; ++b)
#pragma unroll
                for (int m = 0; m < 4; ++m)
#pragma unroll
                    for (int n = 0; n < 2; ++n) acc[a][b][m][n] = (f32x4){0.f, 0.f, 0.f, 0.f};
        cur = nxt; cA = nA; cB = nB; ++ui;
        if constexpr (ALIGN_EPI) { if (wr == 1) PG8_BAR; }
    }
    PG8_WAIT_V(0);
    if constexpr (!ALIGN_EPI) { if (wr == 0) PG8_BAR; }
    PG8_BAR;
    if constexpr (Epi::AFTER_DRAIN) { E.fused(acc, cur, wr, wc, fr, fq, lds, wid, lane); S.done(cur); }
#undef PG8_SA
#undef PG8_SB
#undef PG8_STAGE
#undef PG8_LDA
#undef PG8_LDB
#undef PG8_MMA
#undef PG8_WAIT_V
#undef PG8_WAIT_L
#undef PG8_BAR
#undef PG8_SCHED
}
}

#define LAS __attribute__((address_space(3)))
typedef unsigned short bf16;
typedef unsigned v4u __attribute__((ext_vector_type(4)));
typedef unsigned v2u __attribute__((ext_vector_type(2)));
typedef float f32x4 __attribute__((ext_vector_type(4)));

constexpr int D = 1024, MP = 16 * 4096, MS = 32 * 32, MT = MP + MS, SEQ = 4096, DSEQ = 32, NB = 16, NBS = 32;
constexpr int NPROJ = 4104, NP = 4096, DC = 512, DQKV = 1536, NH = 4, HD = 128;
constexpr int C_BA = 0, C_CA = 512, C_XA = 1024, C_ZA = 1536, C_QKV = 2048, C_ZG = 3584;
constexpr float RMS_EPS = 1e-6f, L2_EPS = 1e-6f;
constexpr int NWAVES = 8, NTHREADS = 512;
constexpr int LDS_PHASE = 144 * 1024;
constexpr int LDS_BYTES = LDS_PHASE + 256;

constexpr size_t O_Y = 0;
constexpr size_t O_CA_P = (size_t)MT * D;
constexpr size_t O_CQ_P = O_CA_P + 16 * 2 * 512;
constexpr size_t O_ST_P = O_CQ_P + 16 * 3 * 1536;
constexpr size_t O_CA_S = O_ST_P + (size_t)16 * 4 * 128 * 128;
constexpr size_t O_CQ_S = O_CA_S + 32 * 2 * 512;
constexpr size_t O_ST_S = O_CQ_S + 32 * 3 * 1536;
constexpr size_t O_END = O_ST_S + (size_t)32 * 4 * 128 * 128;

constexpr int NCH = NB * NH * 64 + NBS * NH;
constexpr int REC = 90368;
constexpr int R_NEGW = 0, R_QG = 16384, R_ATTN = 32768, R_KDEC = 40960, R_U = 57344, R_EGL = 90112, R_OPS = 57344;
constexpr size_t WS_XB = 0;
constexpr size_t WS_ZG = WS_XB + (size_t)MT * D * 2;
constexpr size_t WS_PA = WS_ZG + (size_t)MT * 512 * 2;
constexpr size_t WS_PQ = WS_PA + (size_t)MT * 2048 * 2;
constexpr size_t WS_QKR = WS_PQ + (size_t)MT * DQKV * 2;
constexpr size_t WS_KVT = WS_QKR + (size_t)MT * 1024 * 2;
constexpr size_t WS_WB1 = WS_KVT + (size_t)NCH * 32768;
constexpr size_t WS_WB2 = WS_WB1 + (size_t)NP * D * 2;
constexpr size_t WS_RSTD = WS_WB2 + (size_t)D * D * 2;
constexpr size_t WS_AB = WS_RSTD + (size_t)MT * 4;
constexpr size_t WS_GB = WS_AB + (size_t)MT * 8 * 4;
constexpr size_t WS_BAR = WS_GB + (size_t)MT * 8 * 4;
constexpr size_t WS_END = WS_BAR + 16384;
constexpr size_t WS_PREP = WS_PA, WS_OUT = WS_PA;
constexpr size_t WS_OB2 = WS_QKR;
static_assert(WS_PREP + (size_t)NCH * REC <= WS_QKR, "PREP must fit in the dead projection regions");
static_assert(WS_END <= ((size_t)1 << 30), "workspace map exceeds 1 GiB");

struct Args { const float* in[14]; float* out; unsigned char* ws; int ph_lo, ph_hi; };

__device__ __forceinline__ unsigned f2bf(float f) { unsigned u = __builtin_bit_cast(unsigned, f); return (u + 0x7fffu + ((u >> 16) & 1u)) >> 16; }
typedef float f32x2_t __attribute__((ext_vector_type(2)));
typedef __bf16 bf16x2_t __attribute__((ext_vector_type(2)));
__device__ __forceinline__ unsigned pk2(float lo, float hi) { const f32x2_t v = {lo, hi}; return __builtin_bit_cast(unsigned, __builtin_convertvector(v, bf16x2_t)); }
__device__ __forceinline__ float bflo(unsigned w) { return __builtin_bit_cast(float, w << 16); }
__device__ __forceinline__ float bfhi(unsigned w) { return __builtin_bit_cast(float, w & 0xffff0000u); }
__device__ __forceinline__ void unpack8(const v4u w, float (&f)[8]) { f[0] = bflo(w.x); f[1] = bfhi(w.x); f[2] = bflo(w.y); f[3] = bfhi(w.y); f[4] = bflo(w.z); f[5] = bfhi(w.z); f[6] = bflo(w.w); f[7] = bfhi(w.w); }
__device__ __forceinline__ v4u pack8(const float (&f)[8]) { v4u w; w.x = pk2(f[0], f[1]); w.y = pk2(f[2], f[3]); w.z = pk2(f[4], f[5]); w.w = pk2(f[6], f[7]); return w; }
__device__ __forceinline__ float wave_sum(float v) {
#pragma unroll
    for (int o = 1; o < 64; o <<= 1) v += __shfl_xor(v, o);
    return v;
}
#define DPPF(v, ctrl) __builtin_bit_cast(float, __builtin_amdgcn_update_dpp(0, __builtin_bit_cast(int, (v)), (ctrl), 0xF, 0xF, true))
__device__ __forceinline__ float red16(float v) {
    v += DPPF(v, 0xB1); v += DPPF(v, 0x4E); v += DPPF(v, 0x141); v += DPPF(v, 0x140); return v; }
__device__ __forceinline__ float silu_f(float x) { return x * __builtin_amdgcn_rcpf(1.0f + __expf(-x)); }
__device__ __forceinline__ float sigmoid_f(float x) { return 1.0f / (1.0f + expf(-x)); }
__device__ __forceinline__ float softplus_f(float x) { return x > 20.f ? x : log1pf(expf(x)); }

__device__ __forceinline__ void p0_transpose_item(const float* W, int K, int ldw, int N, const float* sc, bf16* WT, float* scr, int item, int lane) {
    const int nblk = N / 32, kb = item / nblk, nb = item % nblk, k0 = 64 * kb, n0 = 32 * nb;
#pragma unroll 8
    for (int i = 0; i < 32; ++i) { const int kk = 2 * i + (lane >> 5); const float s = sc ? sc[k0 + kk] : 1.0f; scr[kk * 33 + (lane & 31)] = W[(size_t)(k0 + kk) * ldw + n0 + (lane & 31)] * s; }
    asm volatile("s_waitcnt lgkmcnt(0)" ::: "memory");
    const int c = lane & 7;
#pragma unroll
    for (int j = 0; j < 4; ++j) { const int n = (lane >> 3) + 8 * j; const float* s = scr + (8 * c) * 33 + n;
        v4u o; o.x = pk2(s[0 * 33], s[1 * 33]); o.y = pk2(s[2 * 33], s[3 * 33]); o.z = pk2(s[4 * 33], s[5 * 33]); o.w = pk2(s[6 * 33], s[7 * 33]);
        *(v4u*)(WT + (size_t)(n0 + n) * K + k0 + 8 * c) = o; }
    asm volatile("s_waitcnt lgkmcnt(0)" ::: "memory");
}
__device__ __forceinline__ void phase0(const Args& a, unsigned char* lds, int G) {
    const int tid = threadIdx.x, lane = tid & 63, wave = tid >> 6;
    const int gw = blockIdx.x * NWAVES + wave, NGW = G * NWAVES;
    unsigned char* ws = a.ws;
    const float* ln_pre = a.in[5]; const float* w_in = a.in[6]; const float* w_out = a.in[12];
    float* scr = (float*)(lds + wave * 16384);
    constexpr int I1 = (D / 64) * (NP / 32), I2 = (D / 64) * (D / 32);
    for (int it = gw; it < I1 + I2; it += NGW) {
        if (it < I1) p0_transpose_item(w_in, D, NPROJ, NP, ln_pre, (bf16*)(ws + WS_WB1), scr, it, lane);
        else p0_transpose_item(w_out, D, D, D, nullptr, (bf16*)(ws + WS_WB2), scr, it - I1, lane);
    }
    float wx[4][4][8];
#pragma unroll
    for (int i = 0; i < 4; ++i)
#pragma unroll
        for (int c = 0; c < 4; ++c) { const int k = 256 * i + 4 * lane + c; const float s = ln_pre[k];
            const f32x4 w0 = *(const f32x4*)(w_in + (size_t)k * NPROJ + NP), w1 = *(const f32x4*)(w_in + (size_t)k * NPROJ + NP + 4);
#pragma unroll
            for (int j = 0; j < 4; ++j) { wx[i][c][j] = w0[j] * s; wx[i][c][4 + j] = w1[j] * s; } }
    float* rstd = (float*)(ws + WS_RSTD); float* ab = (float*)(ws + WS_AB); bf16* xb = (bf16*)(ws + WS_XB);
    for (int r = gw; r < MT; r += NGW) {
        const float* xrow = (r < MP) ? a.in[0] + (size_t)r * D : a.in[1] + (size_t)(r - MP) * D;
        f32x4 v[4]; float ss = 0.f; float dot[8];
#pragma unroll
        for (int j = 0; j < 8; ++j) dot[j] = 0.f;
#pragma unroll
        for (int i = 0; i < 4; ++i) { v[i] = *((const f32x4*)xrow + 64 * i + lane);
#pragma unroll
            for (int c = 0; c < 4; ++c) { ss += v[i][c] * v[i][c];
#pragma unroll
                for (int j = 0; j < 8; ++j) dot[j] += v[i][c] * wx[i][c][j]; } }
        ss = wave_sum(ss);
#pragma unroll
        for (int j = 0; j < 8; ++j) dot[j] = wave_sum(dot[j]);
        const float rs = 1.0f / sqrtf(ss * (1.0f / D) + RMS_EPS);
        unsigned long long* o8 = (unsigned long long*)(xb + (size_t)r * D) + lane;
#pragma unroll
        for (int i = 0; i < 4; ++i) o8[64 * i] = (unsigned long long)pk2(v[i][0], v[i][1]) | ((unsigned long long)pk2(v[i][2], v[i][3]) << 32);
        if (lane == 0) rstd[r] = rs;
        if (lane < 8) { float d = dot[0];
#pragma unroll
            for (int j = 1; j < 8; ++j) d = (lane == j) ? dot[j] : d;
            ab[(size_t)r * 8 + lane] = d * rs; }
    }
}

#define XB_TMO      128
#define XB_XCNT(j)  (256  + 64 * (j))
#define XB_XSUB(j)  (1280 + 64 * (j))
#define XB_XGEN(j)  (2304 + 64 * (j))
#define XB_TOP      3328
#define XB_TOPGEN   3392
#define XCD_BAR_WORDS 3456
#define XB_SPIN_CAP (1u << 18)

__device__ __forceinline__ unsigned xb_ld(unsigned* p)              { return __hip_atomic_load(p, __ATOMIC_RELAXED, __HIP_MEMORY_SCOPE_AGENT); }
__device__ __forceinline__ unsigned xb_add(unsigned* p, unsigned v) { return __hip_atomic_fetch_add(p, v, __ATOMIC_RELAXED, __HIP_MEMORY_SCOPE_AGENT); }
__device__ __forceinline__ unsigned xb_xcc_id() { return (unsigned)__builtin_amdgcn_s_getreg((3 << 11) | 20) & 0xFu; }
#define XB_SPIN(cond, bar) do { unsigned _sp = 0; while (cond) { __builtin_amdgcn_s_sleep(1); \
    if ((++_sp & 255u) == 0u) { if (xb_ld(&(bar)[XB_TMO])) break; if (_sp > XB_SPIN_CAP) { atomicAdd(&(bar)[XB_TMO], 1u); break; } } } } while (0)
struct XcdBarrier {
    unsigned* bar; unsigned x;
    volatile LAS unsigned* st;
};

__device__ __forceinline__ XcdBarrier xcd_barrier_post(unsigned* bar, volatile LAS unsigned* st) {
    XcdBarrier b; b.bar = bar; b.x = xb_xcc_id(); b.st = st;
    if (threadIdx.x == 0) (void)xb_add(&bar[XB_XCNT(b.x)], 1u);
    return b;
}
__device__ __forceinline__ void xcd_barrier_complete(unsigned* bar, unsigned x, unsigned& nloc, unsigned& nx) {
    const unsigned G = gridDim.x * gridDim.y * gridDim.z;
    unsigned sum, cnt, mine, sp = 0u;
    for (;;) {
        sum = 0u; cnt = 0u; mine = 0u;
#pragma unroll
        for (unsigned j = 0; j < 16; ++j) { const unsigned c = xb_ld(&bar[XB_XCNT(j)]); sum += c; cnt += (c > 0u) ? 1u : 0u; mine = (j == x) ? c : mine; }
        if (sum == G) break;
        __builtin_amdgcn_s_sleep(1);
        if ((++sp & 255u) == 0u) { if (xb_ld(&bar[XB_TMO])) break; if (sp > XB_SPIN_CAP) { atomicAdd(&bar[XB_TMO], 1u); break; } }
    }
    nloc = mine > 0u ? mine : 1u; nx = cnt > 0u ? cnt : 1u;
}

__device__ __forceinline__ void xcd_barrier(const XcdBarrier& b) {
    asm volatile("s_waitcnt vmcnt(0)" ::: "memory");
    __syncthreads();
    if (threadIdx.x == 0) {
        unsigned* bar = b.bar;
        __builtin_amdgcn_s_waitcnt(0);
        unsigned nloc = b.st[0], nx = b.st[1];
        if (nloc == 0u) { xcd_barrier_complete(bar, b.x, nloc, nx); b.st[0] = nloc; b.st[1] = nx; }
        const unsigned old = xb_add(&bar[XB_XSUB(b.x)], 1u);
        const unsigned gen = old / nloc;
        if (old + 1u == (gen + 1u) * nloc) {
            __builtin_amdgcn_fence(__ATOMIC_RELEASE, "agent");
            asm volatile("s_waitcnt vmcnt(0)" ::: "memory");
            const unsigned og = xb_add(&bar[XB_TOP], 1u);
            const unsigned tg = og / nx;
            if (og + 1u == (tg + 1u) * nx) xb_add(&bar[XB_TOPGEN], 1u);
            else XB_SPIN(xb_ld(&bar[XB_TOPGEN]) == tg, bar);
            __builtin_amdgcn_fence(__ATOMIC_ACQUIRE, "agent");
            xb_add(&bar[XB_XGEN(b.x)], 1u);
            asm volatile("s_waitcnt vmcnt(0)" ::: "memory");
        } else {
            XB_SPIN(xb_ld(&bar[XB_XGEN(b.x)]) == gen, bar);
            __builtin_amdgcn_fence(__ATOMIC_ACQUIRE, "agent");
            asm volatile("s_waitcnt vmcnt(0)" ::: "memory");
        }
    }
    __syncthreads();
}

__device__ __forceinline__ void phase2(const Args& a, int G) {
    const int tid = threadIdx.x, lane = tid & 63, wave = tid >> 6;
    const int gw = blockIdx.x * NWAVES + wave, NGW = G * NWAVES;
    unsigned char* ws = a.ws;
    const bf16* pa = (const bf16*)(ws + WS_PA); const bf16* pq = (const bf16*)(ws + WS_PQ);
    bf16* mix = (bf16*)(ws + WS_XB); bf16* qkr = (bf16*)(ws + WS_QKR); bf16* kvt = (bf16*)(ws + WS_KVT);
    const float* ab = (const float*)(ws + WS_AB); float* gbv = (float*)(ws + WS_GB);
    const float* cache_a = a.in[2]; const float* cache_q = a.in[3]; const float* cw_a = a.in[7]; const float* cw_q = a.in[8];
    const float* a_log = a.in[9]; const float* dt_bias = a.in[10];
    float* out = a.out;
    const int c8 = 8 * lane;
    const int hh = lane >> 4, dl = 8 * (lane & 15);
    constexpr int RB = 8;
    for (int blk = gw; blk < MT / RB; blk += NGW) {
        const int r0 = blk * RB;
        const bool smp = r0 >= MP;
        const int b = smp ? (r0 - MP) / DSEQ : r0 / SEQ;
        const int t0 = smp ? (r0 - MP) % DSEQ : r0 % SEQ;
        const int rh = (t0 == 0) ? r0 : r0 - 3;
        {
            float w[3][8];
#pragma unroll
            for (int j = 0; j < 3; ++j) { const f32x4 x0 = *(const f32x4*)(cw_a + j * DC + c8), x1 = *(const f32x4*)(cw_a + j * DC + c8 + 4);
#pragma unroll
                for (int c = 0; c < 4; ++c) { w[j][c] = x0[c]; w[j][4 + c] = x1[c]; } }
            float um2[8], um1[8];
            {
                const int h2 = (t0 == 0) ? r0 : r0 - 2, h1 = (t0 == 0) ? r0 : r0 - 1;
                const v4u c2 = *(const v4u*)(pa + (size_t)h2 * 2048 + C_CA + c8), x2 = *(const v4u*)(pa + (size_t)h2 * 2048 + C_XA + c8);
                const v4u c1 = *(const v4u*)(pa + (size_t)h1 * 2048 + C_CA + c8), x1 = *(const v4u*)(pa + (size_t)h1 * 2048 + C_XA + c8);
                float ca[8], xa[8];
                unpack8(c2, ca); unpack8(x2, xa);
#pragma unroll
                for (int c = 0; c < 8; ++c) um2[c] = ca[c] * xa[c];
                unpack8(c1, ca); unpack8(x1, xa);
#pragma unroll
                for (int c = 0; c < 8; ++c) um1[c] = ca[c] * xa[c];
                if (t0 == 0) {
                    if (smp) { const float* cp = cache_a + (size_t)b * 2 * DC + c8;
#pragma unroll
                        for (int c = 0; c < 8; ++c) { um2[c] = cp[c]; um1[c] = cp[DC + c]; } }
                    else {
#pragma unroll
                        for (int c = 0; c < 8; ++c) { um2[c] = 0.f; um1[c] = 0.f; } }
                }
            }
#pragma unroll 1
            for (int hb = 0; hb < 2; ++hb) {
                v4u lb[4], lc[4], lx[4], lz[4];
#pragma unroll
                for (int i = 0; i < 4; ++i) { const bf16* pr = pa + (size_t)(r0 + 4 * hb + i) * 2048 + c8;
                    lb[i] = *(const v4u*)(pr + C_BA); lc[i] = *(const v4u*)(pr + C_CA); lx[i] = *(const v4u*)(pr + C_XA); lz[i] = *(const v4u*)(pr + C_ZA); }
#pragma unroll
                for (int i = 0; i < 4; ++i) {
                    float ba[8], ca[8], xa[8], za[8], y[8];
                    unpack8(lb[i], ba); unpack8(lc[i], ca); unpack8(lx[i], xa); unpack8(lz[i], za);
#pragma unroll
                    for (int c = 0; c < 8; ++c) { const float u = ca[c] * xa[c]; const float cv = w[0][c] * um2[c] + w[1][c] * um1[c] + w[2][c] * u; y[c] = ba[c] * cv * silu_f(za[c]); um2[c] = um1[c]; um1[c] = u; }
                    *(v4u*)(mix + (size_t)(r0 + 4 * hb + i) * D + c8) = pack8(y);
                }
            }
        }
        const int ch = smp ? NB * NH * 64 + b * NH + hh : (b * NH + hh) * 64 + t0 / 64;
        const int tq = smp ? t0 : (t0 & 63);
        const int ks = tq >> 4, jj0 = (tq & 8) >> 1;
#pragma unroll 1
        for (int seg = 0; seg < 3; ++seg) {
            const int cc = seg * 512 + c8;
            v4u lx[RB + 3];
#pragma unroll
            for (int i = 0; i < 3; ++i) lx[i] = *(const v4u*)(pq + (size_t)(rh + (t0 == 0 ? 0 : i)) * DQKV + cc);
#pragma unroll
            for (int i = 0; i < RB; ++i) lx[3 + i] = *(const v4u*)(pq + (size_t)(r0 + i) * DQKV + cc);
            float w[4][8];
#pragma unroll
            for (int j = 0; j < 4; ++j) { const f32x4 x0 = *(const f32x4*)(cw_q + j * DQKV + cc), x1 = *(const f32x4*)(cw_q + j * DQKV + cc + 4);
#pragma unroll
                for (int c = 0; c < 4; ++c) { w[j][c] = x0[c]; w[j][4 + c] = x1[c]; } }
            float xm3[8], xm2[8], xm1[8];
            unpack8(lx[0], xm3); unpack8(lx[1], xm2); unpack8(lx[2], xm1);
            if (t0 == 0) {
                if (smp) { const float* cp = cache_q + (size_t)b * 3 * DQKV + cc;
#pragma unroll
                    for (int c = 0; c < 8; ++c) { xm3[c] = cp[c]; xm2[c] = cp[DQKV + c]; xm1[c] = cp[2 * DQKV + c]; } }
                else {
#pragma unroll
                    for (int c = 0; c < 8; ++c) { xm3[c] = 0.f; xm2[c] = 0.f; xm1[c] = 0.f; } }
            }
            unsigned tkp[8][4];
#pragma unroll
            for (int i = 0; i < RB; ++i) {
                const int r = r0 + i;
                float x[8], s[8]; unpack8(lx[3 + i], x);
                float ss = 0.f;
#pragma unroll
                for (int c = 0; c < 8; ++c) { const float cv = w[0][c] * xm3[c] + w[1][c] * xm2[c] + w[2][c] * xm1[c] + w[3][c] * x[c]; s[c] = silu_f(cv); ss += s[c] * s[c]; xm3[c] = xm2[c]; xm2[c] = xm1[c]; xm1[c] = x[c]; }
                if (seg < 2) {
                    ss = red16(ss);
                    float inv = __builtin_amdgcn_rsqf(ss + L2_EPS); if (seg == 0) inv *= 0.08838834764831845f;
#pragma unroll
                    for (int c = 0; c < 8; ++c) s[c] *= inv;
                    bf16* qp = qkr + (size_t)r * 1024 + seg * 512 + hh * HD + (dl & ~15) + 4 * (lane & 1);
                    *(v2u*)qp = (v2u){pk2(s[0], s[1]), pk2(s[2], s[3])};
                    *(v2u*)(qp + 8) = (v2u){pk2(s[4], s[5]), pk2(s[6], s[7])};
                }
                if (seg >= 1) {
#pragma unroll
                    for (int c = 0; c < 8; ++c) { const unsigned bv = pk2(s[c], 0.f) & 0xffffu; if (i & 1) tkp[c][i >> 1] |= bv << 16; else tkp[c][i >> 1] = bv; }
                }
            }
            if (seg >= 1) {
                bf16* base = kvt + (size_t)ch * 16384 + (seg - 1) * 8192;
#pragma unroll
                for (int c = 0; c < 8; ++c) { const int d = dl + c, dt = d >> 5, rr = d & 31;
                    bf16* bp = base + (dt * 4 + ks) * 512 + rr * 8 + jj0;
                    *(v2u*)bp = (v2u){tkp[c][0], tkp[c][1]};
                    *(v2u*)(bp + 256) = (v2u){tkp[c][2], tkp[c][3]}; }
            }
        }
        if (lane < RB * NH) { const int i = lane >> 2, h = lane & 3, r = r0 + i;
            const float ad = ab[(size_t)r * 8 + h], bb = ab[(size_t)r * 8 + 4 + h];
            gbv[(size_t)r * 8 + h] = -expf(a_log[h]) * softplus_f(ad + dt_bias[h]);
            gbv[(size_t)r * 8 + 4 + h] = sigmoid_f(bb); }
    }
    for (int it = gw; it < (NB + NBS) * 5; it += NGW) {
        const int sq = it / 5, j = it % 5; const bool smp = sq >= NB; const int b = smp ? sq - NB : sq;
        const int rend = smp ? MP + (b + 1) * DSEQ : (b + 1) * SEQ;
        if (j < 2) { const int r = rend - 2 + j; float ca[8], xa[8];
            unpack8(*(const v4u*)(pa + (size_t)r * 2048 + C_CA + c8), ca); unpack8(*(const v4u*)(pa + (size_t)r * 2048 + C_XA + c8), xa);
            float* op = out + (smp ? O_CA_S : O_CA_P) + ((size_t)b * 2 + j) * DC + c8;
            *(f32x4*)op = (f32x4){ca[0] * xa[0], ca[1] * xa[1], ca[2] * xa[2], ca[3] * xa[3]}; *(f32x4*)(op + 4) = (f32x4){ca[4] * xa[4], ca[5] * xa[5], ca[6] * xa[6], ca[7] * xa[7]};
        } else { const int jj = j - 2, r = rend - 3 + jj;
#pragma unroll
            for (int seg = 0; seg < 3; ++seg) { float x[8]; unpack8(*(const v4u*)(pq + (size_t)r * DQKV + seg * 512 + c8), x);
                float* op = out + (smp ? O_CQ_S : O_CQ_P) + ((size_t)b * 3 + jj) * DQKV + seg * 512 + c8;
                *(f32x4*)op = (f32x4){x[0], x[1], x[2], x[3]}; *(f32x4*)(op + 4) = (f32x4){x[4], x[5], x[6], x[7]}; }
        }
    }
}

typedef short bf16x8 __attribute__((ext_vector_type(8)));
typedef float f32x16 __attribute__((ext_vector_type(16)));
#define MFMA32(a, b, c) __builtin_amdgcn_mfma_f32_32x32x16_bf16((a), (b), (c), 0, 0, 0)
__device__ __forceinline__ bf16x8 pack_regs(const f32x16& x, int s) {
    v4u w; w.x = pk2(x[8 * s + 0], x[8 * s + 1]); w.y = pk2(x[8 * s + 2], x[8 * s + 3]); w.z = pk2(x[8 * s + 4], x[8 * s + 5]); w.w = pk2(x[8 * s + 6], x[8 * s + 7]);
    return __builtin_bit_cast(bf16x8, w);
}
__device__ __forceinline__ f32x16 zero16() { f32x16 z;
#pragma unroll
    for (int i = 0; i < 16; ++i) z[i] = 0.f;
    return z; }
constexpr int AP = 68;
constexpr int SLOT_BYTES = 64 * AP * 4 + 1024;
static_assert(SLOT_BYTES * NWAVES <= LDS_PHASE, "chunk-prep LDS");

__device__ __forceinline__ void chunk_prep_item(const Args& a, float* Am, float* tab, const int ch, const int lane) {
    unsigned char* ws = a.ws;
    const bf16* qkr = (const bf16*)(ws + WS_QKR); const bf16* kvt = (const bf16*)(ws + WS_KVT); const float* gbv = (const float*)(ws + WS_GB);
    const int r = lane & 31, hf = lane >> 5;
    {
        const bool smp = ch >= NB * NH * 64;
        int rbase, hh, ntok;
        if (smp) { const int sl = ch - NB * NH * 64; rbase = MP + (sl >> 2) * DSEQ; hh = sl & 3; ntok = DSEQ; }
        else { const int sq = ch >> 6, n = ch & 63; rbase = (sq >> 2) * SEQ + n * 64; hh = sq & 3; ntok = 64; }
        const int nks = ntok >> 4;
        unsigned char* rec = ws + WS_PREP + (size_t)ch * REC;
        float g = 0.f, bt = 0.f;
        if (lane < ntok) { g = gbv[(size_t)(rbase + lane) * 8 + hh]; bt = gbv[(size_t)(rbase + lane) * 8 + 4 + hh]; }
        float gb = g;
        gb += DPPF(gb, 0x111); gb += DPPF(gb, 0x112); gb += DPPF(gb, 0x114); gb += DPPF(gb, 0x118);
        gb += __builtin_bit_cast(float, __builtin_amdgcn_update_dpp(0, __builtin_bit_cast(int, gb), 0x142, 0xA, 0xF, false));
        gb += __builtin_bit_cast(float, __builtin_amdgcn_update_dpp(0, __builtin_bit_cast(int, gb), 0x143, 0xC, 0xF, false));
        const float gl = __builtin_bit_cast(float, __builtin_amdgcn_readlane(__builtin_bit_cast(int, gb), 63));
        tab[lane] = gb; tab[64 + lane] = bt; tab[128 + lane] = expf(gb); tab[192 + lane] = expf(gl - gb);
        asm volatile("s_waitcnt lgkmcnt(0)" ::: "memory");
        const int row0 = r & (ntok - 1), row1 = (32 + r) & (ntok - 1);
        const bf16* q0p = qkr + (size_t)(rbase + row0) * 1024 + hh * HD + 8 * hf; const bf16* q1p = qkr + (size_t)(rbase + row1) * 1024 + hh * HD + 8 * hf;
        f32x16 at00 = zero16(), at01 = zero16(), at11 = zero16(), ak00 = zero16(), ak10 = zero16(), ak11 = zero16();
        const float e0 = tab[128 + r], e1 = tab[160 + r];
#pragma unroll
        for (int ks8 = 0; ks8 < 8; ++ks8) {
            const v4u qf0 = *(const v4u*)(q0p + 16 * ks8), qf1 = *(const v4u*)(q1p + 16 * ks8), kf0 = *(const v4u*)(q0p + 512 + 16 * ks8), kf1 = *(const v4u*)(q1p + 512 + 16 * ks8);
            const bf16x8 q0 = __builtin_bit_cast(bf16x8, qf0), q1 = __builtin_bit_cast(bf16x8, qf1), k0 = __builtin_bit_cast(bf16x8, kf0), k1 = __builtin_bit_cast(bf16x8, kf1);
            at00 = MFMA32(k0, q0, at00); at01 = MFMA32(k0, q1, at01); at11 = MFMA32(k1, q1, at11);
            ak00 = MFMA32(k0, k0, ak00); ak10 = MFMA32(k0, k1, ak10); ak11 = MFMA32(k1, k1, ak11);
            float f0[8], f1[8]; unpack8(qf0, f0); unpack8(qf1, f1);
#pragma unroll
            for (int c = 0; c < 8; ++c) { f0[c] *= e0; f1[c] *= e1; }
            *(v4u*)(rec + R_QG + (0 * 8 + ks8) * 1024 + lane * 16) = pack8(f0);
            *(v4u*)(rec + R_QG + (1 * 8 + ks8) * 1024 + lane * 16) = pack8(f1);
        }
        {
            const float gi0 = tab[r], gi1 = tab[32 + r];
#pragma unroll
            for (int tile = 0; tile < 3; ++tile) {
                const int jt = (tile == 2) ? 1 : 0, it = (tile == 0) ? 0 : 1;
                f32x16& acc = (tile == 0) ? at00 : (tile == 1 ? at01 : at11);
                const float gi = it ? gi1 : gi0; const int i = 32 * it + r;
#pragma unroll
                for (int gq = 0; gq < 4; ++gq) { const f32x4 gj = *(const f32x4*)(tab + 32 * jt + 8 * gq + 4 * hf);
#pragma unroll
                    for (int c = 0; c < 4; ++c) { const int j = 32 * jt + 8 * gq + 4 * hf + c; const float dcy = __expf(fminf(gi - gj[c], 0.f)); acc[4 * gq + c] = (i >= j) ? acc[4 * gq + c] * dcy : 0.f; } }
#pragma unroll
                for (int s = 0; s < 2; ++s) *(bf16x8*)(rec + R_ATTN + (it * 4 + 2 * jt + s) * 1024 + lane * 16) = pack_regs(acc, s);
            }
        }
        {
            const float gi0 = tab[r], gi1 = tab[32 + r], bi0 = tab[64 + r], bi1 = tab[96 + r];
#pragma unroll
            for (int tile = 0; tile < 3; ++tile) {
                const int jt = (tile == 2) ? 1 : 0, it = (tile == 0) ? 0 : 1;
                const f32x16& acc = (tile == 0) ? ak00 : (tile == 1 ? ak10 : ak11);
                const float gi = it ? gi1 : gi0, bi = it ? bi1 : bi0; const int i = 32 * it + r;
#pragma unroll
                for (int gq = 0; gq < 4; ++gq) { const f32x4 gj = *(const f32x4*)(tab + 32 * jt + 8 * gq + 4 * hf);
#pragma unroll
                    for (int c = 0; c < 4; ++c) { const int j = 32 * jt + 8 * gq + 4 * hf + c; Am[j * AP + i] = bi * acc[4 * gq + c] * __expf(fminf(gi - gj[c], 0.f)); } }
            }
        }
        asm volatile("s_waitcnt lgkmcnt(0)" ::: "memory");
        v4u ktr[4][4];
        const bf16* ktp = kvt + (size_t)ch * 16384 + lane * 8;
        __builtin_amdgcn_sched_barrier(0);
#pragma unroll
        for (int dt = 0; dt < 2; ++dt)
#pragma unroll
            for (int ks = 0; ks < 4; ++ks) ktr[dt][ks] = *(const v4u*)(ktp + (dt * 4 + ((ks < nks) ? ks : 0)) * 512);
        {
            float x0 = (lane == 0) ? 1.f : 0.f, x1 = (lane == 1) ? 1.f : 0.f, x2 = (lane == 2) ? 1.f : 0.f, x3 = (lane == 3) ? 1.f : 0.f, x4 = (lane == 4) ? 1.f : 0.f, x5 = (lane == 5) ? 1.f : 0.f, x6 = (lane == 6) ? 1.f : 0.f, x7 = (lane == 7) ? 1.f : 0.f, x8 = (lane == 8) ? 1.f : 0.f, x9 = (lane == 9) ? 1.f : 0.f, x10 = (lane == 10) ? 1.f : 0.f, x11 = (lane == 11) ? 1.f : 0.f, x12 = (lane == 12) ? 1.f : 0.f, x13 = (lane == 13) ? 1.f : 0.f, x14 = (lane == 14) ? 1.f : 0.f, x15 = (lane == 15) ? 1.f : 0.f, x16 = (lane == 16) ? 1.f : 0.f, x17 = (lane == 17) ? 1.f : 0.f, x18 = (lane == 18) ? 1.f : 0.f, x19 = (lane == 19) ? 1.f : 0.f, x20 = (lane == 20) ? 1.f : 0.f, x21 = (lane == 21) ? 1.f : 0.f, x22 = (lane == 22) ? 1.f : 0.f, x23 = (lane == 23) ? 1.f : 0.f, x24 = (lane == 24) ? 1.f : 0.f, x25 = (lane == 25) ? 1.f : 0.f, x26 = (lane == 26) ? 1.f : 0.f, x27 = (lane == 27) ? 1.f : 0.f, x28 = (lane == 28) ? 1.f : 0.f, x29 = (lane == 29) ? 1.f : 0.f, x30 = (lane == 30) ? 1.f : 0.f, x31 = (lane == 31) ? 1.f : 0.f, x32 = (lane == 32) ? 1.f : 0.f, x33 = (lane == 33) ? 1.f : 0.f, x34 = (lane == 34) ? 1.f : 0.f, x35 = (lane == 35) ? 1.f : 0.f, x36 = (lane == 36) ? 1.f : 0.f, x37 = (lane == 37) ? 1.f : 0.f, x38 = (lane == 38) ? 1.f : 0.f, x39 = (lane == 39) ? 1.f : 0.f, x40 = (lane == 40) ? 1.f : 0.f, x41 = (lane == 41) ? 1.f : 0.f, x42 = (lane == 42) ? 1.f : 0.f, x43 = (lane == 43) ? 1.f : 0.f, x44 = (lane == 44) ? 1.f : 0.f, x45 = (lane == 45) ? 1.f : 0.f, x46 = (lane == 46) ? 1.f : 0.f, x47 = (lane == 47) ? 1.f : 0.f, x48 = (lane == 48) ? 1.f : 0.f, x49 = (lane == 49) ? 1.f : 0.f, x50 = (lane == 50) ? 1.f : 0.f, x51 = (lane == 51) ? 1.f : 0.f, x52 = (lane == 52) ? 1.f : 0.f, x53 = (lane == 53) ? 1.f : 0.f, x54 = (lane == 54) ? 1.f : 0.f, x55 = (lane == 55) ? 1.f : 0.f, x56 = (lane == 56) ? 1.f : 0.f, x57 = (lane == 57) ? 1.f : 0.f, x58 = (lane == 58) ? 1.f : 0.f, x59 = (lane == 59) ? 1.f : 0.f, x60 = (lane == 60) ? 1.f : 0.f, x61 = (lane == 61) ? 1.f : 0.f, x62 = (lane == 62) ? 1.f : 0.f, x63 = (lane == 63) ? 1.f : 0.f;
            f32x4 ca0, cb0, ca1, cb1, ca2, cb2, ca3, cb3;
            ca0 = *(const f32x4*)(Am + 0 * AP + 0);
            ca1 = *(const f32x4*)(Am + 0 * AP + 4);
            ca2 = *(const f32x4*)(Am + 0 * AP + 8);
            ca3 = *(const f32x4*)(Am + 0 * AP + 12);
            cb0 = *(const f32x4*)(Am + 0 * AP + 16);
            cb1 = *(const f32x4*)(Am + 0 * AP + 20);
            cb2 = *(const f32x4*)(Am + 0 * AP + 24);
            cb3 = *(const f32x4*)(Am + 0 * AP + 28);
            __builtin_amdgcn_sched_barrier(0);
            x1 -= ca0[1] * x0; x2 -= ca0[2] * x0; x3 -= ca0[3] * x0; x4 -= ca1[0] * x0; x5 -= ca1[1] * x0; x6 -= ca1[2] * x0; x7 -= ca1[3] * x0; x8 -= ca2[0] * x0; x9 -= ca2[1] * x0; x10 -= ca2[2] * x0; x11 -= ca2[3] * x0; x12 -= ca3[0] * x0; x13 -= ca3[1] * x0; x14 -= ca3[2] * x0; x15 -= ca3[3] * x0;
            __builtin_amdgcn_sched_barrier(0);
            ca0 = *(const f32x4*)(Am + 0 * AP + 32);
            ca1 = *(const f32x4*)(Am + 0 * AP + 36);
            ca2 = *(const f32x4*)(Am + 0 * AP + 40);
            ca3 = *(const f32x4*)(Am + 0 * AP + 44);
            __builtin_amdgcn_sched_barrier(0);
            x16 -= cb0[0] * x0; x17 -= cb0[1] * x0; x18 -= cb0[2] * x0; x19 -= cb0[3] * x0; x20 -= cb1[0] * x0; x21 -= cb1[1] * x0; x22 -= cb1[2] * x0; x23 -= cb1[3] * x0; x24 -= cb2[0] * x0; x25 -= cb2[1] * x0; x26 -= cb2[2] * x0; x27 -= cb2[3] * x0; x28 -= cb3[0] * x0; x29 -= cb3[1] * x0; x30 -= cb3[2] * x0; x31 -= cb3[3] * x0;
            __builtin_amdgcn_sched_barrier(0);
            cb0 = *(const f32x4*)(Am + 0 * AP + 48);
            cb1 = *(const f32x4*)(Am + 0 * AP + 52);
            cb2 = *(const f32x4*)(Am + 0 * AP + 56);
            cb3 = *(const f32x4*)(Am + 0 * AP + 60);
            __builtin_amdgcn_sched_barrier(0);
            x32 -= ca0[0] * x0; x33 -= ca0[1] * x0; x34 -= ca0[2] * x0; x35 -= ca0[3] * x0; x36 -= ca1[0] * x0; x37 -= ca1[1] * x0; x38 -= ca1[2] * x0; x39 -= ca1[3] * x0; x40 -= ca2[0] * x0; x41 -= ca2[1] * x0; x42 -= ca2[2] * x0; x43 -= ca2[3] * x0; x44 -= ca3[0] * x0; x45 -= ca3[1] * x0; x46 -= ca3[2] * x0; x47 -= ca3[3] * x0;
            __builtin_amdgcn_sched_barrier(0);
            ca0 = *(const f32x4*)(Am + 1 * AP + 0);
            ca1 = *(const f32x4*)(Am + 1 * AP + 4);
            ca2 = *(const f32x4*)(Am + 1 * AP + 8);
            ca3 = *(const f32x4*)(Am + 1 * AP + 12);
            __builtin_amdgcn_sched_barrier(0);
            x48 -= cb0[0] * x0; x49 -= cb0[1] * x0; x50 -= cb0[2] * x0; x51 -= cb0[3] * x0; x52 -= cb1[0] * x0; x53 -= cb1[1] * x0; x54 -= cb1[2] * x0; x55 -= cb1[3] * x0; x56 -= cb2[0] * x0; x57 -= cb2[1] * x0; x58 -= cb2[2] * x0; x59 -= cb2[3] * x0; x60 -= cb3[0] * x0; x61 -= cb3[1] * x0; x62 -= cb3[2] * x0; x63 -= cb3[3] * x0;
            __builtin_amdgcn_sched_barrier(0);
            cb0 = *(const f32x4*)(Am + 1 * AP + 16);
            cb1 = *(const f32x4*)(Am + 1 * AP + 20);
            cb2 = *(const f32x4*)(Am + 1 * AP + 24);
            cb3 = *(const f32x4*)(Am + 1 * AP + 28);
            __builtin_amdgcn_sched_barrier(0);
            x2 -= ca0[2] * x1; x3 -= ca0[3] * x1; x4 -= ca1[0] * x1; x5 -= ca1[1] * x1; x6 -= ca1[2] * x1; x7 -= ca1[3] * x1; x8 -= ca2[0] * x1; x9 -= ca2[1] * x1; x10 -= ca2[2] * x1; x11 -= ca2[3] * x1; x12 -= ca3[0] * x1; x13 -= ca3[1] * x1; x14 -= ca3[2] * x1; x15 -= ca3[3] * x1;
            __builtin_amdgcn_sched_barrier(0);
            ca0 = *(const f32x4*)(Am + 1 * AP + 32);
            ca1 = *(const f32x4*)(Am + 1 * AP + 36);
            ca2 = *(const f32x4*)(Am + 1 * AP + 40);
            ca3 = *(const f32x4*)(Am + 1 * AP + 44);
            __builtin_amdgcn_sched_barrier(0);
            x16 -= cb0[0] * x1; x17 -= cb0[1] * x1; x18 -= cb0[2] * x1; x19 -= cb0[3] * x1; x20 -= cb1[0] * x1; x21 -= cb1[1] * x1; x22 -= cb1[2] * x1; x23 -= cb1[3] * x1; x24 -= cb2[0] * x1; x25 -= cb2[1] * x1; x26 -= cb2[2] * x1; x27 -= cb2[3] * x1; x28 -= cb3[0] * x1; x29 -= cb3[1] * x1; x30 -= cb3[2] * x1; x31 -= cb3[3] * x1;
            __builtin_amdgcn_sched_barrier(0);
            cb0 = *(const f32x4*)(Am + 1 * AP + 48);
            cb1 = *(const f32x4*)(Am + 1 * AP + 52);
            cb2 = *(const f32x4*)(Am + 1 * AP + 56);
            cb3 = *(const f32x4*)(Am + 1 * AP + 60);
            __builtin_amdgcn_sched_barrier(0);
            x32 -= ca0[0] * x1; x33 -= ca0[1] * x1; x34 -= ca0[2] * x1; x35 -= ca0[3] * x1; x36 -= ca1[0] * x1; x37 -= ca1[1] * x1; x38 -= ca1[2] * x1; x39 -= ca1[3] * x1; x40 -= ca2[0] * x1; x41 -= ca2[1] * x1; x42 -= ca2[2] * x1; x43 -= ca2[3] * x1; x44 -= ca3[0] * x1; x45 -= ca3[1] * x1; x46 -= ca3[2] * x1; x47 -= ca3[3] * x1;
            __builtin_amdgcn_sched_barrier(0);
            ca0 = *(const f32x4*)(Am + 2 * AP + 0);
            ca1 = *(const f32x4*)(Am + 2 * AP + 4);
            ca2 = *(const f32x4*)(Am + 2 * AP + 8);
            ca3 = *(const f32x4*)(Am + 2 * AP + 12);
            __builtin_amdgcn_sched_barrier(0);
            x48 -= cb0[0] * x1; x49 -= cb0[1] * x1; x50 -= cb0[2] * x1; x51 -= cb0[3] * x1; x52 -= cb1[0] * x1; x53 -= cb1[1] * x1; x54 -= cb1[2] * x1; x55 -= cb1[3] * x1; x56 -= cb2[0] * x1; x57 -= cb2[1] * x1; x58 -= cb2[2] * x1; x59 -= cb2[3] * x1; x60 -= cb3[0] * x1; x61 -= cb3[1] * x1; x62 -= cb3[2] * x1; x63 -= cb3[3] * x1;
            __builtin_amdgcn_sched_barrier(0);
            cb0 = *(const f32x4*)(Am + 2 * AP + 16);
            cb1 = *(const f32x4*)(Am + 2 * AP + 20);
            cb2 = *(const f32x4*)(Am + 2 * AP + 24);
            cb3 = *(const f32x4*)(Am + 2 * AP + 28);
            __builtin_amdgcn_sched_barrier(0);
            x3 -= ca0[3] * x2; x4 -= ca1[0] * x2; x5 -= ca1[1] * x2; x6 -= ca1[2] * x2; x7 -= ca1[3] * x2; x8 -= ca2[0] * x2; x9 -= ca2[1] * x2; x10 -= ca2[2] * x2; x11 -= ca2[3] * x2; x12 -= ca3[0] * x2; x13 -= ca3[1] * x2; x14 -= ca3[2] * x2; x15 -= ca3[3] * x2;
            __builtin_amdgcn_sched_barrier(0);
            ca0 = *(const f32x4*)(Am + 2 * AP + 32);
            ca1 = *(const f32x4*)(Am + 2 * AP + 36);
            ca2 = *(const f32x4*)(Am + 2 * AP + 40);
            ca3 = *(const f32x4*)(Am + 2 * AP + 44);
            __builtin_amdgcn_sched_barrier(0);
            x16 -= cb0[0] * x2; x17 -= cb0[1] * x2; x18 -= cb0[2] * x2; x19 -= cb0[3] * x2; x20 -= cb1[0] * x2; x21 -= cb1[1] * x2; x22 -= cb1[2] * x2; x23 -= cb1[3] * x2; x24 -= cb2[0] * x2; x25 -= cb2[1] * x2; x26 -= cb2[2] * x2; x27 -= cb2[3] * x2; x28 -= cb3[0] * x2; x29 -= cb3[1] * x2; x30 -= cb3[2] * x2; x31 -= cb3[3] * x2;
            __builtin_amdgcn_sched_barrier(0);
            cb0 = *(const f32x4*)(Am + 2 * AP + 48);
            cb1 = *(const f32x4*)(Am + 2 * AP + 52);
            cb2 = *(const f32x4*)(Am + 2 * AP + 56);
            cb3 = *(const f32x4*)(Am + 2 * AP + 60);
            __builtin_amdgcn_sched_barrier(0);
            x32 -= ca0[0] * x2; x33 -= ca0[1] * x2; x34 -= ca0[2] * x2; x35 -= ca0[3] * x2; x36 -= ca1[0] * x2; x37 -= ca1[1] * x2; x38 -= ca1[2] * x2; x39 -= ca1[3] * x2; x40 -= ca2[0] * x2; x41 -= ca2[1] * x2; x42 -= ca2[2] * x2; x43 -= ca2[3] * x2; x44 -= ca3[0] * x2; x45 -= ca3[1] * x2; x46 -= ca3[2] * x2; x47 -= ca3[3] * x2;
            __builtin_amdgcn_sched_barrier(0);
            ca1 = *(const f32x4*)(Am + 3 * AP + 4);
            ca2 = *(const f32x4*)(Am + 3 * AP + 8);
            ca3 = *(const f32x4*)(Am + 3 * AP + 12);
            __builtin_amdgcn_sched_barrier(0);
            x48 -= cb0[0] * x2; x49 -= cb0[1] * x2; x50 -= cb0[2] * x2; x51 -= cb0[3] * x2; x52 -= cb1[0] * x2; x53 -= cb1[1] * x2; x54 -= cb1[2] * x2; x55 -= cb1[3] * x2; x56 -= cb2[0] * x2; x57 -= cb2[1] * x2; x58 -= cb2[2] * x2; x59 -= cb2[3] * x2; x60 -= cb3[0] * x2; x61 -= cb3[1] * x2; x62 -= cb3[2] * x2; x63 -= cb3[3] * x2;
            __builtin_amdgcn_sched_barrier(0);
            cb0 = *(const f32x4*)(Am + 3 * AP + 16);
            cb1 = *(const f32x4*)(Am + 3 * AP + 20);
            cb2 = *(const f32x4*)(Am + 3 * AP + 24);
            cb3 = *(const f32x4*)(Am + 3 * AP + 28);
            __builtin_amdgcn_sched_barrier(0);
            x4 -= ca1[0] * x3; x5 -= ca1[1] * x3; x6 -= ca1[2] * x3; x7 -= ca1[3] * x3; x8 -= ca2[0] * x3; x9 -= ca2[1] * x3; x10 -= ca2[2] * x3; x11 -= ca2[3] * x3; x12 -= ca3[0] * x3; x13 -= ca3[1] * x3; x14 -= ca3[2] * x3; x15 -= ca3[3] * x3;
            __builtin_amdgcn_sched_barrier(0);
            ca0 = *(const f32x4*)(Am + 3 * AP + 32);
            ca1 = *(const f32x4*)(Am + 3 * AP + 36);
            ca2 = *(const f32x4*)(Am + 3 * AP + 40);
            ca3 = *(const f32x4*)(Am + 3 * AP + 44);
            __builtin_amdgcn_sched_barrier(0);
            x16 -= cb0[0] * x3; x17 -= cb0[1] * x3; x18 -= cb0[2] * x3; x19 -= cb0[3] * x3; x20 -= cb1[0] * x3; x21 -= cb1[1] * x3; x22 -= cb1[2] * x3; x23 -= cb1[3] * x3; x24 -= cb2[0] * x3; x25 -= cb2[1] * x3; x26 -= cb2[2] * x3; x27 -= cb2[3] * x3; x28 -= cb3[0] * x3; x29 -= cb3[1] * x3; x30 -= cb3[2] * x3; x31 -= cb3[3] * x3;
            __builtin_amdgcn_sched_barrier(0);
            cb0 = *(const f32x4*)(Am + 3 * AP + 48);
            cb1 = *(const f32x4*)(Am + 3 * AP + 52);
            cb2 = *(const f32x4*)(Am + 3 * AP + 56);
            cb3 = *(const f32x4*)(Am + 3 * AP + 60);
            __builtin_amdgcn_sched_barrier(0);
            x32 -= ca0[0] * x3; x33 -= ca0[1] * x3; x34 -= ca0[2] * x3; x35 -= ca0[3] * x3; x36 -= ca1[0] * x3; x37 -= ca1[1] * x3; x38 -= ca1[2] * x3; x39 -= ca1[3] * x3; x40 -= ca2[0] * x3; x41 -= ca2[1] * x3; x42 -= ca2[2] * x3; x43 -= ca2[3] * x3; x44 -= ca3[0] * x3; x45 -= ca3[1] * x3; x46 -= ca3[2] * x3; x47 -= ca3[3] * x3;
            __builtin_amdgcn_sched_barrier(0);
            ca1 = *(const f32x4*)(Am + 4 * AP + 4);
            ca2 = *(const f32x4*)(Am + 4 * AP + 8);
            ca3 = *(const f32x4*)(Am + 4 * AP + 12);
            __builtin_amdgcn_sched_barrier(0);
            x48 -= cb0[0] * x3; x49 -= cb0[1] * x3; x50 -= cb0[2] * x3; x51 -= cb0[3] * x3; x52 -= cb1[0] * x3; x53 -= cb1[1] * x3; x54 -= cb1[2] * x3; x55 -= cb1[3] * x3; x56 -= cb2[0] * x3; x57 -= cb2[1] * x3; x58 -= cb2[2] * x3; x59 -= cb2[3] * x3; x60 -= cb3[0] * x3; x61 -= cb3[1] * x3; x62 -= cb3[2] * x3; x63 -= cb3[3] * x3;
            __builtin_amdgcn_sched_barrier(0);
            cb0 = *(const f32x4*)(Am + 4 * AP + 16);
            cb1 = *(const f32x4*)(Am + 4 * AP + 20);
            cb2 = *(const f32x4*)(Am + 4 * AP + 24);
            cb3 = *(const f32x4*)(Am + 4 * AP + 28);
            __builtin_amdgcn_sched_barrier(0);
            x5 -= ca1[1] * x4; x6 -= ca1[2] * x4; x7 -= ca1[3] * x4; x8 -= ca2[0] * x4; x9 -= ca2[1] * x4; x10 -= ca2[2] * x4; x11 -= ca2[3] * x4; x12 -= ca3[0] * x4; x13 -= ca3[1] * x4; x14 -= ca3[2] * x4; x15 -= ca3[3] * x4;
            __builtin_amdgcn_sched_barrier(0);
            ca0 = *(const f32x4*)(Am + 4 * AP + 32);
            ca1 = *(const f32x4*)(Am + 4 * AP + 36);
            ca2 = *(const f32x4*)(Am + 4 * AP + 40);
            ca3 = *(const f32x4*)(Am + 4 * AP + 44);
            __builtin_amdgcn_sched_barrier(0);
            x16 -= cb0[0] * x4; x17 -= cb0[1] * x4; x18 -= cb0[2] * x4; x19 -= cb0[3] * x4; x20 -= cb1[0] * x4; x21 -= cb1[1] * x4; x22 -= cb1[2] * x4; x23 -= cb1[3] * x4; x24 -= cb2[0] * x4; x25 -= cb2[1] * x4; x26 -= cb2[2] * x4; x27 -= cb2[3] * x4; x28 -= cb3[0] * x4; x29 -= cb3[1] * x4; x30 -= cb3[2] * x4; x31 -= cb3[3] * x4;
            __builtin_amdgcn_sched_barrier(0);
            cb0 = *(const f32x4*)(Am + 4 * AP + 48);
            cb1 = *(const f32x4*)(Am + 4 * AP + 52);
            cb2 = *(const f32x4*)(Am + 4 * AP + 56);
            cb3 = *(const f32x4*)(Am + 4 * AP + 60);
            __builtin_amdgcn_sched_barrier(0);
            x32 -= ca0[0] * x4; x33 -= ca0[1] * x4; x34 -= ca0[2] * x4; x35 -= ca0[3] * x4; x36 -= ca1[0] * x4; x37 -= ca1[1] * x4; x38 -= ca1[2] * x4; x39 -= ca1[3] * x4; x40 -= ca2[0] * x4; x41 -= ca2[1] * x4; x42 -= ca2[2] * x4; x43 -= ca2[3] * x4; x44 -= ca3[0] * x4; x45 -= ca3[1] * x4; x46 -= ca3[2] * x4; x47 -= ca3[3] * x4;
            __builtin_amdgcn_sched_barrier(0);
            ca1 = *(const f32x4*)(Am + 5 * AP + 4);
            ca2 = *(const f32x4*)(Am + 5 * AP + 8);
            ca3 = *(const f32x4*)(Am + 5 * AP + 12);
            __builtin_amdgcn_sched_barrier(0);
            x48 -= cb0[0] * x4; x49 -= cb0[1] * x4; x50 -= cb0[2] * x4; x51 -= cb0[3] * x4; x52 -= cb1[0] * x4; x53 -= cb1[1] * x4; x54 -= cb1[2] * x4; x55 -= cb1[3] * x4; x56 -= cb2[0] * x4; x57 -= cb2[1] * x4; x58 -= cb2[2] * x4; x59 -= cb2[3] * x4; x60 -= cb3[0] * x4; x61 -= cb3[1] * x4; x62 -= cb3[2] * x4; x63 -= cb3[3] * x4;
            __builtin_amdgcn_sched_barrier(0);
            cb0 = *(const f32x4*)(Am + 5 * AP + 16);
            cb1 = *(const f32x4*)(Am + 5 * AP + 20);
            cb2 = *(const f32x4*)(Am + 5 * AP + 24);
            cb3 = *(const f32x4*)(Am + 5 * AP + 28);
            __builtin_amdgcn_sched_barrier(0);
            x6 -= ca1[2] * x5; x7 -= ca1[3] * x5; x8 -= ca2[0] * x5; x9 -= ca2[1] * x5; x10 -= ca2[2] * x5; x11 -= ca2[3] * x5; x12 -= ca3[0] * x5; x13 -= ca3[1] * x5; x14 -= ca3[2] * x5; x15 -= ca3[3] * x5;
            __builtin_amdgcn_sched_barrier(0);
            ca0 = *(const f32x4*)(Am + 5 * AP + 32);
            ca1 = *(const f32x4*)(Am + 5 * AP + 36);
            ca2 = *(const f32x4*)(Am + 5 * AP + 40);
            ca3 = *(const f32x4*)(Am + 5 * AP + 44);
            __builtin_amdgcn_sched_barrier(0);
            x16 -= cb0[0] * x5; x17 -= cb0[1] * x5; x18 -= cb0[2] * x5; x19 -= cb0[3] * x5; x20 -= cb1[0] * x5; x21 -= cb1[1] * x5; x22 -= cb1[2] * x5; x23 -= cb1[3] * x5; x24 -= cb2[0] * x5; x25 -= cb2[1] * x5; x26 -= cb2[2] * x5; x27 -= cb2[3] * x5; x28 -= cb3[0] * x5; x29 -= cb3[1] * x5; x30 -= cb3[2] * x5; x31 -= cb3[3] * x5;
            __builtin_amdgcn_sched_barrier(0);
            cb0 = *(const f32x4*)(Am + 5 * AP + 48);
            cb1 = *(const f32x4*)(Am + 5 * AP + 52);
            cb2 = *(const f32x4*)(Am + 5 * AP + 56);
            cb3 = *(const f32x4*)(Am + 5 * AP + 60);
            __builtin_amdgcn_sched_barrier(0);
            x32 -= ca0[0] * x5; x33 -= ca0[1] * x5; x34 -= ca0[2] * x5; x35 -= ca0[3] * x5; x36 -= ca1[0] * x5; x37 -= ca1[1] * x5; x38 -= ca1[2] * x5; x39 -= ca1[3] * x5; x40 -= ca2[0] * x5; x41 -= ca2[1] * x5; x42 -= ca2[2] * x5; x43 -= ca2[3] * x5; x44 -= ca3[0] * x5; x45 -= ca3[1] * x5; x46 -= ca3[2] * x5; x47 -= ca3[3] * x5;
            __builtin_amdgcn_sched_barrier(0);
            ca1 = *(const f32x4*)(Am + 6 * AP + 4);
            ca2 = *(const f32x4*)(Am + 6 * AP + 8);
            ca3 = *(const f32x4*)(Am + 6 * AP + 12);
            __builtin_amdgcn_sched_barrier(0);
            x48 -= cb0[0] * x5; x49 -= cb0[1] * x5; x50 -= cb0[2] * x5; x51 -= cb0[3] * x5; x52 -= cb1[0] * x5; x53 -= cb1[1] * x5; x54 -= cb1[2] * x5; x55 -= cb1[3] * x5; x56 -= cb2[0] * x5; x57 -= cb2[1] * x5; x58 -= cb2[2] * x5; x59 -= cb2[3] * x5; x60 -= cb3[0] * x5; x61 -= cb3[1] * x5; x62 -= cb3[2] * x5; x63 -= cb3[3] * x5;
            __builtin_amdgcn_sched_barrier(0);
            cb0 = *(const f32x4*)(Am + 6 * AP + 16);
            cb1 = *(const f32x4*)(Am + 6 * AP + 20);
            cb2 = *(const f32x4*)(Am + 6 * AP + 24);
            cb3 = *(const f32x4*)(Am + 6 * AP + 28);
            __builtin_amdgcn_sched_barrier(0);
            x7 -= ca1[3] * x6; x8 -= ca2[0] * x6; x9 -= ca2[1] * x6; x10 -= ca2[2] * x6; x11 -= ca2[3] * x6; x12 -= ca3[0] * x6; x13 -= ca3[1] * x6; x14 -= ca3[2] * x6; x15 -= ca3[3] * x6;
            __builtin_amdgcn_sched_barrier(0);
            ca0 = *(const f32x4*)(Am + 6 * AP + 32);
            ca1 = *(const f32x4*)(Am + 6 * AP + 36);
            ca2 = *(const f32x4*)(Am + 6 * AP + 40);
            ca3 = *(const f32x4*)(Am + 6 * AP + 44);
            __builtin_amdgcn_sched_barrier(0);
            x16 -= cb0[0] * x6; x17 -= cb0[1] * x6; x18 -= cb0[2] * x6; x19 -= cb0[3] * x6; x20 -= cb1[0] * x6; x21 -= cb1[1] * x6; x22 -= cb1[2] * x6; x23 -= cb1[3] * x6; x24 -= cb2[0] * x6; x25 -= cb2[1] * x6; x26 -= cb2[2] * x6; x27 -= cb2[3] * x6; x28 -= cb3[0] * x6; x29 -= cb3[1] * x6; x30 -= cb3[2] * x6; x31 -= cb3[3] * x6;
            __builtin_amdgcn_sched_barrier(0);
            cb0 = *(const f32x4*)(Am + 6 * AP + 48);
            cb1 = *(const f32x4*)(Am + 6 * AP + 52);
            cb2 = *(const f32x4*)(Am + 6 * AP + 56);
            cb3 = *(const f32x4*)(Am + 6 * AP + 60);
            __builtin_amdgcn_sched_barrier(0);
            x32 -= ca0[0] * x6; x33 -= ca0[1] * x6; x34 -= ca0[2] * x6; x35 -= ca0[3] * x6; x36 -= ca1[0] * x6; x37 -= ca1[1] * x6; x38 -= ca1[2] * x6; x39 -= ca1[3] * x6; x40 -= ca2[0] * x6; x41 -= ca2[1] * x6; x42 -= ca2[2] * x6; x43 -= ca2[3] * x6; x44 -= ca3[0] * x6; x45 -= ca3[1] * x6; x46 -= ca3[2] * x6; x47 -= ca3[3] * x6;
            __builtin_amdgcn_sched_barrier(0);
            ca2 = *(const f32x4*)(Am + 7 * AP + 8);
            ca3 = *(const f32x4*)(Am + 7 * AP + 12);
            __builtin_amdgcn_sched_barrier(0);
            x48 -= cb0[0] * x6; x49 -= cb0[1] * x6; x50 -= cb0[2] * x6; x51 -= cb0[3] * x6; x52 -= cb1[0] * x6; x53 -= cb1[1] * x6; x54 -= cb1[2] * x6; x55 -= cb1[3] * x6; x56 -= cb2[0] * x6; x57 -= cb2[1] * x6; x58 -= cb2[2] * x6; x59 -= cb2[3] * x6; x60 -= cb3[0] * x6; x61 -= cb3[1] * x6; x62 -= cb3[2] * x6; x63 -= cb3[3] * x6;
            __builtin_amdgcn_sched_barrier(0);
            cb0 = *(const f32x4*)(Am + 7 * AP + 16);
            cb1 = *(const f32x4*)(Am + 7 * AP + 20);
            cb2 = *(const f32x4*)(Am + 7 * AP + 24);
            cb3 = *(const f32x4*)(Am + 7 * AP + 28);
            __builtin_amdgcn_sched_barrier(0);
            x8 -= ca2[0] * x7; x9 -= ca2[1] * x7; x10 -= ca2[2] * x7; x11 -= ca2[3] * x7; x12 -= ca3[0] * x7; x13 -= ca3[1] * x7; x14 -= ca3[2] * x7; x15 -= ca3[3] * x7;
            __builtin_amdgcn_sched_barrier(0);
            ca0 = *(const f32x4*)(Am + 7 * AP + 32);
            ca1 = *(const f32x4*)(Am + 7 * AP + 36);
            ca2 = *(const f32x4*)(Am + 7 * AP + 40);
            ca3 = *(const f32x4*)(Am + 7 * AP + 44);
            __builtin_amdgcn_sched_barrier(0);
            x16 -= cb0[0] * x7; x17 -= cb0[1] * x7; x18 -= cb0[2] * x7; x19 -= cb0[3] * x7; x20 -= cb1[0] * x7; x21 -= cb1[1] * x7; x22 -= cb1[2] * x7; x23 -= cb1[3] * x7; x24 -= cb2[0] * x7; x25 -= cb2[1] * x7; x26 -= cb2[2] * x7; x27 -= cb2[3] * x7; x28 -= cb3[0] * x7; x29 -= cb3[1] * x7; x30 -= cb3[2] * x7; x31 -= cb3[3] * x7;
            __builtin_amdgcn_sched_barrier(0);
            cb0 = *(const f32x4*)(Am + 7 * AP + 48);
            cb1 = *(const f32x4*)(Am + 7 * AP + 52);
            cb2 = *(const f32x4*)(Am + 7 * AP + 56);
            cb3 = *(const f32x4*)(Am + 7 * AP + 60);
            __builtin_amdgcn_sched_barrier(0);
            x32 -= ca0[0] * x7; x33 -= ca0[1] * x7; x34 -= ca0[2] * x7; x35 -= ca0[3] * x7; x36 -= ca1[0] * x7; x37 -= ca1[1] * x7; x38 -= ca1[2] * x7; x39 -= ca1[3] * x7; x40 -= ca2[0] * x7; x41 -= ca2[1] * x7; x42 -= ca2[2] * x7; x43 -= ca2[3] * x7; x44 -= ca3[0] * x7; x45 -= ca3[1] * x7; x46 -= ca3[2] * x7; x47 -= ca3[3] * x7;
            __builtin_amdgcn_sched_barrier(0);
            ca2 = *(const f32x4*)(Am + 8 * AP + 8);
            ca3 = *(const f32x4*)(Am + 8 * AP + 12);
            __builtin_amdgcn_sched_barrier(0);
            x48 -= cb0[0] * x7; x49 -= cb0[1] * x7; x50 -= cb0[2] * x7; x51 -= cb0[3] * x7; x52 -= cb1[0] * x7; x53 -= cb1[1] * x7; x54 -= cb1[2] * x7; x55 -= cb1[3] * x7; x56 -= cb2[0] * x7; x57 -= cb2[1] * x7; x58 -= cb2[2] * x7; x59 -= cb2[3] * x7; x60 -= cb3[0] * x7; x61 -= cb3[1] * x7; x62 -= cb3[2] * x7; x63 -= cb3[3] * x7;
            __builtin_amdgcn_sched_barrier(0);
            cb0 = *(const f32x4*)(Am + 8 * AP + 16);
            cb1 = *(const f32x4*)(Am + 8 * AP + 20);
            cb2 = *(const f32x4*)(Am + 8 * AP + 24);
            cb3 = *(const f32x4*)(Am + 8 * AP + 28);
            __builtin_amdgcn_sched_barrier(0);
            x9 -= ca2[1] * x8; x10 -= ca2[2] * x8; x11 -= ca2[3] * x8; x12 -= ca3[0] * x8; x13 -= ca3[1] * x8; x14 -= ca3[2] * x8; x15 -= ca3[3] * x8;
            __builtin_amdgcn_sched_barrier(0);
            ca0 = *(const f32x4*)(Am + 8 * AP + 32);
            ca1 = *(const f32x4*)(Am + 8 * AP + 36);
            ca2 = *(const f32x4*)(Am + 8 * AP + 40);
            ca3 = *(const f32x4*)(Am + 8 * AP + 44);
            __builtin_amdgcn_sched_barrier(0);
            x16 -= cb0[0] * x8; x17 -= cb0[1] * x8; x18 -= cb0[2] * x8; x19 -= cb0[3] * x8; x20 -= cb1[0] * x8; x21 -= cb1[1] * x8; x22 -= cb1[2] * x8; x23 -= cb1[3] * x8; x24 -= cb2[0] * x8; x25 -= cb2[1] * x8; x26 -= cb2[2] * x8; x27 -= cb2[3] * x8; x28 -= cb3[0] * x8; x29 -= cb3[1] * x8; x30 -= cb3[2] * x8; x31 -= cb3[3] * x8;
            __builtin_amdgcn_sched_barrier(0);
            cb0 = *(const f32x4*)(Am + 8 * AP + 48);
            cb1 = *(const f32x4*)(Am + 8 * AP + 52);
            cb2 = *(const f32x4*)(Am + 8 * AP + 56);
            cb3 = *(const f32x4*)(Am + 8 * AP + 60);
            __builtin_amdgcn_sched_barrier(0);
            x32 -= ca0[0] * x8; x33 -= ca0[1] * x8; x34 -= ca0[2] * x8; x35 -= ca0[3] * x8; x36 -= ca1[0] * x8; x37 -= ca1[1] * x8; x38 -= ca1[2] * x8; x39 -= ca1[3] * x8; x40 -= ca2[0] * x8; x41 -= ca2[1] * x8; x42 -= ca2[2] * x8; x43 -= ca2[3] * x8; x44 -= ca3[0] * x8; x45 -= ca3[1] * x8; x46 -= ca3[2] * x8; x47 -= ca3[3] * x8;
            __builtin_amdgcn_sched_barrier(0);
            ca2 = *(const f32x4*)(Am + 9 * AP + 8);
            ca3 = *(const f32x4*)(Am + 9 * AP + 12);
            __builtin_amdgcn_sched_barrier(0);
            x48 -= cb0[0] * x8; x49 -= cb0[1] * x8; x50 -= cb0[2] * x8; x51 -= cb0[3] * x8; x52 -= cb1[0] * x8; x53 -= cb1[1] * x8; x54 -= cb1[2] * x8; x55 -= cb1[3] * x8; x56 -= cb2[0] * x8; x57 -= cb2[1] * x8; x58 -= cb2[2] * x8; x59 -= cb2[3] * x8; x60 -= cb3[0] * x8; x61 -= cb3[1] * x8; x62 -= cb3[2] * x8; x63 -= cb3[3] * x8;
            __builtin_amdgcn_sched_barrier(0);
            cb0 = *(const f32x4*)(Am + 9 * AP + 16);
            cb1 = *(const f32x4*)(Am + 9 * AP + 20);
            cb2 = *(const f32x4*)(Am + 9 * AP + 24);
            cb3 = *(const f32x4*)(Am + 9 * AP + 28);
            __builtin_amdgcn_sched_barrier(0);
            x10 -= ca2[2] * x9; x11 -= ca2[3] * x9; x12 -= ca3[0] * x9; x13 -= ca3[1] * x9; x14 -= ca3[2] * x9; x15 -= ca3[3] * x9;
            __builtin_amdgcn_sched_barrier(0);
            ca0 = *(const f32x4*)(Am + 9 * AP + 32);
            ca1 = *(const f32x4*)(Am + 9 * AP + 36);
            ca2 = *(const f32x4*)(Am + 9 * AP + 40);
            ca3 = *(const f32x4*)(Am + 9 * AP + 44);
            __builtin_amdgcn_sched_barrier(0);
            x16 -= cb0[0] * x9; x17 -= cb0[1] * x9; x18 -= cb0[2] * x9; x19 -= cb0[3] * x9; x20 -= cb1[0] * x9; x21 -= cb1[1] * x9; x22 -= cb1[2] * x9; x23 -= cb1[3] * x9; x24 -= cb2[0] * x9; x25 -= cb2[1] * x9; x26 -= cb2[2] * x9; x27 -= cb2[3] * x9; x28 -= cb3[0] * x9; x29 -= cb3[1] * x9; x30 -= cb3[2] * x9; x31 -= cb3[3] * x9;
            __builtin_amdgcn_sched_barrier(0);
            cb0 = *(const f32x4*)(Am + 9 * AP + 48);
            cb1 = *(const f32x4*)(Am + 9 * AP + 52);
            cb2 = *(const f32x4*)(Am + 9 * AP + 56);
            cb3 = *(const f32x4*)(Am + 9 * AP + 60);
            __builtin_amdgcn_sched_barrier(0);
            x32 -= ca0[0] * x9; x33 -= ca0[1] * x9; x34 -= ca0[2] * x9; x35 -= ca0[3] * x9; x36 -= ca1[0] * x9; x37 -= ca1[1] * x9; x38 -= ca1[2] * x9; x39 -= ca1[3] * x9; x40 -= ca2[0] * x9; x41 -= ca2[1] * x9; x42 -= ca2[2] * x9; x43 -= ca2[3] * x9; x44 -= ca3[0] * x9; x45 -= ca3[1] * x9; x46 -= ca3[2] * x9; x47 -= ca3[3] * x9;
            __builtin_amdgcn_sched_barrier(0);
            ca2 = *(const f32x4*)(Am + 10 * AP + 8);
            ca3 = *(const f32x4*)(Am + 10 * AP + 12);
            __builtin_amdgcn_sched_barrier(0);
            x48 -= cb0[0] * x9; x49 -= cb0[1] * x9; x50 -= cb0[2] * x9; x51 -= cb0[3] * x9; x52 -= cb1[0] * x9; x53 -= cb1[1] * x9; x54 -= cb1[2] * x9; x55 -= cb1[3] * x9; x56 -= cb2[0] * x9; x57 -= cb2[1] * x9; x58 -= cb2[2] * x9; x59 -= cb2[3] * x9; x60 -= cb3[0] * x9; x61 -= cb3[1] * x9; x62 -= cb3[2] * x9; x63 -= cb3[3] * x9;
            __builtin_amdgcn_sched_barrier(0);
            cb0 = *(const f32x4*)(Am + 10 * AP + 16);
            cb1 = *(const f32x4*)(Am + 10 * AP + 20);
            cb2 = *(const f32x4*)(Am + 10 * AP + 24);
            cb3 = *(const f32x4*)(Am + 10 * AP + 28);
            __builtin_amdgcn_sched_barrier(0);
            x11 -= ca2[3] * x10; x12 -= ca3[0] * x10; x13 -= ca3[1] * x10; x14 -= ca3[2] * x10; x15 -= ca3[3] * x10;
            __builtin_amdgcn_sched_barrier(0);
            ca0 = *(const f32x4*)(Am + 10 * AP + 32);
            ca1 = *(const f32x4*)(Am + 10 * AP + 36);
            ca2 = *(const f32x4*)(Am + 10 * AP + 40);
            ca3 = *(const f32x4*)(Am + 10 * AP + 44);
            __builtin_amdgcn_sched_barrier(0);
            x16 -= cb0[0] * x10; x17 -= cb0[1] * x10; x18 -= cb0[2] * x10; x19 -= cb0[3] * x10; x20 -= cb1[0] * x10; x21 -= cb1[1] * x10; x22 -= cb1[2] * x10; x23 -= cb1[3] * x10; x24 -= cb2[0] * x10; x25 -= cb2[1] * x10; x26 -= cb2[2] * x10; x27 -= cb2[3] * x10; x28 -= cb3[0] * x10; x29 -= cb3[1] * x10; x30 -= cb3[2] * x10; x31 -= cb3[3] * x10;
            __builtin_amdgcn_sched_barrier(0);
            cb0 = *(const f32x4*)(Am + 10 * AP + 48);
            cb1 = *(const f32x4*)(Am + 10 * AP + 52);
            cb2 = *(const f32x4*)(Am + 10 * AP + 56);
            cb3 = *(const f32x4*)(Am + 10 * AP + 60);
            __builtin_amdgcn_sched_barrier(0);
            x32 -= ca0[0] * x10; x33 -= ca0[1] * x10; x34 -= ca0[2] * x10; x35 -= ca0[3] * x10; x36 -= ca1[0] * x10; x37 -= ca1[1] * x10; x38 -= ca1[2] * x10; x39 -= ca1[3] * x10; x40 -= ca2[0] * x10; x41 -= ca2[1] * x10; x42 -= ca2[2] * x10; x43 -= ca2[3] * x10; x44 -= ca3[0] * x10; x45 -= ca3[1] * x10; x46 -= ca3[2] * x10; x47 -= ca3[3] * x10;
            __builtin_amdgcn_sched_barrier(0);
            ca3 = *(const f32x4*)(Am + 11 * AP + 12);
            __builtin_amdgcn_sched_barrier(0);
            x48 -= cb0[0] * x10; x49 -= cb0[1] * x10; x50 -= cb0[2] * x10; x51 -= cb0[3] * x10; x52 -= cb1[0] * x10; x53 -= cb1[1] * x10; x54 -= cb1[2] * x10; x55 -= cb1[3] * x10; x56 -= cb2[0] * x10; x57 -= cb2[1] * x10; x58 -= cb2[2] * x10; x59 -= cb2[3] * x10; x60 -= cb3[0] * x10; x61 -= cb3[1] * x10; x62 -= cb3[2] * x10; x63 -= cb3[3] * x10;
            __builtin_amdgcn_sched_barrier(0);
            cb0 = *(const f32x4*)(Am + 11 * AP + 16);
            cb1 = *(const f32x4*)(Am + 11 * AP + 20);
            cb2 = *(const f32x4*)(Am + 11 * AP + 24);
            cb3 = *(const f32x4*)(Am + 11 * AP + 28);
            __builtin_amdgcn_sched_barrier(0);
            x12 -= ca3[0] * x11; x13 -= ca3[1] * x11; x14 -= ca3[2] * x11; x15 -= ca3[3] * x11;
            __builtin_amdgcn_sched_barrier(0);
            ca0 = *(const f32x4*)(Am + 11 * AP + 32);
            ca1 = *(const f32x4*)(Am + 11 * AP + 36);
            ca2 = *(const f32x4*)(Am + 11 * AP + 40);
            ca3 = *(const f32x4*)(Am + 11 * AP + 44);
            __builtin_amdgcn_sched_barrier(0);
            x16 -= cb0[0] * x11; x17 -= cb0[1] * x11; x18 -= cb0[2] * x11; x19 -= cb0[3] * x11; x20 -= cb1[0] * x11; x21 -= cb1[1] * x11; x22 -= cb1[2] * x11; x23 -= cb1[3] * x11; x24 -= cb2[0] * x11; x25 -= cb2[1] * x11; x26 -= cb2[2] * x11; x27 -= cb2[3] * x11; x28 -= cb3[0] * x11; x29 -= cb3[1] * x11; x30 -= cb3[2] * x11; x31 -= cb3[3] * x11;
            __builtin_amdgcn_sched_barrier(0);
            cb0 = *(const f32x4*)(Am + 11 * AP + 48);
            cb1 = *(const f32x4*)(Am + 11 * AP + 52);
            cb2 = *(const f32x4*)(Am + 11 * AP + 56);
            cb3 = *(const f32x4*)(Am + 11 * AP + 60);
            __builtin_amdgcn_sched_barrier(0);
            x32 -= ca0[0] * x11; x33 -= ca0[1] * x11; x34 -= ca0[2] * x11; x35 -= ca0[3] * x11; x36 -= ca1[0] * x11; x37 -= ca1[1] * x11; x38 -= ca1[2] * x11; x39 -= ca1[3] * x11; x40 -= ca2[0] * x11; x41 -= ca2[1] * x11; x42 -= ca2[2] * x11; x43 -= ca2[3] * x11; x44 -= ca3[0] * x11; x45 -= ca3[1] * x11; x46 -= ca3[2] * x11; x47 -= ca3[3] * x11;
            __builtin_amdgcn_sched_barrier(0);
            ca3 = *(const f32x4*)(Am + 12 * AP + 12);
            __builtin_amdgcn_sched_barrier(0);
            x48 -= cb0[0] * x11; x49 -= cb0[1] * x11; x50 -= cb0[2] * x11; x51 -= cb0[3] * x11; x52 -= cb1[0] * x11; x53 -= cb1[1] * x11; x54 -= cb1[2] * x11; x55 -= cb1[3] * x11; x56 -= cb2[0] * x11; x57 -= cb2[1] * x11; x58 -= cb2[2] * x11; x59 -= cb2[3] * x11; x60 -= cb3[0] * x11; x61 -= cb3[1] * x11; x62 -= cb3[2] * x11; x63 -= cb3[3] * x11;
            __builtin_amdgcn_sched_barrier(0);
            cb0 = *(const f32x4*)(Am + 12 * AP + 16);
            cb1 = *(const f32x4*)(Am + 12 * AP + 20);
            cb2 = *(const f32x4*)(Am + 12 * AP + 24);
            cb3 = *(const f32x4*)(Am + 12 * AP + 28);
            __builtin_amdgcn_sched_barrier(0);
            x13 -= ca3[1] * x12; x14 -= ca3[2] * x12; x15 -= ca3[3] * x12;
            __builtin_amdgcn_sched_barrier(0);
            ca0 = *(const f32x4*)(Am + 12 * AP + 32);
            ca1 = *(const f32x4*)(Am + 12 * AP + 36);
            ca2 = *(const f32x4*)(Am + 12 * AP + 40);
            ca3 = *(const f32x4*)(Am + 12 * AP + 44);
            __builtin_amdgcn_sched_barrier(0);
            x16 -= cb0[0] * x12; x17 -= cb0[1] * x12; x18 -= cb0[2] * x12; x19 -= cb0[3] * x12; x20 -= cb1[0] * x12; x21 -= cb1[1] * x12; x22 -= cb1[2] * x12; x23 -= cb1[3] * x12; x24 -= cb2[0] * x12; x25 -= cb2[1] * x12; x26 -= cb2[2] * x12; x27 -= cb2[3] * x12; x28 -= cb3[0] * x12; x29 -= cb3[1] * x12; x30 -= cb3[2] * x12; x31 -= cb3[3] * x12;
            __builtin_amdgcn_sched_barrier(0);
            cb0 = *(const f32x4*)(Am + 12 * AP + 48);
            cb1 = *(const f32x4*)(Am + 12 * AP + 52);
            cb2 = *(const f32x4*)(Am + 12 * AP + 56);
            cb3 = *(const f32x4*)(Am + 12 * AP + 60);
            __builtin_amdgcn_sched_barrier(0);
            x32 -= ca0[0] * x12; x33 -= ca0[1] * x12; x34 -= ca0[2] * x12; x35 -= ca0[3] * x12; x36 -= ca1[0] * x12; x37 -= ca1[1] * x12; x38 -= ca1[2] * x12; x39 -= ca1[3] * x12; x40 -= ca2[0] * x12; x41 -= ca2[1] * x12; x42 -= ca2[2] * x12; x43 -= ca2[3] * x12; x44 -= ca3[0] * x12; x45 -= ca3[1] * x12; x46 -= ca3[2] * x12; x47 -= ca3[3] * x12;
            __builtin_amdgcn_sched_barrier(0);
            ca3 = *(const f32x4*)(Am + 13 * AP + 12);
            __builtin_amdgcn_sched_barrier(0);
            x48 -= cb0[0] * x12; x49 -= cb0[1] * x12; x50 -= cb0[2] * x12; x51 -= cb0[3] * x12; x52 -= cb1[0] * x12; x53 -= cb1[1] * x12; x54 -= cb1[2] * x12; x55 -= cb1[3] * x12; x56 -= cb2[0] * x12; x57 -= cb2[1] * x12; x58 -= cb2[2] * x12; x59 -= cb2[3] * x12; x60 -= cb3[0] * x12; x61 -= cb3[1] * x12; x62 -= cb3[2] * x12; x63 -= cb3[3] * x12;
            __builtin_amdgcn_sched_barrier(0);
            cb0 = *(const f32x4*)(Am + 13 * AP + 16);
            cb1 = *(const f32x4*)(Am + 13 * AP + 20);
            cb2 = *(const f32x4*)(Am + 13 * AP + 24);
            cb3 = *(const f32x4*)(Am + 13 * AP + 28);
            __builtin_amdgcn_sched_barrier(0);
            x14 -= ca3[2] * x13; x15 -= ca3[3] * x13;
            __builtin_amdgcn_sched_barrier(0);
            ca0 = *(const f32x4*)(Am + 13 * AP + 32);
            ca1 = *(const f32x4*)(Am + 13 * AP + 36);
            ca2 = *(const f32x4*)(Am + 13 * AP + 40);
            ca3 = *(const f32x4*)(Am + 13 * AP + 44);
            __builtin_amdgcn_sched_barrier(0);
            x16 -= cb0[0] * x13; x17 -= cb0[1] * x13; x18 -= cb0[2] * x13; x19 -= cb0[3] * x13; x20 -= cb1[0] * x13; x21 -= cb1[1] * x13; x22 -= cb1[2] * x13; x23 -= cb1[3] * x13; x24 -= cb2[0] * x13; x25 -= cb2[1] * x13; x26 -= cb2[2] * x13; x27 -= cb2[3] * x13; x28 -= cb3[0] * x13; x29 -= cb3[1] * x13; x30 -= cb3[2] * x13; x31 -= cb3[3] * x13;
            __builtin_amdgcn_sched_barrier(0);
            cb0 = *(const f32x4*)(Am + 13 * AP + 48);
            cb1 = *(const f32x4*)(Am + 13 * AP + 52);
            cb2 = *(const f32x4*)(Am + 13 * AP + 56);
            cb3 = *(const f32x4*)(Am + 13 * AP + 60);
            __builtin_amdgcn_sched_barrier(0);
            x32 -= ca0[0] * x13; x33 -= ca0[1] * x13; x34 -= ca0[2] * x13; x35 -= ca0[3] * x13; x36 -= ca1[0] * x13; x37 -= ca1[1] * x13; x38 -= ca1[2] * x13; x39 -= ca1[3] * x13; x40 -= ca2[0] * x13; x41 -= ca2[1] * x13; x42 -= ca2[2] * x13; x43 -= ca2[3] * x13; x44 -= ca3[0] * x13; x45 -= ca3[1] * x13; x46 -= ca3[2] * x13; x47 -= ca3[3] * x13;
            __builtin_amdgcn_sched_barrier(0);
            ca3 = *(const f32x4*)(Am + 14 * AP + 12);
            __builtin_amdgcn_sched_barrier(0);
            x48 -= cb0[0] * x13; x49 -= cb0[1] * x13; x50 -= cb0[2] * x13; x51 -= cb0[3] * x13; x52 -= cb1[0] * x13; x53 -= cb1[1] * x13; x54 -= cb1[2] * x13; x55 -= cb1[3] * x13; x56 -= cb2[0] * x13; x57 -= cb2[1] * x13; x58 -= cb2[2] * x13; x59 -= cb2[3] * x13; x60 -= cb3[0] * x13; x61 -= cb3[1] * x13; x62 -= cb3[2] * x13; x63 -= cb3[3] * x13;
            __builtin_amdgcn_sched_barrier(0);
            cb0 = *(const f32x4*)(Am + 14 * AP + 16);
            cb1 = *(const f32x4*)(Am + 14 * AP + 20);
            cb2 = *(const f32x4*)(Am + 14 * AP + 24);
            cb3 = *(const f32x4*)(Am + 14 * AP + 28);
            __builtin_amdgcn_sched_barrier(0);
            x15 -= ca3[3] * x14;
            __builtin_amdgcn_sched_barrier(0);
            ca0 = *(const f32x4*)(Am + 14 * AP + 32);
            ca1 = *(const f32x4*)(Am + 14 * AP + 36);
            ca2 = *(const f32x4*)(Am + 14 * AP + 40);
            ca3 = *(const f32x4*)(Am + 14 * AP + 44);
            __builtin_amdgcn_sched_barrier(0);
            x16 -= cb0[0] * x14; x17 -= cb0[1] * x14; x18 -= cb0[2] * x14; x19 -= cb0[3] * x14; x20 -= cb1[0] * x14; x21 -= cb1[1] * x14; x22 -= cb1[2] * x14; x23 -= cb1[3] * x14; x24 -= cb2[0] * x14; x25 -= cb2[1] * x14; x26 -= cb2[2] * x14; x27 -= cb2[3] * x14; x28 -= cb3[0] * x14; x29 -= cb3[1] * x14; x30 -= cb3[2] * x14; x31 -= cb3[3] * x14;
            __builtin_amdgcn_sched_barrier(0);
            cb0 = *(const f32x4*)(Am + 14 * AP + 48);
            cb1 = *(const f32x4*)(Am + 14 * AP + 52);
            cb2 = *(const f32x4*)(Am + 14 * AP + 56);
            cb3 = *(const f32x4*)(Am + 14 * AP + 60);
            __builtin_amdgcn_sched_barrier(0);
            x32 -= ca0[0] * x14; x33 -= ca0[1] * x14; x34 -= ca0[2] * x14; x35 -= ca0[3] * x14; x36 -= ca1[0] * x14; x37 -= ca1[1] * x14; x38 -= ca1[2] * x14; x39 -= ca1[3] * x14; x40 -= ca2[0] * x14; x41 -= ca2[1] * x14; x42 -= ca2[2] * x14; x43 -= ca2[3] * x14; x44 -= ca3[0] * x14; x45 -= ca3[1] * x14; x46 -= ca3[2] * x14; x47 -= ca3[3] * x14;
            __builtin_amdgcn_sched_barrier(0);
            ca0 = *(const f32x4*)(Am + 15 * AP + 16);
            ca1 = *(const f32x4*)(Am + 15 * AP + 20);
            ca2 = *(const f32x4*)(Am + 15 * AP + 24);
            ca3 = *(const f32x4*)(Am + 15 * AP + 28);
            __builtin_amdgcn_sched_barrier(0);
            x48 -= cb0[0] * x14; x49 -= cb0[1] * x14; x50 -= cb0[2] * x14; x51 -= cb0[3] * x14; x52 -= cb1[0] * x14; x53 -= cb1[1] * x14; x54 -= cb1[2] * x14; x55 -= cb1[3] * x14; x56 -= cb2[0] * x14; x57 -= cb2[1] * x14; x58 -= cb2[2] * x14; x59 -= cb2[3] * x14; x60 -= cb3[0] * x14; x61 -= cb3[1] * x14; x62 -= cb3[2] * x14; x63 -= cb3[3] * x14;
            __builtin_amdgcn_sched_barrier(0);
            cb0 = *(const f32x4*)(Am + 15 * AP + 32);
            cb1 = *(const f32x4*)(Am + 15 * AP + 36);
            cb2 = *(const f32x4*)(Am + 15 * AP + 40);
            cb3 = *(const f32x4*)(Am + 15 * AP + 44);
            __builtin_amdgcn_sched_barrier(0);
            x16 -= ca0[0] * x15; x17 -= ca0[1] * x15; x18 -= ca0[2] * x15; x19 -= ca0[3] * x15; x20 -= ca1[0] * x15; x21 -= ca1[1] * x15; x22 -= ca1[2] * x15; x23 -= ca1[3] * x15; x24 -= ca2[0] * x15; x25 -= ca2[1] * x15; x26 -= ca2[2] * x15; x27 -= ca2[3] * x15; x28 -= ca3[0] * x15; x29 -= ca3[1] * x15; x30 -= ca3[2] * x15; x31 -= ca3[3] * x15;
            __builtin_amdgcn_sched_barrier(0);
            ca0 = *(const f32x4*)(Am + 15 * AP + 48);
            ca1 = *(const f32x4*)(Am + 15 * AP + 52);
            ca2 = *(const f32x4*)(Am + 15 * AP + 56);
            ca3 = *(const f32x4*)(Am + 15 * AP + 60);
            __builtin_amdgcn_sched_barrier(0);
            x32 -= cb0[0] * x15; x33 -= cb0[1] * x15; x34 -= cb0[2] * x15; x35 -= cb0[3] * x15; x36 -= cb1[0] * x15; x37 -= cb1[1] * x15; x38 -= cb1[2] * x15; x39 -= cb1[3] * x15; x40 -= cb2[0] * x15; x41 -= cb2[1] * x15; x42 -= cb2[2] * x15; x43 -= cb2[3] * x15; x44 -= cb3[0] * x15; x45 -= cb3[1] * x15; x46 -= cb3[2] * x15; x47 -= cb3[3] * x15;
            __builtin_amdgcn_sched_barrier(0);
            cb0 = *(const f32x4*)(Am + 16 * AP + 16);
            cb1 = *(const f32x4*)(Am + 16 * AP + 20);
            cb2 = *(const f32x4*)(Am + 16 * AP + 24);
            cb3 = *(const f32x4*)(Am + 16 * AP + 28);
            __builtin_amdgcn_sched_barrier(0);
            x48 -= ca0[0] * x15; x49 -= ca0[1] * x15; x50 -= ca0[2] * x15; x51 -= ca0[3] * x15; x52 -= ca1[0] * x15; x53 -= ca1[1] * x15; x54 -= ca1[2] * x15; x55 -= ca1[3] * x15; x56 -= ca2[0] * x15; x57 -= ca2[1] * x15; x58 -= ca2[2] * x15; x59 -= ca2[3] * x15; x60 -= ca3[0] * x15; x61 -= ca3[1] * x15; x62 -= ca3[2] * x15; x63 -= ca3[3] * x15;
            __builtin_amdgcn_sched_barrier(0);
            ca0 = *(const f32x4*)(Am + 16 * AP + 32);
            ca1 = *(const f32x4*)(Am + 16 * AP + 36);
            ca2 = *(const f32x4*)(Am + 16 * AP + 40);
            ca3 = *(const f32x4*)(Am + 16 * AP + 44);
            __builtin_amdgcn_sched_barrier(0);
            x17 -= cb0[1] * x16; x18 -= cb0[2] * x16; x19 -= cb0[3] * x16; x20 -= cb1[0] * x16; x21 -= cb1[1] * x16; x22 -= cb1[2] * x16; x23 -= cb1[3] * x16; x24 -= cb2[0] * x16; x25 -= cb2[1] * x16; x26 -= cb2[2] * x16; x27 -= cb2[3] * x16; x28 -= cb3[0] * x16; x29 -= cb3[1] * x16; x30 -= cb3[2] * x16; x31 -= cb3[3] * x16;
            __builtin_amdgcn_sched_barrier(0);
            cb0 = *(const f32x4*)(Am + 16 * AP + 48);
            cb1 = *(const f32x4*)(Am + 16 * AP + 52);
            cb2 = *(const f32x4*)(Am + 16 * AP + 56);
            cb3 = *(const f32x4*)(Am + 16 * AP + 60);
            __builtin_amdgcn_sched_barrier(0);
            x32 -= ca0[0] * x16; x33 -= ca0[1] * x16; x34 -= ca0[2] * x16; x35 -= ca0[3] * x16; x36 -= ca1[0] * x16; x37 -= ca1[1] * x16; x38 -= ca1[2] * x16; x39 -= ca1[3] * x16; x40 -= ca2[0] * x16; x41 -= ca2[1] * x16; x42 -= ca2[2] * x16; x43 -= ca2[3] * x16; x44 -= ca3[0] * x16; x45 -= ca3[1] * x16; x46 -= ca3[2] * x16; x47 -= ca3[3] * x16;
            __builtin_amdgcn_sched_barrier(0);
            ca0 = *(const f32x4*)(Am + 17 * AP + 16);
            ca1 = *(const f32x4*)(Am + 17 * AP + 20);
            ca2 = *(const f32x4*)(Am + 17 * AP + 24);
            ca3 = *(const f32x4*)(Am + 17 * AP + 28);
            __builtin_amdgcn_sched_barrier(0);
            x48 -= cb0[0] * x16; x49 -= cb0[1] * x16; x50 -= cb0[2] * x16; x51 -= cb0[3] * x16; x52 -= cb1[0] * x16; x53 -= cb1[1] * x16; x54 -= cb1[2] * x16; x55 -= cb1[3] * x16; x56 -= cb2[0] * x16; x57 -= cb2[1] * x16; x58 -= cb2[2] * x16; x59 -= cb2[3] * x16; x60 -= cb3[0] * x16; x61 -= cb3[1] * x16; x62 -= cb3[2] * x16; x63 -= cb3[3] * x16;
            __builtin_amdgcn_sched_barrier(0);
            cb0 = *(const f32x4*)(Am + 17 * AP + 32);
            cb1 = *(const f32x4*)(Am + 17 * AP + 36);
            cb2 = *(const f32x4*)(Am + 17 * AP + 40);
            cb3 = *(const f32x4*)(Am + 17 * AP + 44);
            __builtin_amdgcn_sched_barrier(0);
            x18 -= ca0[2] * x17; x19 -= ca0[3] * x17; x20 -= ca1[0] * x17; x21 -= ca1[1] * x17; x22 -= ca1[2] * x17; x23 -= ca1[3] * x17; x24 -= ca2[0] * x17; x25 -= ca2[1] * x17; x26 -= ca2[2] * x17; x27 -= ca2[3] * x17; x28 -= ca3[0] * x17; x29 -= ca3[1] * x17; x30 -= ca3[2] * x17; x31 -= ca3[3] * x17;
            __builtin_amdgcn_sched_barrier(0);
            ca0 = *(const f32x4*)(Am + 17 * AP + 48);
            ca1 = *(const f32x4*)(Am + 17 * AP + 52);
            ca2 = *(const f32x4*)(Am + 17 * AP + 56);
            ca3 = *(const f32x4*)(Am + 17 * AP + 60);
            __builtin_amdgcn_sched_barrier(0);
            x32 -= cb0[0] * x17; x33 -= cb0[1] * x17; x34 -= cb0[2] * x17; x35 -= cb0[3] * x17; x36 -= cb1[0] * x17; x37 -= cb1[1] * x17; x38 -= cb1[2] * x17; x39 -= cb1[3] * x17; x40 -= cb2[0] * x17; x41 -= cb2[1] * x17; x42 -= cb2[2] * x17; x43 -= cb2[3] * x17; x44 -= cb3[0] * x17; x45 -= cb3[1] * x17; x46 -= cb3[2] * x17; x47 -= cb3[3] * x17;
            __builtin_amdgcn_sched_barrier(0);
            cb0 = *(const f32x4*)(Am + 18 * AP + 16);
            cb1 = *(const f32x4*)(Am + 18 * AP + 20);
            cb2 = *(const f32x4*)(Am + 18 * AP + 24);
            cb3 = *(const f32x4*)(Am + 18 * AP + 28);
            __builtin_amdgcn_sched_barrier(0);
            x48 -= ca0[0] * x17; x49 -= ca0[1] * x17; x50 -= ca0[2] * x17; x51 -= ca0[3] * x17; x52 -= ca1[0] * x17; x53 -= ca1[1] * x17; x54 -= ca1[2] * x17; x55 -= ca1[3] * x17; x56 -= ca2[0] * x17; x57 -= ca2[1] * x17; x58 -= ca2[2] * x17; x59 -= ca2[3] * x17; x60 -= ca3[0] * x17; x61 -= ca3[1] * x17; x62 -= ca3[2] * x17; x63 -= ca3[3] * x17;
            __builtin_amdgcn_sched_barrier(0);
            ca0 = *(const f32x4*)(Am + 18 * AP + 32);
            ca1 = *(const f32x4*)(Am + 18 * AP + 36);
            ca2 = *(const f32x4*)(Am + 18 * AP + 40);
            ca3 = *(const f32x4*)(Am + 18 * AP + 44);
            __builtin_amdgcn_sched_barrier(0);
            x19 -= cb0[3] * x18; x20 -= cb1[0] * x18; x21 -= cb1[1] * x18; x22 -= cb1[2] * x18; x23 -= cb1[3] * x18; x24 -= cb2[0] * x18; x25 -= cb2[1] * x18; x26 -= cb2[2] * x18; x27 -= cb2[3] * x18; x28 -= cb3[0] * x18; x29 -= cb3[1] * x18; x30 -= cb3[2] * x18; x31 -= cb3[3] * x18;
            __builtin_amdgcn_sched_barrier(0);
            cb0 = *(const f32x4*)(Am + 18 * AP + 48);
            cb1 = *(const f32x4*)(Am + 18 * AP + 52);
            cb2 = *(const f32x4*)(Am + 18 * AP + 56);
            cb3 = *(const f32x4*)(Am + 18 * AP + 60);
            __builtin_amdgcn_sched_barrier(0);
            x32 -= ca0[0] * x18; x33 -= ca0[1] * x18; x34 -= ca0[2] * x18; x35 -= ca0[3] * x18; x36 -= ca1[0] * x18; x37 -= ca1[1] * x18; x38 -= ca1[2] * x18; x39 -= ca1[3] * x18; x40 -= ca2[0] * x18; x41 -= ca2[1] * x18; x42 -= ca2[2] * x18; x43 -= ca2[3] * x18; x44 -= ca3[0] * x18; x45 -= ca3[1] * x18; x46 -= ca3[2] * x18; x47 -= ca3[3] * x18;
            __builtin_amdgcn_sched_barrier(0);
            ca1 = *(const f32x4*)(Am + 19 * AP + 20);
            ca2 = *(const f32x4*)(Am + 19 * AP + 24);
            ca3 = *(const f32x4*)(Am + 19 * AP + 28);
            __builtin_amdgcn_sched_barrier(0);
            x48 -= cb0[0] * x18; x49 -= cb0[1] * x18; x50 -= cb0[2] * x18; x51 -= cb0[3] * x18; x52 -= cb1[0] * x18; x53 -= cb1[1] * x18; x54 -= cb1[2] * x18; x55 -= cb1[3] * x18; x56 -= cb2[0] * x18; x57 -= cb2[1] * x18; x58 -= cb2[2] * x18; x59 -= cb2[3] * x18; x60 -= cb3[0] * x18; x61 -= cb3[1] * x18; x62 -= cb3[2] * x18; x63 -= cb3[3] * x18;
            __builtin_amdgcn_sched_barrier(0);
            cb0 = *(const f32x4*)(Am + 19 * AP + 32);
            cb1 = *(const f32x4*)(Am + 19 * AP + 36);
            cb2 = *(const f32x4*)(Am + 19 * AP + 40);
            cb3 = *(const f32x4*)(Am + 19 * AP + 44);
            __builtin_amdgcn_sched_barrier(0);
            x20 -= ca1[0] * x19; x21 -= ca1[1] * x19; x22 -= ca1[2] * x19; x23 -= ca1[3] * x19; x24 -= ca2[0] * x19; x25 -= ca2[1] * x19; x26 -= ca2[2] * x19; x27 -= ca2[3] * x19; x28 -= ca3[0] * x19; x29 -= ca3[1] * x19; x30 -= ca3[2] * x19; x31 -= ca3[3] * x19;
            __builtin_amdgcn_sched_barrier(0);
            ca0 = *(const f32x4*)(Am + 19 * AP + 48);
            ca1 = *(const f32x4*)(Am + 19 * AP + 52);
            ca2 = *(const f32x4*)(Am + 19 * AP + 56);
            ca3 = *(const f32x4*)(Am + 19 * AP + 60);
            __builtin_amdgcn_sched_barrier(0);
            x32 -= cb0[0] * x19; x33 -= cb0[1] * x19; x34 -= cb0[2] * x19; x35 -= cb0[3] * x19; x36 -= cb1[0] * x19; x37 -= cb1[1] * x19; x38 -= cb1[2] * x19; x39 -= cb1[3] * x19; x40 -= cb2[0] * x19; x41 -= cb2[1] * x19; x42 -= cb2[2] * x19; x43 -= cb2[3] * x19; x44 -= cb3[0] * x19; x45 -= cb3[1] * x19; x46 -= cb3[2] * x19; x47 -= cb3[3] * x19;
            __builtin_amdgcn_sched_barrier(0);
            cb1 = *(const f32x4*)(Am + 20 * AP + 20);
            cb2 = *(const f32x4*)(Am + 20 * AP + 24);
            cb3 = *(const f32x4*)(Am + 20 * AP + 28);
            __builtin_amdgcn_sched_barrier(0);
            x48 -= ca0[0] * x19; x49 -= ca0[1] * x19; x50 -= ca0[2] * x19; x51 -= ca0[3] * x19; x52 -= ca1[0] * x19; x53 -= ca1[1] * x19; x54 -= ca1[2] * x19; x55 -= ca1[3] * x19; x56 -= ca2[0] * x19; x57 -= ca2[1] * x19; x58 -= ca2[2] * x19; x59 -= ca2[3] * x19; x60 -= ca3[0] * x19; x61 -= ca3[1] * x19; x62 -= ca3[2] * x19; x63 -= ca3[3] * x19;
            __builtin_amdgcn_sched_barrier(0);
            ca0 = *(const f32x4*)(Am + 20 * AP + 32);
            ca1 = *(const f32x4*)(Am + 20 * AP + 36);
            ca2 = *(const f32x4*)(Am + 20 * AP + 40);
            ca3 = *(const f32x4*)(Am + 20 * AP + 44);
            __builtin_amdgcn_sched_barrier(0);
            x21 -= cb1[1] * x20; x22 -= cb1[2] * x20; x23 -= cb1[3] * x20; x24 -= cb2[0] * x20; x25 -= cb2[1] * x20; x26 -= cb2[2] * x20; x27 -= cb2[3] * x20; x28 -= cb3[0] * x20; x29 -= cb3[1] * x20; x30 -= cb3[2] * x20; x31 -= cb3[3] * x20;
            __builtin_amdgcn_sched_barrier(0);
            cb0 = *(const f32x4*)(Am + 20 * AP + 48);
            cb1 = *(const f32x4*)(Am + 20 * AP + 52);
            cb2 = *(const f32x4*)(Am + 20 * AP + 56);
            cb3 = *(const f32x4*)(Am + 20 * AP + 60);
            __builtin_amdgcn_sched_barrier(0);
            x32 -= ca0[0] * x20; x33 -= ca0[1] * x20; x34 -= ca0[2] * x20; x35 -= ca0[3] * x20; x36 -= ca1[0] * x20; x37 -= ca1[1] * x20; x38 -= ca1[2] * x20; x39 -= ca1[3] * x20; x40 -= ca2[0] * x20; x41 -= ca2[1] * x20; x42 -= ca2[2] * x20; x43 -= ca2[3] * x20; x44 -= ca3[0] * x20; x45 -= ca3[1] * x20; x46 -= ca3[2] * x20; x47 -= ca3[3] * x20;
            __builtin_amdgcn_sched_barrier(0);
            ca1 = *(const f32x4*)(Am + 21 * AP + 20);
            ca2 = *(const f32x4*)(Am + 21 * AP + 24);
            ca3 = *(const f32x4*)(Am + 21 * AP + 28);
            __builtin_amdgcn_sched_barrier(0);
            x48 -= cb0[0] * x20; x49 -= cb0[1] * x20; x50 -= cb0[2] * x20; x51 -= cb0[3] * x20; x52 -= cb1[0] * x20; x53 -= cb1[1] * x20; x54 -= cb1[2] * x20; x55 -= cb1[3] * x20; x56 -= cb2[0] * x20; x57 -= cb2[1] * x20; x58 -= cb2[2] * x20; x59 -= cb2[3] * x20; x60 -= cb3[0] * x20; x61 -= cb3[1] * x20; x62 -= cb3[2] * x20; x63 -= cb3[3] * x20;
            __builtin_amdgcn_sched_barrier(0);
            cb0 = *(const f32x4*)(Am + 21 * AP + 32);
            cb1 = *(const f32x4*)(Am + 21 * AP + 36);
            cb2 = *(const f32x4*)(Am + 21 * AP + 40);
            cb3 = *(const f32x4*)(Am + 21 * AP + 44);
            __builtin_amdgcn_sched_barrier(0);
            x22 -= ca1[2] * x21; x23 -= ca1[3] * x21; x24 -= ca2[0] * x21; x25 -= ca2[1] * x21; x26 -= ca2[2] * x21; x27 -= ca2[3] * x21; x28 -= ca3[0] * x21; x29 -= ca3[1] * x21; x30 -= ca3[2] * x21; x31 -= ca3[3] * x21;
            __builtin_amdgcn_sched_barrier(0);
            ca0 = *(const f32x4*)(Am + 21 * AP + 48);
            ca1 = *(const f32x4*)(Am + 21 * AP + 52);
            ca2 = *(const f32x4*)(Am + 21 * AP + 56);
            ca3 = *(const f32x4*)(Am + 21 * AP + 60);
            __builtin_amdgcn_sched_barrier(0);
            x32 -= cb0[0] * x21; x33 -= cb0[1] * x21; x34 -= cb0[2] * x21; x35 -= cb0[3] * x21; x36 -= cb1[0] * x21; x37 -= cb1[1] * x21; x38 -= cb1[2] * x21; x39 -= cb1[3] * x21; x40 -= cb2[0] * x21; x41 -= cb2[1] * x21; x42 -= cb2[2] * x21; x43 -= cb2[3] * x21; x44 -= cb3[0] * x21; x45 -= cb3[1] * x21; x46 -= cb3[2] * x21; x47 -= cb3[3] * x21;
            __builtin_amdgcn_sched_barrier(0);
            cb1 = *(const f32x4*)(Am + 22 * AP + 20);
            cb2 = *(const f32x4*)(Am + 22 * AP + 24);
            cb3 = *(const f32x4*)(Am + 22 * AP + 28);
            __builtin_amdgcn_sched_barrier(0);
            x48 -= ca0[0] * x21; x49 -= ca0[1] * x21; x50 -= ca0[2] * x21; x51 -= ca0[3] * x21; x52 -= ca1[0] * x21; x53 -= ca1[1] * x21; x54 -= ca1[2] * x21; x55 -= ca1[3] * x21; x56 -= ca2[0] * x21; x57 -= ca2[1] * x21; x58 -= ca2[2] * x21; x59 -= ca2[3] * x21; x60 -= ca3[0] * x21; x61 -= ca3[1] * x21; x62 -= ca3[2] * x21; x63 -= ca3[3] * x21;
            __builtin_amdgcn_sched_barrier(0);
            ca0 = *(const f32x4*)(Am + 22 * AP + 32);
            ca1 = *(const f32x4*)(Am + 22 * AP + 36);
            ca2 = *(const f32x4*)(Am + 22 * AP + 40);
            ca3 = *(const f32x4*)(Am + 22 * AP + 44);
            __builtin_amdgcn_sched_barrier(0);
            x23 -= cb1[3] * x22; x24 -= cb2[0] * x22; x25 -= cb2[1] * x22; x26 -= cb2[2] * x22; x27 -= cb2[3] * x22; x28 -= cb3[0] * x22; x29 -= cb3[1] * x22; x30 -= cb3[2] * x22; x31 -= cb3[3] * x22;
            __builtin_amdgcn_sched_barrier(0);
            cb0 = *(const f32x4*)(Am + 22 * AP + 48);
            cb1 = *(const f32x4*)(Am + 22 * AP + 52);
            cb2 = *(const f32x4*)(Am + 22 * AP + 56);
            cb3 = *(const f32x4*)(Am + 22 * AP + 60);
            __builtin_amdgcn_sched_barrier(0);
            x32 -= ca0[0] * x22; x33 -= ca0[1] * x22; x34 -= ca0[2] * x22; x35 -= ca0[3] * x22; x36 -= ca1[0] * x22; x37 -= ca1[1] * x22; x38 -= ca1[2] * x22; x39 -= ca1[3] * x22; x40 -= ca2[0] * x22; x41 -= ca2[1] * x22; x42 -= ca2[2] * x22; x43 -= ca2[3] * x22; x44 -= ca3[0] * x22; x45 -= ca3[1] * x22; x46 -= ca3[2] * x22; x47 -= ca3[3] * x22;
            __builtin_amdgcn_sched_barrier(0);
            ca2 = *(const f32x4*)(Am + 23 * AP + 24);
            ca3 = *(const f32x4*)(Am + 23 * AP + 28);
            __builtin_amdgcn_sched_barrier(0);
            x48 -= cb0[0] * x22; x49 -= cb0[1] * x22; x50 -= cb0[2] * x22; x51 -= cb0[3] * x22; x52 -= cb1[0] * x22; x53 -= cb1[1] * x22; x54 -= cb1[2] * x22; x55 -= cb1[3] * x22; x56 -= cb2[0] * x22; x57 -= cb2[1] * x22; x58 -= cb2[2] * x22; x59 -= cb2[3] * x22; x60 -= cb3[0] * x22; x61 -= cb3[1] * x22; x62 -= cb3[2] * x22; x63 -= cb3[3] * x22;
            __builtin_amdgcn_sched_barrier(0);
            cb0 = *(const f32x4*)(Am + 23 * AP + 32);
            cb1 = *(const f32x4*)(Am + 23 * AP + 36);
            cb2 = *(const f32x4*)(Am + 23 * AP + 40);
            cb3 = *(const f32x4*)(Am + 23 * AP + 44);
            __builtin_amdgcn_sched_barrier(0);
            x24 -= ca2[0] * x23; x25 -= ca2[1] * x23; x26 -= ca2[2] * x23; x27 -= ca2[3] * x23; x28 -= ca3[0] * x23; x29 -= ca3[1] * x23; x30 -= ca3[2] * x23; x31 -= ca3[3] * x23;
            __builtin_amdgcn_sched_barrier(0);
            ca0 = *(const f32x4*)(Am + 23 * AP + 48);
            ca1 = *(const f32x4*)(Am + 23 * AP + 52);
            ca2 = *(const f32x4*)(Am + 23 * AP + 56);
            ca3 = *(const f32x4*)(Am + 23 * AP + 60);
            __builtin_amdgcn_sched_barrier(0);
            x32 -= cb0[0] * x23; x33 -= cb0[1] * x23; x34 -= cb0[2] * x23; x35 -= cb0[3] * x23; x36 -= cb1[0] * x23; x37 -= cb1[1] * x23; x38 -= cb1[2] * x23; x39 -= cb1[3] * x23; x40 -= cb2[0] * x23; x41 -= cb2[1] * x23; x42 -= cb2[2] * x23; x43 -= cb2[3] * x23; x44 -= cb3[0] * x23; x45 -= cb3[1] * x23; x46 -= cb3[2] * x23; x47 -= cb3[3] * x23;
            __builtin_amdgcn_sched_barrier(0);
            cb2 = *(const f32x4*)(Am + 24 * AP + 24);
            cb3 = *(const f32x4*)(Am + 24 * AP + 28);
            __builtin_amdgcn_sched_barrier(0);
            x48 -= ca0[0] * x23; x49 -= ca0[1] * x23; x50 -= ca0[2] * x23; x51 -= ca0[3] * x23; x52 -= ca1[0] * x23; x53 -= ca1[1] * x23; x54 -= ca1[2] * x23; x55 -= ca1[3] * x23; x56 -= ca2[0] * x23; x57 -= ca2[1] * x23; x58 -= ca2[2] * x23; x59 -= ca2[3] * x23; x60 -= ca3[0] * x23; x61 -= ca3[1] * x23; x62 -= ca3[2] * x23; x63 -= ca3[3] * x23;
            __builtin_amdgcn_sched_barrier(0);
            ca0 = *(const f32x4*)(Am + 24 * AP + 32);
            ca1 = *(const f32x4*)(Am + 24 * AP + 36);
            ca2 = *(const f32x4*)(Am + 24 * AP + 40);
            ca3 = *(const f32x4*)(Am + 24 * AP + 44);
            __builtin_amdgcn_sched_barrier(0);
            x25 -= cb2[1] * x24; x26 -= cb2[2] * x24; x27 -= cb2[3] * x24; x28 -= cb3[0] * x24; x29 -= cb3[1] * x24; x30 -= cb3[2] * x24; x31 -= cb3[3] * x24;
            __builtin_amdgcn_sched_barrier(0);
            cb0 = *(const f32x4*)(Am + 24 * AP + 48);
            cb1 = *(const f32x4*)(Am + 24 * AP + 52);
            cb2 = *(const f32x4*)(Am + 24 * AP + 56);
            cb3 = *(const f32x4*)(Am + 24 * AP + 60);
            __builtin_amdgcn_sched_barrier(0);
            x32 -= ca0[0] * x24; x33 -= ca0[1] * x24; x34 -= ca0[2] * x24; x35 -= ca0[3] * x24; x36 -= ca1[0] * x24; x37 -= ca1[1] * x24; x38 -= ca1[2] * x24; x39 -= ca1[3] * x24; x40 -= ca2[0] * x24; x41 -= ca2[1] * x24; x42 -= ca2[2] * x24; x43 -= ca2[3] * x24; x44 -= ca3[0] * x24; x45 -= ca3[1] * x24; x46 -= ca3[2] * x24; x47 -= ca3[3] * x24;
            __builtin_amdgcn_sched_barrier(0);
            ca2 = *(const f32x4*)(Am + 25 * AP + 24);
            ca3 = *(const f32x4*)(Am + 25 * AP + 28);
            __builtin_amdgcn_sched_barrier(0);
            x48 -= cb0[0] * x24; x49 -= cb0[1] * x24; x50 -= cb0[2] * x24; x51 -= cb0[3] * x24; x52 -= cb1[0] * x24; x53 -= cb1[1] * x24; x54 -= cb1[2] * x24; x55 -= cb1[3] * x24; x56 -= cb2[0] * x24; x57 -= cb2[1] * x24; x58 -= cb2[2] * x24; x59 -= cb2[3] * x24; x60 -= cb3[0] * x24; x61 -= cb3[1] * x24; x62 -= cb3[2] * x24; x63 -= cb3[3] * x24;
            __builtin_amdgcn_sched_barrier(0);
            cb0 = *(const f32x4*)(Am + 25 * AP + 32);
            cb1 = *(const f32x4*)(Am + 25 * AP + 36);
            cb2 = *(const f32x4*)(Am + 25 * AP + 40);
            cb3 = *(const f32x4*)(Am + 25 * AP + 44);
            __builtin_amdgcn_sched_barrier(0);
            x26 -= ca2[2] * x25; x27 -= ca2[3] * x25; x28 -= ca3[0] * x25; x29 -= ca3[1] * x25; x30 -= ca3[2] * x25; x31 -= ca3[3] * x25;
            __builtin_amdgcn_sched_barrier(0);
            ca0 = *(const f32x4*)(Am + 25 * AP + 48);
            ca1 = *(const f32x4*)(Am + 25 * AP + 52);
            ca2 = *(const f32x4*)(Am + 25 * AP + 56);
            ca3 = *(const f32x4*)(Am + 25 * AP + 60);
            __builtin_amdgcn_sched_barrier(0);
            x32 -= cb0[0] * x25; x33 -= cb0[1] * x25; x34 -= cb0[2] * x25; x35 -= cb0[3] * x25; x36 -= cb1[0] * x25; x37 -= cb1[1] * x25; x38 -= cb1[2] * x25; x39 -= cb1[3] * x25; x40 -= cb2[0] * x25; x41 -= cb2[1] * x25; x42 -= cb2[2] * x25; x43 -= cb2[3] * x25; x44 -= cb3[0] * x25; x45 -= cb3[1] * x25; x46 -= cb3[2] * x25; x47 -= cb3[3] * x25;
            __builtin_amdgcn_sched_barrier(0);
            cb2 = *(const f32x4*)(Am + 26 * AP + 24);
            cb3 = *(const f32x4*)(Am + 26 * AP + 28);
            __builtin_amdgcn_sched_barrier(0);
            x48 -= ca0[0] * x25; x49 -= ca0[1] * x25; x50 -= ca0[2] * x25; x51 -= ca0[3] * x25; x52 -= ca1[0] * x25; x53 -= ca1[1] * x25; x54 -= ca1[2] * x25; x55 -= ca1[3] * x25; x56 -= ca2[0] * x25; x57 -= ca2[1] * x25; x58 -= ca2[2] * x25; x59 -= ca2[3] * x25; x60 -= ca3[0] * x25; x61 -= ca3[1] * x25; x62 -= ca3[2] * x25; x63 -= ca3[3] * x25;
            __builtin_amdgcn_sched_barrier(0);
            ca0 = *(const f32x4*)(Am + 26 * AP + 32);
            ca1 = *(const f32x4*)(Am + 26 * AP + 36);
            ca2 = *(const f32x4*)(Am + 26 * AP + 40);
            ca3 = *(const f32x4*)(Am + 26 * AP + 44);
            __builtin_amdgcn_sched_barrier(0);
            x27 -= cb2[3] * x26; x28 -= cb3[0] * x26; x29 -= cb3[1] * x26; x30 -= cb3[2] * x26; x31 -= cb3[3] * x26;
            __builtin_amdgcn_sched_barrier(0);
            cb0 = *(const f32x4*)(Am + 26 * AP + 48);
            cb1 = *(const f32x4*)(Am + 26 * AP + 52);
            cb2 = *(const f32x4*)(Am + 26 * AP + 56);
            cb3 = *(const f32x4*)(Am + 26 * AP + 60);
            __builtin_amdgcn_sched_barrier(0);
            x32 -= ca0[0] * x26; x33 -= ca0[1] * x26; x34 -= ca0[2] * x26; x35 -= ca0[3] * x26; x36 -= ca1[0] * x26; x37 -= ca1[1] * x26; x38 -= ca1[2] * x26; x39 -= ca1[3] * x26; x40 -= ca2[0] * x26; x41 -= ca2[1] * x26; x42 -= ca2[2] * x26; x43 -= ca2[3] * x26; x44 -= ca3[0] * x26; x45 -= ca3[1] * x26; x46 -= ca3[2] * x26; x47 -= ca3[3] * x26;
            __builtin_amdgcn_sched_barrier(0);
            ca3 = *(const f32x4*)(Am + 27 * AP + 28);
            __builtin_amdgcn_sched_barrier(0);
            x48 -= cb0[0] * x26; x49 -= cb0[1] * x26; x50 -= cb0[2] * x26; x51 -= cb0[3] * x26; x52 -= cb1[0] * x26; x53 -= cb1[1] * x26; x54 -= cb1[2] * x26; x55 -= cb1[3] * x26; x56 -= cb2[0] * x26; x57 -= cb2[1] * x26; x58 -= cb2[2] * x26; x59 -= cb2[3] * x26; x60 -= cb3[0] * x26; x61 -= cb3[1] * x26; x62 -= cb3[2] * x26; x63 -= cb3[3] * x26;
            __builtin_amdgcn_sched_barrier(0);
            cb0 = *(const f32x4*)(Am + 27 * AP + 32);
            cb1 = *(const f32x4*)(Am + 27 * AP + 36);
            cb2 = *(const f32x4*)(Am + 27 * AP + 40);
            cb3 = *(const f32x4*)(Am + 27 * AP + 44);
            __builtin_amdgcn_sched_barrier(0);
            x28 -= ca3[0] * x27; x29 -= ca3[1] * x27; x30 -= ca3[2] * x27; x31 -= ca3[3] * x27;
            __builtin_amdgcn_sched_barrier(0);
            ca0 = *(const f32x4*)(Am + 27 * AP + 48);
            ca1 = *(const f32x4*)(Am + 27 * AP + 52);
            ca2 = *(const f32x4*)(Am + 27 * AP + 56);
            ca3 = *(const f32x4*)(Am + 27 * AP + 60);
            __builtin_amdgcn_sched_barrier(0);
            x32 -= cb0[0] * x27; x33 -= cb0[1] * x27; x34 -= cb0[2] * x27; x35 -= cb0[3] * x27; x36 -= cb1[0] * x27; x37 -= cb1[1] * x27; x38 -= cb1[2] * x27; x39 -= cb1[3] * x27; x40 -= cb2[0] * x27; x41 -= cb2[1] * x27; x42 -= cb2[2] * x27; x43 -= cb2[3] * x27; x44 -= cb3[0] * x27; x45 -= cb3[1] * x27; x46 -= cb3[2] * x27; x47 -= cb3[3] * x27;
            __builtin_amdgcn_sched_barrier(0);
            cb3 = *(const f32x4*)(Am + 28 * AP + 28);
            __builtin_amdgcn_sched_barrier(0);
            x48 -= ca0[0] * x27; x49 -= ca0[1] * x27; x50 -= ca0[2] * x27; x51 -= ca0[3] * x27; x52 -= ca1[0] * x27; x53 -= ca1[1] * x27; x54 -= ca1[2] * x27; x55 -= ca1[3] * x27; x56 -= ca2[0] * x27; x57 -= ca2[1] * x27; x58 -= ca2[2] * x27; x59 -= ca2[3] * x27; x60 -= ca3[0] * x27; x61 -= ca3[1] * x27; x62 -= ca3[2] * x27; x63 -= ca3[3] * x27;
            __builtin_amdgcn_sched_barrier(0);
            ca0 = *(const f32x4*)(Am + 28 * AP + 32);
            ca1 = *(const f32x4*)(Am + 28 * AP + 36);
            ca2 = *(const f32x4*)(Am + 28 * AP + 40);
            ca3 = *(const f32x4*)(Am + 28 * AP + 44);
            __builtin_amdgcn_sched_barrier(0);
            x29 -= cb3[1] * x28; x30 -= cb3[2] * x28; x31 -= cb3[3] * x28;
            __builtin_amdgcn_sched_barrier(0);
            cb0 = *(const f32x4*)(Am + 28 * AP + 48);
            cb1 = *(const f32x4*)(Am + 28 * AP + 52);
            cb2 = *(const f32x4*)(Am + 28 * AP + 56);
            cb3 = *(const f32x4*)(Am + 28 * AP + 60);
            __builtin_amdgcn_sched_barrier(0);
            x32 -= ca0[0] * x28; x33 -= ca0[1] * x28; x34 -= ca0[2] * x28; x35 -= ca0[3] * x28; x36 -= ca1[0] * x28; x37 -= ca1[1] * x28; x38 -= ca1[2] * x28; x39 -= ca1[3] * x28; x40 -= ca2[0] * x28; x41 -= ca2[1] * x28; x42 -= ca2[2] * x28; x43 -= ca2[3] * x28; x44 -= ca3[0] * x28; x45 -= ca3[1] * x28; x46 -= ca3[2] * x28; x47 -= ca3[3] * x28;
            __builtin_amdgcn_sched_barrier(0);
            ca3 = *(const f32x4*)(Am + 29 * AP + 28);
            __builtin_amdgcn_sched_barrier(0);
            x48 -= cb0[0] * x28; x49 -= cb0[1] * x28; x50 -= cb0[2] * x28; x51 -= cb0[3] * x28; x52 -= cb1[0] * x28; x53 -= cb1[1] * x28; x54 -= cb1[2] * x28; x55 -= cb1[3] * x28; x56 -= cb2[0] * x28; x57 -= cb2[1] * x28; x58 -= cb2[2] * x28; x59 -= cb2[3] * x28; x60 -= cb3[0] * x28; x61 -= cb3[1] * x28; x62 -= cb3[2] * x28; x63 -= cb3[3] * x28;
            __builtin_amdgcn_sched_barrier(0);
            cb0 = *(const f32x4*)(Am + 29 * AP + 32);
            cb1 = *(const f32x4*)(Am + 29 * AP + 36);
            cb2 = *(const f32x4*)(Am + 29 * AP + 40);
            cb3 = *(const f32x4*)(Am + 29 * AP + 44);
            __builtin_amdgcn_sched_barrier(0);
            x30 -= ca3[2] * x29; x31 -= ca3[3] * x29;
            __builtin_amdgcn_sched_barrier(0);
            ca0 = *(const f32x4*)(Am + 29 * AP + 48);
            ca1 = *(const f32x4*)(Am + 29 * AP + 52);
            ca2 = *(const f32x4*)(Am + 29 * AP + 56);
            ca3 = *(const f32x4*)(Am + 29 * AP + 60);
            __builtin_amdgcn_sched_barrier(0);
            x32 -= cb0[0] * x29; x33 -= cb0[1] * x29; x34 -= cb0[2] * x29; x35 -= cb0[3] * x29; x36 -= cb1[0] * x29; x37 -= cb1[1] * x29; x38 -= cb1[2] * x29; x39 -= cb1[3] * x29; x40 -= cb2[0] * x29; x41 -= cb2[1] * x29; x42 -= cb2[2] * x29; x43 -= cb2[3] * x29; x44 -= cb3[0] * x29; x45 -= cb3[1] * x29; x46 -= cb3[2] * x29; x47 -= cb3[3] * x29;
            __builtin_amdgcn_sched_barrier(0);
            cb3 = *(const f32x4*)(Am + 30 * AP + 28);
            __builtin_amdgcn_sched_barrier(0);
            x48 -= ca0[0] * x29; x49 -= ca0[1] * x29; x50 -= ca0[2] * x29; x51 -= ca0[3] * x29; x52 -= ca1[0] * x29; x53 -= ca1[1] * x29; x54 -= ca1[2] * x29; x55 -= ca1[3] * x29; x56 -= ca2[0] * x29; x57 -= ca2[1] * x29; x58 -= ca2[2] * x29; x59 -= ca2[3] * x29; x60 -= ca3[0] * x29; x61 -= ca3[1] * x29; x62 -= ca3[2] * x29; x63 -= ca3[3] * x29;
            __builtin_amdgcn_sched_barrier(0);
            ca0 = *(const f32x4*)(Am + 30 * AP + 32);
            ca1 = *(const f32x4*)(Am + 30 * AP + 36);
            ca2 = *(const f32x4*)(Am + 30 * AP + 40);
            ca3 = *(const f32x4*)(Am + 30 * AP + 44);
            __builtin_amdgcn_sched_barrier(0);
            x31 -= cb3[3] * x30;
            __builtin_amdgcn_sched_barrier(0);
            cb0 = *(const f32x4*)(Am + 30 * AP + 48);
            cb1 = *(const f32x4*)(Am + 30 * AP + 52);
            cb2 = *(const f32x4*)(Am + 30 * AP + 56);
            cb3 = *(const f32x4*)(Am + 30 * AP + 60);
            __builtin_amdgcn_sched_barrier(0);
            x32 -= ca0[0] * x30; x33 -= ca0[1] * x30; x34 -= ca0[2] * x30; x35 -= ca0[3] * x30; x36 -= ca1[0] * x30; x37 -= ca1[1] * x30; x38 -= ca1[2] * x30; x39 -= ca1[3] * x30; x40 -= ca2[0] * x30; x41 -= ca2[1] * x30; x42 -= ca2[2] * x30; x43 -= ca2[3] * x30; x44 -= ca3[0] * x30; x45 -= ca3[1] * x30; x46 -= ca3[2] * x30; x47 -= ca3[3] * x30;
            __builtin_amdgcn_sched_barrier(0);
            ca0 = *(const f32x4*)(Am + 31 * AP + 32);
            ca1 = *(const f32x4*)(Am + 31 * AP + 36);
            ca2 = *(const f32x4*)(Am + 31 * AP + 40);
            ca3 = *(const f32x4*)(Am + 31 * AP + 44);
            __builtin_amdgcn_sched_barrier(0);
            x48 -= cb0[0] * x30; x49 -= cb0[1] * x30; x50 -= cb0[2] * x30; x51 -= cb0[3] * x30; x52 -= cb1[0] * x30; x53 -= cb1[1] * x30; x54 -= cb1[2] * x30; x55 -= cb1[3] * x30; x56 -= cb2[0] * x30; x57 -= cb2[1] * x30; x58 -= cb2[2] * x30; x59 -= cb2[3] * x30; x60 -= cb3[0] * x30; x61 -= cb3[1] * x30; x62 -= cb3[2] * x30; x63 -= cb3[3] * x30;
            __builtin_amdgcn_sched_barrier(0);
            cb0 = *(const f32x4*)(Am + 31 * AP + 48);
            cb1 = *(const f32x4*)(Am + 31 * AP + 52);
            cb2 = *(const f32x4*)(Am + 31 * AP + 56);
            cb3 = *(const f32x4*)(Am + 31 * AP + 60);
            __builtin_amdgcn_sched_barrier(0);
            x32 -= ca0[0] * x31; x33 -= ca0[1] * x31; x34 -= ca0[2] * x31; x35 -= ca0[3] * x31; x36 -= ca1[0] * x31; x37 -= ca1[1] * x31; x38 -= ca1[2] * x31; x39 -= ca1[3] * x31; x40 -= ca2[0] * x31; x41 -= ca2[1] * x31; x42 -= ca2[2] * x31; x43 -= ca2[3] * x31; x44 -= ca3[0] * x31; x45 -= ca3[1] * x31; x46 -= ca3[2] * x31; x47 -= ca3[3] * x31;
            __builtin_amdgcn_sched_barrier(0);
            ca0 = *(const f32x4*)(Am + 32 * AP + 32);
            ca1 = *(const f32x4*)(Am + 32 * AP + 36);
            ca2 = *(const f32x4*)(Am + 32 * AP + 40);
            ca3 = *(const f32x4*)(Am + 32 * AP + 44);
            __builtin_amdgcn_sched_barrier(0);
            x48 -= cb0[0] * x31; x49 -= cb0[1] * x31; x50 -= cb0[2] * x31; x51 -= cb0[3] * x31; x52 -= cb1[0] * x31; x53 -= cb1[1] * x31; x54 -= cb1[2] * x31; x55 -= cb1[3] * x31; x56 -= cb2[0] * x31; x57 -= cb2[1] * x31; x58 -= cb2[2] * x31; x59 -= cb2[3] * x31; x60 -= cb3[0] * x31; x61 -= cb3[1] * x31; x62 -= cb3[2] * x31; x63 -= cb3[3] * x31;
            __builtin_amdgcn_sched_barrier(0);
            cb0 = *(const f32x4*)(Am + 32 * AP + 48);
            cb1 = *(const f32x4*)(Am + 32 * AP + 52);
            cb2 = *(const f32x4*)(Am + 32 * AP + 56);
            cb3 = *(const f32x4*)(Am + 32 * AP + 60);
            __builtin_amdgcn_sched_barrier(0);
            x33 -= ca0[1] * x32; x34 -= ca0[2] * x32; x35 -= ca0[3] * x32; x36 -= ca1[0] * x32; x37 -= ca1[1] * x32; x38 -= ca1[2] * x32; x39 -= ca1[3] * x32; x40 -= ca2[0] * x32; x41 -= ca2[1] * x32; x42 -= ca2[2] * x32; x43 -= ca2[3] * x32; x44 -= ca3[0] * x32; x45 -= ca3[1] * x32; x46 -= ca3[2] * x32; x47 -= ca3[3] * x32;
            __builtin_amdgcn_sched_barrier(0);
            ca0 = *(const f32x4*)(Am + 33 * AP + 32);
            ca1 = *(const f32x4*)(Am + 33 * AP + 36);
            ca2 = *(const f32x4*)(Am + 33 * AP + 40);
            ca3 = *(const f32x4*)(Am + 33 * AP + 44);
            __builtin_amdgcn_sched_barrier(0);
            x48 -= cb0[0] * x32; x49 -= cb0[1] * x32; x50 -= cb0[2] * x32; x51 -= cb0[3] * x32; x52 -= cb1[0] * x32; x53 -= cb1[1] * x32; x54 -= cb1[2] * x32; x55 -= cb1[3] * x32; x56 -= cb2[0] * x32; x57 -= cb2[1] * x32; x58 -= cb2[2] * x32; x59 -= cb2[3] * x32; x60 -= cb3[0] * x32; x61 -= cb3[1] * x32; x62 -= cb3[2] * x32; x63 -= cb3[3] * x32;
            __builtin_amdgcn_sched_barrier(0);
            cb0 = *(const f32x4*)(Am + 33 * AP + 48);
            cb1 = *(const f32x4*)(Am + 33 * AP + 52);
            cb2 = *(const f32x4*)(Am + 33 * AP + 56);
            cb3 = *(const f32x4*)(Am + 33 * AP + 60);
            __builtin_amdgcn_sched_barrier(0);
            x34 -= ca0[2] * x33; x35 -= ca0[3] * x33; x36 -= ca1[0] * x33; x37 -= ca1[1] * x33; x38 -= ca1[2] * x33; x39 -= ca1[3] * x33; x40 -= ca2[0] * x33; x41 -= ca2[1] * x33; x42 -= ca2[2] * x33; x43 -= ca2[3] * x33; x44 -= ca3[0] * x33; x45 -= ca3[1] * x33; x46 -= ca3[2] * x33; x47 -= ca3[3] * x33;
            __builtin_amdgcn_sched_barrier(0);
            ca0 = *(const f32x4*)(Am + 34 * AP + 32);
            ca1 = *(const f32x4*)(Am + 34 * AP + 36);
            ca2 = *(const f32x4*)(Am + 34 * AP + 40);
            ca3 = *(const f32x4*)(Am + 34 * AP + 44);
            __builtin_amdgcn_sched_barrier(0);
            x48 -= cb0[0] * x33; x49 -= cb0[1] * x33; x50 -= cb0[2] * x33; x51 -= cb0[3] * x33; x52 -= cb1[0] * x33; x53 -= cb1[1] * x33; x54 -= cb1[2] * x33; x55 -= cb1[3] * x33; x56 -= cb2[0] * x33; x57 -= cb2[1] * x33; x58 -= cb2[2] * x33; x59 -= cb2[3] * x33; x60 -= cb3[0] * x33; x61 -= cb3[1] * x33; x62 -= cb3[2] * x33; x63 -= cb3[3] * x33;
            __builtin_amdgcn_sched_barrier(0);
            cb0 = *(const f32x4*)(Am + 34 * AP + 48);
            cb1 = *(const f32x4*)(Am + 34 * AP + 52);
            cb2 = *(const f32x4*)(Am + 34 * AP + 56);
            cb3 = *(const f32x4*)(Am + 34 * AP + 60);
            __builtin_amdgcn_sched_barrier(0);
            x35 -= ca0[3] * x34; x36 -= ca1[0] * x34; x37 -= ca1[1] * x34; x38 -= ca1[2] * x34; x39 -= ca1[3] * x34; x40 -= ca2[0] * x34; x41 -= ca2[1] * x34; x42 -= ca2[2] * x34; x43 -= ca2[3] * x34; x44 -= ca3[0] * x34; x45 -= ca3[1] * x34; x46 -= ca3[2] * x34; x47 -= ca3[3] * x34;
            __builtin_amdgcn_sched_barrier(0);
            ca1 = *(const f32x4*)(Am + 35 * AP + 36);
            ca2 = *(const f32x4*)(Am + 35 * AP + 40);
            ca3 = *(const f32x4*)(Am + 35 * AP + 44);
            __builtin_amdgcn_sched_barrier(0);
            x48 -= cb0[0] * x34; x49 -= cb0[1] * x34; x50 -= cb0[2] * x34; x51 -= cb0[3] * x34; x52 -= cb1[0] * x34; x53 -= cb1[1] * x34; x54 -= cb1[2] * x34; x55 -= cb1[3] * x34; x56 -= cb2[0] * x34; x57 -= cb2[1] * x34; x58 -= cb2[2] * x34; x59 -= cb2[3] * x34; x60 -= cb3[0] * x34; x61 -= cb3[1] * x34; x62 -= cb3[2] * x34; x63 -= cb3[3] * x34;
            __builtin_amdgcn_sched_barrier(0);
            cb0 = *(const f32x4*)(Am + 35 * AP + 48);
            cb1 = *(const f32x4*)(Am + 35 * AP + 52);
            cb2 = *(const f32x4*)(Am + 35 * AP + 56);
            cb3 = *(const f32x4*)(Am + 35 * AP + 60);
            __builtin_amdgcn_sched_barrier(0);
            x36 -= ca1[0] * x35; x37 -= ca1[1] * x35; x38 -= ca1[2] * x35; x39 -= ca1[3] * x35; x40 -= ca2[0] * x35; x41 -= ca2[1] * x35; x42 -= ca2[2] * x35; x43 -= ca2[3] * x35; x44 -= ca3[0] * x35; x45 -= ca3[1] * x35; x46 -= ca3[2] * x35; x47 -= ca3[3] * x35;
            __builtin_amdgcn_sched_barrier(0);
            ca1 = *(const f32x4*)(Am + 36 * AP + 36);
            ca2 = *(const f32x4*)(Am + 36 * AP + 40);
            ca3 = *(const f32x4*)(Am + 36 * AP + 44);
            __builtin_amdgcn_sched_barrier(0);
            x48 -= cb0[0] * x35; x49 -= cb0[1] * x35; x50 -= cb0[2] * x35; x51 -= cb0[3] * x35; x52 -= cb1[0] * x35; x53 -= cb1[1] * x35; x54 -= cb1[2] * x35; x55 -= cb1[3] * x35; x56 -= cb2[0] * x35; x57 -= cb2[1] * x35; x58 -= cb2[2] * x35; x59 -= cb2[3] * x35; x60 -= cb3[0] * x35; x61 -= cb3[1] * x35; x62 -= cb3[2] * x35; x63 -= cb3[3] * x35;
            __builtin_amdgcn_sched_barrier(0);
            cb0 = *(const f32x4*)(Am + 36 * AP + 48);
            cb1 = *(const f32x4*)(Am + 36 * AP + 52);
            cb2 = *(const f32x4*)(Am + 36 * AP + 56);
            cb3 = *(const f32x4*)(Am + 36 * AP + 60);
            __builtin_amdgcn_sched_barrier(0);
            x37 -= ca1[1] * x36; x38 -= ca1[2] * x36; x39 -= ca1[3] * x36; x40 -= ca2[0] * x36; x41 -= ca2[1] * x36; x42 -= ca2[2] * x36; x43 -= ca2[3] * x36; x44 -= ca3[0] * x36; x45 -= ca3[1] * x36; x46 -= ca3[2] * x36; x47 -= ca3[3] * x36;
            __builtin_amdgcn_sched_barrier(0);
            ca1 = *(const f32x4*)(Am + 37 * AP + 36);
            ca2 = *(const f32x4*)(Am + 37 * AP + 40);
            ca3 = *(const f32x4*)(Am + 37 * AP + 44);
            __builtin_amdgcn_sched_barrier(0);
            x48 -= cb0[0] * x36; x49 -= cb0[1] * x36; x50 -= cb0[2] * x36; x51 -= cb0[3] * x36; x52 -= cb1[0] * x36; x53 -= cb1[1] * x36; x54 -= cb1[2] * x36; x55 -= cb1[3] * x36; x56 -= cb2[0] * x36; x57 -= cb2[1] * x36; x58 -= cb2[2] * x36; x59 -= cb2[3] * x36; x60 -= cb3[0] * x36; x61 -= cb3[1] * x36; x62 -= cb3[2] * x36; x63 -= cb3[3] * x36;
            __builtin_amdgcn_sched_barrier(0);
            cb0 = *(const f32x4*)(Am + 37 * AP + 48);
            cb1 = *(const f32x4*)(Am + 37 * AP + 52);
            cb2 = *(const f32x4*)(Am + 37 * AP + 56);
            cb3 = *(const f32x4*)(Am + 37 * AP + 60);
            __builtin_amdgcn_sched_barrier(0);
            x38 -= ca1[2] * x37; x39 -= ca1[3] * x37; x40 -= ca2[0] * x37; x41 -= ca2[1] * x37; x42 -= ca2[2] * x37; x43 -= ca2[3] * x37; x44 -= ca3[0] * x37; x45 -= ca3[1] * x37; x46 -= ca3[2] * x37; x47 -= ca3[3] * x37;
            __builtin_amdgcn_sched_barrier(0);
            ca1 = *(const f32x4*)(Am + 38 * AP + 36);
            ca2 = *(const f32x4*)(Am + 38 * AP + 40);
            ca3 = *(const f32x4*)(Am + 38 * AP + 44);
            __builtin_amdgcn_sched_barrier(0);
            x48 -= cb0[0] * x37; x49 -= cb0[1] * x37; x50 -= cb0[2] * x37; x51 -= cb0[3] * x37; x52 -= cb1[0] * x37; x53 -= cb1[1] * x37; x54 -= cb1[2] * x37; x55 -= cb1[3] * x37; x56 -= cb2[0] * x37; x57 -= cb2[1] * x37; x58 -= cb2[2] * x37; x59 -= cb2[3] * x37; x60 -= cb3[0] * x37; x61 -= cb3[1] * x37; x62 -= cb3[2] * x37; x63 -= cb3[3] * x37;
            __builtin_amdgcn_sched_barrier(0);
            cb0 = *(const f32x4*)(Am + 38 * AP + 48);
            cb1 = *(const f32x4*)(Am + 38 * AP + 52);
            cb2 = *(const f32x4*)(Am + 38 * AP + 56);
            cb3 = *(const f32x4*)(Am + 38 * AP + 60);
            __builtin_amdgcn_sched_barrier(0);
            x39 -= ca1[3] * x38; x40 -= ca2[0] * x38; x41 -= ca2[1] * x38; x42 -= ca2[2] * x38; x43 -= ca2[3] * x38; x44 -= ca3[0] * x38; x45 -= ca3[1] * x38; x46 -= ca3[2] * x38; x47 -= ca3[3] * x38;
            __builtin_amdgcn_sched_barrier(0);
            ca2 = *(const f32x4*)(Am + 39 * AP + 40);
            ca3 = *(const f32x4*)(Am + 39 * AP + 44);
            __builtin_amdgcn_sched_barrier(0);
            x48 -= cb0[0] * x38; x49 -= cb0[1] * x38; x50 -= cb0[2] * x38; x51 -= cb0[3] * x38; x52 -= cb1[0] * x38; x53 -= cb1[1] * x38; x54 -= cb1[2] * x38; x55 -= cb1[3] * x38; x56 -= cb2[0] * x38; x57 -= cb2[1] * x38; x58 -= cb2[2] * x38; x59 -= cb2[3] * x38; x60 -= cb3[0] * x38; x61 -= cb3[1] * x38; x62 -= cb3[2] * x38; x63 -= cb3[3] * x38;
            __builtin_amdgcn_sched_barrier(0);
            cb0 = *(const f32x4*)(Am + 39 * AP + 48);
            cb1 = *(const f32x4*)(Am + 39 * AP + 52);
            cb2 = *(const f32x4*)(Am + 39 * AP + 56);
            cb3 = *(const f32x4*)(Am + 39 * AP + 60);
            __builtin_amdgcn_sched_barrier(0);
            x40 -= ca2[0] * x39; x41 -= ca2[1] * x39; x42 -= ca2[2] * x39; x43 -= ca2[3] * x39; x44 -= ca3[0] * x39; x45 -= ca3[1] * x39; x46 -= ca3[2] * x39; x47 -= ca3[3] * x39;
            __builtin_amdgcn_sched_barrier(0);
            ca2 = *(const f32x4*)(Am + 40 * AP + 40);
            ca3 = *(const f32x4*)(Am + 40 * AP + 44);
            __builtin_amdgcn_sched_barrier(0);
            x48 -= cb0[0] * x39; x49 -= cb0[1] * x39; x50 -= cb0[2] * x39; x51 -= cb0[3] * x39; x52 -= cb1[0] * x39; x53 -= cb1[1] * x39; x54 -= cb1[2] * x39; x55 -= cb1[3] * x39; x56 -= cb2[0] * x39; x57 -= cb2[1] * x39; x58 -= cb2[2] * x39; x59 -= cb2[3] * x39; x60 -= cb3[0] * x39; x61 -= cb3[1] * x39; x62 -= cb3[2] * x39; x63 -= cb3[3] * x39;
            __builtin_amdgcn_sched_barrier(0);
            cb0 = *(const f32x4*)(Am + 40 * AP + 48);
            cb1 = *(const f32x4*)(Am + 40 * AP + 52);
            cb2 = *(const f32x4*)(Am + 40 * AP + 56);
            cb3 = *(const f32x4*)(Am + 40 * AP + 60);
            __builtin_amdgcn_sched_barrier(0);
            x41 -= ca2[1] * x40; x42 -= ca2[2] * x40; x43 -= ca2[3] * x40; x44 -= ca3[0] * x40; x45 -= ca3[1] * x40; x46 -= ca3[2] * x40; x47 -= ca3[3] * x40;
            __builtin_amdgcn_sched_barrier(0);
            ca2 = *(const f32x4*)(Am + 41 * AP + 40);
            ca3 = *(const f32x4*)(Am + 41 * AP + 44);
            __builtin_amdgcn_sched_barrier(0);
            x48 -= cb0[0] * x40; x49 -= cb0[1] * x40; x50 -= cb0[2] * x40; x51 -= cb0[3] * x40; x52 -= cb1[0] * x40; x53 -= cb1[1] * x40; x54 -= cb1[2] * x40; x55 -= cb1[3] * x40; x56 -= cb2[0] * x40; x57 -= cb2[1] * x40; x58 -= cb2[2] * x40; x59 -= cb2[3] * x40; x60 -= cb3[0] * x40; x61 -= cb3[1] * x40; x62 -= cb3[2] * x40; x63 -= cb3[3] * x40;
            __builtin_amdgcn_sched_barrier(0);
            cb0 = *(const f32x4*)(Am + 41 * AP + 48);
            cb1 = *(const f32x4*)(Am + 41 * AP + 52);
            cb2 = *(const f32x4*)(Am + 41 * AP + 56);
            cb3 = *(const f32x4*)(Am + 41 * AP + 60);
            __builtin_amdgcn_sched_barrier(0);
            x42 -= ca2[2] * x41; x43 -= ca2[3] * x41; x44 -= ca3[0] * x41; x45 -= ca3[1] * x41; x46 -= ca3[2] * x41; x47 -= ca3[3] * x41;
            __builtin_amdgcn_sched_barrier(0);
            ca2 = *(const f32x4*)(Am + 42 * AP + 40);
            ca3 = *(const f32x4*)(Am + 42 * AP + 44);
            __builtin_amdgcn_sched_barrier(0);
            x48 -= cb0[0] * x41; x49 -= cb0[1] * x41; x50 -= cb0[2] * x41; x51 -= cb0[3] * x41; x52 -= cb1[0] * x41; x53 -= cb1[1] * x41; x54 -= cb1[2] * x41; x55 -= cb1[3] * x41; x56 -= cb2[0] * x41; x57 -= cb2[1] * x41; x58 -= cb2[2] * x41; x59 -= cb2[3] * x41; x60 -= cb3[0] * x41; x61 -= cb3[1] * x41; x62 -= cb3[2] * x41; x63 -= cb3[3] * x41;
            __builtin_amdgcn_sched_barrier(0);
            cb0 = *(const f32x4*)(Am + 42 * AP + 48);
            cb1 = *(const f32x4*)(Am + 42 * AP + 52);
            cb2 = *(const f32x4*)(Am + 42 * AP + 56);
            cb3 = *(const f32x4*)(Am + 42 * AP + 60);
            __builtin_amdgcn_sched_barrier(0);
            x43 -= ca2[3] * x42; x44 -= ca3[0] * x42; x45 -= ca3[1] * x42; x46 -= ca3[2] * x42; x47 -= ca3[3] * x42;
            __builtin_amdgcn_sched_barrier(0);
            ca3 = *(const f32x4*)(Am + 43 * AP + 44);
            __builtin_amdgcn_sched_barrier(0);
            x48 -= cb0[0] * x42; x49 -= cb0[1] * x42; x50 -= cb0[2] * x42; x51 -= cb0[3] * x42; x52 -= cb1[0] * x42; x53 -= cb1[1] * x42; x54 -= cb1[2] * x42; x55 -= cb1[3] * x42; x56 -= cb2[0] * x42; x57 -= cb2[1] * x42; x58 -= cb2[2] * x42; x59 -= cb2[3] * x42; x60 -= cb3[0] * x42; x61 -= cb3[1] * x42; x62 -= cb3[2] * x42; x63 -= cb3[3] * x42;
            __builtin_amdgcn_sched_barrier(0);
            cb0 = *(const f32x4*)(Am + 43 * AP + 48);
            cb1 = *(const f32x4*)(Am + 43 * AP + 52);
            cb2 = *(const f32x4*)(Am + 43 * AP + 56);
            cb3 = *(const f32x4*)(Am + 43 * AP + 60);
            __builtin_amdgcn_sched_barrier(0);
            x44 -= ca3[0] * x43; x45 -= ca3[1] * x43; x46 -= ca3[2] * x43; x47 -= ca3[3] * x43;
            __builtin_amdgcn_sched_barrier(0);
            ca3 = *(const f32x4*)(Am + 44 * AP + 44);
            __builtin_amdgcn_sched_barrier(0);
            x48 -= cb0[0] * x43; x49 -= cb0[1] * x43; x50 -= cb0[2] * x43; x51 -= cb0[3] * x43; x52 -= cb1[0] * x43; x53 -= cb1[1] * x43; x54 -= cb1[2] * x43; x55 -= cb1[3] * x43; x56 -= cb2[0] * x43; x57 -= cb2[1] * x43; x58 -= cb2[2] * x43; x59 -= cb2[3] * x43; x60 -= cb3[0] * x43; x61 -= cb3[1] * x43; x62 -= cb3[2] * x43; x63 -= cb3[3] * x43;
            __builtin_amdgcn_sched_barrier(0);
            cb0 = *(const f32x4*)(Am + 44 * AP + 48);
            cb1 = *(const f32x4*)(Am + 44 * AP + 52);
            cb2 = *(const f32x4*)(Am + 44 * AP + 56);
            cb3 = *(const f32x4*)(Am + 44 * AP + 60);
            __builtin_amdgcn_sched_barrier(0);
            x45 -= ca3[1] * x44; x46 -= ca3[2] * x44; x47 -= ca3[3] * x44;
            __builtin_amdgcn_sched_barrier(0);
            ca3 = *(const f32x4*)(Am + 45 * AP + 44);
            __builtin_amdgcn_sched_barrier(0);
            x48 -= cb0[0] * x44; x49 -= cb0[1] * x44; x50 -= cb0[2] * x44; x51 -= cb0[3] * x44; x52 -= cb1[0] * x44; x53 -= cb1[1] * x44; x54 -= cb1[2] * x44; x55 -= cb1[3] * x44; x56 -= cb2[0] * x44; x57 -= cb2[1] * x44; x58 -= cb2[2] * x44; x59 -= cb2[3] * x44; x60 -= cb3[0] * x44; x61 -= cb3[1] * x44; x62 -= cb3[2] * x44; x63 -= cb3[3] * x44;
            __builtin_amdgcn_sched_barrier(0);
            cb0 = *(const f32x4*)(Am + 45 * AP + 48);
            cb1 = *(const f32x4*)(Am + 45 * AP + 52);
            cb2 = *(const f32x4*)(Am + 45 * AP + 56);
            cb3 = *(const f32x4*)(Am + 45 * AP + 60);
            __builtin_amdgcn_sched_barrier(0);
            x46 -= ca3[2] * x45; x47 -= ca3[3] * x45;
            __builtin_amdgcn_sched_barrier(0);
            ca3 = *(const f32x4*)(Am + 46 * AP + 44);
            __builtin_amdgcn_sched_barrier(0);
            x48 -= cb0[0] * x45; x49 -= cb0[1] * x45; x50 -= cb0[2] * x45; x51 -= cb0[3] * x45; x52 -= cb1[0] * x45; x53 -= cb1[1] * x45; x54 -= cb1[2] * x45; x55 -= cb1[3] * x45; x56 -= cb2[0] * x45; x57 -= cb2[1] * x45; x58 -= cb2[2] * x45; x59 -= cb2[3] * x45; x60 -= cb3[0] * x45; x61 -= cb3[1] * x45; x62 -= cb3[2] * x45; x63 -= cb3[3] * x45;
            __builtin_amdgcn_sched_barrier(0);
            cb0 = *(const f32x4*)(Am + 46 * AP + 48);
            cb1 = *(const f32x4*)(Am + 46 * AP + 52);
            cb2 = *(const f32x4*)(Am + 46 * AP + 56);
            cb3 = *(const f32x4*)(Am + 46 * AP + 60);
            __builtin_amdgcn_sched_barrier(0);
            x47 -= ca3[3] * x46;
            __builtin_amdgcn_sched_barrier(0);
            ca0 = *(const f32x4*)(Am + 47 * AP + 48);
            ca1 = *(const f32x4*)(Am + 47 * AP + 52);
            ca2 = *(const f32x4*)(Am + 47 * AP + 56);
            ca3 = *(const f32x4*)(Am + 47 * AP + 60);
            __builtin_amdgcn_sched_barrier(0);
            x48 -= cb0[0] * x46; x49 -= cb0[1] * x46; x50 -= cb0[2] * x46; x51 -= cb0[3] * x46; x52 -= cb1[0] * x46; x53 -= cb1[1] * x46; x54 -= cb1[2] * x46; x55 -= cb1[3] * x46; x56 -= cb2[0] * x46; x57 -= cb2[1] * x46; x58 -= cb2[2] * x46; x59 -= cb2[3] * x46; x60 -= cb3[0] * x46; x61 -= cb3[1] * x46; x62 -= cb3[2] * x46; x63 -= cb3[3] * x46;
            __builtin_amdgcn_sched_barrier(0);
            cb0 = *(const f32x4*)(Am + 48 * AP + 48);
            cb1 = *(const f32x4*)(Am + 48 * AP + 52);
            cb2 = *(const f32x4*)(Am + 48 * AP + 56);
            cb3 = *(const f32x4*)(Am + 48 * AP + 60);
            __builtin_amdgcn_sched_barrier(0);
            x48 -= ca0[0] * x47; x49 -= ca0[1] * x47; x50 -= ca0[2] * x47; x51 -= ca0[3] * x47; x52 -= ca1[0] * x47; x53 -= ca1[1] * x47; x54 -= ca1[2] * x47; x55 -= ca1[3] * x47; x56 -= ca2[0] * x47; x57 -= ca2[1] * x47; x58 -= ca2[2] * x47; x59 -= ca2[3] * x47; x60 -= ca3[0] * x47; x61 -= ca3[1] * x47; x62 -= ca3[2] * x47; x63 -= ca3[3] * x47;
            __builtin_amdgcn_sched_barrier(0);
            ca0 = *(const f32x4*)(Am + 49 * AP + 48);
            ca1 = *(const f32x4*)(Am + 49 * AP + 52);
            ca2 = *(const f32x4*)(Am + 49 * AP + 56);
            ca3 = *(const f32x4*)(Am + 49 * AP + 60);
            __builtin_amdgcn_sched_barrier(0);
            x49 -= cb0[1] * x48; x50 -= cb0[2] * x48; x51 -= cb0[3] * x48; x52 -= cb1[0] * x48; x53 -= cb1[1] * x48; x54 -= cb1[2] * x48; x55 -= cb1[3] * x48; x56 -= cb2[0] * x48; x57 -= cb2[1] * x48; x58 -= cb2[2] * x48; x59 -= cb2[3] * x48; x60 -= cb3[0] * x48; x61 -= cb3[1] * x48; x62 -= cb3[2] * x48; x63 -= cb3[3] * x48;
            __builtin_amdgcn_sched_barrier(0);
            cb0 = *(const f32x4*)(Am + 50 * AP + 48);
            cb1 = *(const f32x4*)(Am + 50 * AP + 52);
            cb2 = *(const f32x4*)(Am + 50 * AP + 56);
            cb3 = *(const f32x4*)(Am + 50 * AP + 60);
            __builtin_amdgcn_sched_barrier(0);
            x50 -= ca0[2] * x49; x51 -= ca0[3] * x49; x52 -= ca1[0] * x49; x53 -= ca1[1] * x49; x54 -= ca1[2] * x49; x55 -= ca1[3] * x49; x56 -= ca2[0] * x49; x57 -= ca2[1] * x49; x58 -= ca2[2] * x49; x59 -= ca2[3] * x49; x60 -= ca3[0] * x49; x61 -= ca3[1] * x49; x62 -= ca3[2] * x49; x63 -= ca3[3] * x49;
            __builtin_amdgcn_sched_barrier(0);
            ca1 = *(const f32x4*)(Am + 51 * AP + 52);
            ca2 = *(const f32x4*)(Am + 51 * AP + 56);
            ca3 = *(const f32x4*)(Am + 51 * AP + 60);
            __builtin_amdgcn_sched_barrier(0);
            x51 -= cb0[3] * x50; x52 -= cb1[0] * x50; x53 -= cb1[1] * x50; x54 -= cb1[2] * x50; x55 -= cb1[3] * x50; x56 -= cb2[0] * x50; x57 -= cb2[1] * x50; x58 -= cb2[2] * x50; x59 -= cb2[3] * x50; x60 -= cb3[0] * x50; x61 -= cb3[1] * x50; x62 -= cb3[2] * x50; x63 -= cb3[3] * x50;
            __builtin_amdgcn_sched_barrier(0);
            cb1 = *(const f32x4*)(Am + 52 * AP + 52);
            cb2 = *(const f32x4*)(Am + 52 * AP + 56);
            cb3 = *(const f32x4*)(Am + 52 * AP + 60);
            __builtin_amdgcn_sched_barrier(0);
            x52 -= ca1[0] * x51; x53 -= ca1[1] * x51; x54 -= ca1[2] * x51; x55 -= ca1[3] * x51; x56 -= ca2[0] * x51; x57 -= ca2[1] * x51; x58 -= ca2[2] * x51; x59 -= ca2[3] * x51; x60 -= ca3[0] * x51; x61 -= ca3[1] * x51; x62 -= ca3[2] * x51; x63 -= ca3[3] * x51;
            __builtin_amdgcn_sched_barrier(0);
            ca1 = *(const f32x4*)(Am + 53 * AP + 52);
            ca2 = *(const f32x4*)(Am + 53 * AP + 56);
            ca3 = *(const f32x4*)(Am + 53 * AP + 60);
            __builtin_amdgcn_sched_barrier(0);
            x53 -= cb1[1] * x52; x54 -= cb1[2] * x52; x55 -= cb1[3] * x52; x56 -= cb2[0] * x52; x57 -= cb2[1] * x52; x58 -= cb2[2] * x52; x59 -= cb2[3] * x52; x60 -= cb3[0] * x52; x61 -= cb3[1] * x52; x62 -= cb3[2] * x52; x63 -= cb3[3] * x52;
            __builtin_amdgcn_sched_barrier(0);
            cb1 = *(const f32x4*)(Am + 54 * AP + 52);
            cb2 = *(const f32x4*)(Am + 54 * AP + 56);
            cb3 = *(const f32x4*)(Am + 54 * AP + 60);
            __builtin_amdgcn_sched_barrier(0);
            x54 -= ca1[2] * x53; x55 -= ca1[3] * x53; x56 -= ca2[0] * x53; x57 -= ca2[1] * x53; x58 -= ca2[2] * x53; x59 -= ca2[3] * x53; x60 -= ca3[0] * x53; x61 -= ca3[1] * x53; x62 -= ca3[2] * x53; x63 -= ca3[3] * x53;
            __builtin_amdgcn_sched_barrier(0);
            ca2 = *(const f32x4*)(Am + 55 * AP + 56);
            ca3 = *(const f32x4*)(Am + 55 * AP + 60);
            __builtin_amdgcn_sched_barrier(0);
            x55 -= cb1[3] * x54; x56 -= cb2[0] * x54; x57 -= cb2[1] * x54; x58 -= cb2[2] * x54; x59 -= cb2[3] * x54; x60 -= cb3[0] * x54; x61 -= cb3[1] * x54; x62 -= cb3[2] * x54; x63 -= cb3[3] * x54;
            __builtin_amdgcn_sched_barrier(0);
            cb2 = *(const f32x4*)(Am + 56 * AP + 56);
            cb3 = *(const f32x4*)(Am + 56 * AP + 60);
            __builtin_amdgcn_sched_barrier(0);
            x56 -= ca2[0] * x55; x57 -= ca2[1] * x55; x58 -= ca2[2] * x55; x59 -= ca2[3] * x55; x60 -= ca3[0] * x55; x61 -= ca3[1] * x55; x62 -= ca3[2] * x55; x63 -= ca3[3] * x55;
            __builtin_amdgcn_sched_barrier(0);
            ca2 = *(const f32x4*)(Am + 57 * AP + 56);
            ca3 = *(const f32x4*)(Am + 57 * AP + 60);
            __builtin_amdgcn_sched_barrier(0);
            x57 -= cb2[1] * x56; x58 -= cb2[2] * x56; x59 -= cb2[3] * x56; x60 -= cb3[0] * x56; x61 -= cb3[1] * x56; x62 -= cb3[2] * x56; x63 -= cb3[3] * x56;
            __builtin_amdgcn_sched_barrier(0);
            cb2 = *(const f32x4*)(Am + 58 * AP + 56);
            cb3 = *(const f32x4*)(Am + 58 * AP + 60);
            __builtin_amdgcn_sched_barrier(0);
            x58 -= ca2[2] * x57; x59 -= ca2[3] * x57; x60 -= ca3[0] * x57; x61 -= ca3[1] * x57; x62 -= ca3[2] * x57; x63 -= ca3[3] * x57;
            __builtin_amdgcn_sched_barrier(0);
            ca3 = *(const f32x4*)(Am + 59 * AP + 60);
            __builtin_amdgcn_sched_barrier(0);
            x59 -= cb2[3] * x58; x60 -= cb3[0] * x58; x61 -= cb3[1] * x58; x62 -= cb3[2] * x58; x63 -= cb3[3] * x58;
            __builtin_amdgcn_sched_barrier(0);
            cb3 = *(const f32x4*)(Am + 60 * AP + 60);
            __builtin_amdgcn_sched_barrier(0);
            x60 -= ca3[0] * x59; x61 -= ca3[1] * x59; x62 -= ca3[2] * x59; x63 -= ca3[3] * x59;
            __builtin_amdgcn_sched_barrier(0);
            ca3 = *(const f32x4*)(Am + 61 * AP + 60);
            __builtin_amdgcn_sched_barrier(0);
            x61 -= cb3[1] * x60; x62 -= cb3[2] * x60; x63 -= cb3[3] * x60;
            __builtin_amdgcn_sched_barrier(0);
            cb3 = *(const f32x4*)(Am + 62 * AP + 60);
            __builtin_amdgcn_sched_barrier(0);
            x62 -= ca3[2] * x61; x63 -= ca3[3] * x61;
            __builtin_amdgcn_sched_barrier(0);
            __builtin_amdgcn_sched_barrier(0);
            x63 -= cb3[3] * x62;
            __builtin_amdgcn_sched_barrier(0);
            asm volatile("s_waitcnt lgkmcnt(0)" ::: "memory");
            Am[0 * AP + lane] = x0 * bt;
            Am[1 * AP + lane] = x1 * bt;
            Am[2 * AP + lane] = x2 * bt;
            Am[3 * AP + lane] = x3 * bt;
            Am[4 * AP + lane] = x4 * bt;
            Am[5 * AP + lane] = x5 * bt;
            Am[6 * AP + lane] = x6 * bt;
            Am[7 * AP + lane] = x7 * bt;
            Am[8 * AP + lane] = x8 * bt;
            Am[9 * AP + lane] = x9 * bt;
            Am[10 * AP + lane] = x10 * bt;
            Am[11 * AP + lane] = x11 * bt;
            Am[12 * AP + lane] = x12 * bt;
            Am[13 * AP + lane] = x13 * bt;
            Am[14 * AP + lane] = x14 * bt;
            Am[15 * AP + lane] = x15 * bt;
            Am[16 * AP + lane] = x16 * bt;
            Am[17 * AP + lane] = x17 * bt;
            Am[18 * AP + lane] = x18 * bt;
            Am[19 * AP + lane] = x19 * bt;
            Am[20 * AP + lane] = x20 * bt;
            Am[21 * AP + lane] = x21 * bt;
            Am[22 * AP + lane] = x22 * bt;
            Am[23 * AP + lane] = x23 * bt;
            Am[24 * AP + lane] = x24 * bt;
            Am[25 * AP + lane] = x25 * bt;
            Am[26 * AP + lane] = x26 * bt;
            Am[27 * AP + lane] = x27 * bt;
            Am[28 * AP + lane] = x28 * bt;
            Am[29 * AP + lane] = x29 * bt;
            Am[30 * AP + lane] = x30 * bt;
            Am[31 * AP + lane] = x31 * bt;
            Am[32 * AP + lane] = x32 * bt;
            Am[33 * AP + lane] = x33 * bt;
            Am[34 * AP + lane] = x34 * bt;
            Am[35 * AP + lane] = x35 * bt;
            Am[36 * AP + lane] = x36 * bt;
            Am[37 * AP + lane] = x37 * bt;
            Am[38 * AP + lane] = x38 * bt;
            Am[39 * AP + lane] = x39 * bt;
            Am[40 * AP + lane] = x40 * bt;
            Am[41 * AP + lane] = x41 * bt;
            Am[42 * AP + lane] = x42 * bt;
            Am[43 * AP + lane] = x43 * bt;
            Am[44 * AP + lane] = x44 * bt;
            Am[45 * AP + lane] = x45 * bt;
            Am[46 * AP + lane] = x46 * bt;
            Am[47 * AP + lane] = x47 * bt;
            Am[48 * AP + lane] = x48 * bt;
            Am[49 * AP + lane] = x49 * bt;
            Am[50 * AP + lane] = x50 * bt;
            Am[51 * AP + lane] = x51 * bt;
            Am[52 * AP + lane] = x52 * bt;
            Am[53 * AP + lane] = x53 * bt;
            Am[54 * AP + lane] = x54 * bt;
            Am[55 * AP + lane] = x55 * bt;
            Am[56 * AP + lane] = x56 * bt;
            Am[57 * AP + lane] = x57 * bt;
            Am[58 * AP + lane] = x58 * bt;
            Am[59 * AP + lane] = x59 * bt;
            Am[60 * AP + lane] = x60 * bt;
            Am[61 * AP + lane] = x61 * bt;
            Am[62 * AP + lane] = x62 * bt;
            Am[63 * AP + lane] = x63 * bt;
        }
        asm volatile("s_waitcnt lgkmcnt(0)" ::: "memory");
        v4u vtr[4][4];
        const bf16* vtp = kvt + (size_t)ch * 16384 + 8192 + lane * 8;
        __builtin_amdgcn_sched_barrier(0);
#pragma unroll
        for (int dt = 2; dt < 4; ++dt)
#pragma unroll
            for (int ks = 0; ks < 4; ++ks) ktr[dt][ks] = *(const v4u*)(ktp + (dt * 4 + ((ks < nks) ? ks : 0)) * 512);
        bf16x8 t2f[2][4];
#pragma unroll
        for (int it = 0; it < 2; ++it)
#pragma unroll
            for (int ks = 0; ks < 4; ++ks) { if (it == 0 && ks >= 2) continue;
                const f32x4 lo = *(const f32x4*)(Am + (32 * it + r) * AP + 16 * ks + 4 * hf), hi = *(const f32x4*)(Am + (32 * it + r) * AP + 16 * ks + 8 + 4 * hf);
                v4u w; w.x = pk2(lo[0], lo[1]); w.y = pk2(lo[2], lo[3]); w.z = pk2(hi[0], hi[1]); w.w = pk2(hi[2], hi[3]); t2f[it][ks] = __builtin_bit_cast(bf16x8, w); }
#pragma unroll
        for (int dt = 0; dt < 4; ++dt) {
            __builtin_amdgcn_sched_barrier(0);
            if (dt == 2) {
#pragma unroll
                for (int et = 0; et < 2; ++et)
#pragma unroll
                    for (int ks = 0; ks < 4; ++ks) vtr[et][ks] = *(const v4u*)(vtp + (et * 4 + ((ks < nks) ? ks : 0)) * 512);
                __builtin_amdgcn_sched_barrier(0);
            }
            f32x16 w0 = zero16(), w1 = zero16();
#pragma unroll
            for (int ks = 0; ks < 4; ++ks) {
                v4u kd = (v4u){0u, 0u, 0u, 0u};
                if (ks < nks) {
                    float kt[8], ke[8], kf[8]; unpack8(ktr[dt][ks], kt);
                    const f32x4 ea = *(const f32x4*)(tab + 128 + 16 * ks + 4 * hf), eb = *(const f32x4*)(tab + 128 + 16 * ks + 8 + 4 * hf);
                    const f32x4 fa = *(const f32x4*)(tab + 192 + 16 * ks + 4 * hf), fb = *(const f32x4*)(tab + 192 + 16 * ks + 8 + 4 * hf);
#pragma unroll
                    for (int c = 0; c < 4; ++c) { ke[c] = kt[c] * ea[c]; ke[4 + c] = kt[4 + c] * eb[c]; kf[c] = kt[c] * fa[c]; kf[4 + c] = kt[4 + c] * fb[c]; }
                    const bf16x8 aop = __builtin_bit_cast(bf16x8, pack8(ke));
                    kd = pack8(kf);
                    w1 = MFMA32(aop, t2f[1][ks], w1);
                    if (ks < 2) w0 = MFMA32(aop, t2f[0][ks], w0);
                }
                *(v4u*)(rec + R_KDEC + (dt * 4 + ks) * 1024 + lane * 16) = kd;
            }
#pragma unroll
            for (int i = 0; i < 16; ++i) { w0[i] = -w0[i]; w1[i] = -w1[i]; }
#pragma unroll
            for (int s = 0; s < 2; ++s) { *(bf16x8*)(rec + R_NEGW + (0 * 8 + 2 * dt + s) * 1024 + lane * 16) = pack_regs(w0, s);
                                          *(bf16x8*)(rec + R_NEGW + (1 * 8 + 2 * dt + s) * 1024 + lane * 16) = pack_regs(w1, s); }
        }
#pragma unroll
        for (int et = 0; et < 4; ++et) {
            __builtin_amdgcn_sched_barrier(0);
            if (et == 0) {
#pragma unroll
                for (int e2 = 2; e2 < 4; ++e2)
#pragma unroll
                    for (int ks = 0; ks < 4; ++ks) vtr[e2][ks] = *(const v4u*)(vtp + (e2 * 4 + ((ks < nks) ? ks : 0)) * 512);
                __builtin_amdgcn_sched_barrier(0);
            }
            f32x16 u0 = zero16(), u1 = zero16();
#pragma unroll
            for (int ks = 0; ks < 4; ++ks) {
                if (ks < nks) { const bf16x8 vb = __builtin_bit_cast(bf16x8, vtr[et][ks]);
                    u1 = MFMA32(t2f[1][ks], vb, u1);
                    if (ks < 2) u0 = MFMA32(t2f[0][ks], vb, u0); }
            }
#pragma unroll
            for (int q = 0; q < 4; ++q) { *(f32x4*)(rec + R_U + (((et * 2 + 0) * 4 + q) * 64 + lane) * 16) = (f32x4){u0[4 * q], u0[4 * q + 1], u0[4 * q + 2], u0[4 * q + 3]};
                                          *(f32x4*)(rec + R_U + (((et * 2 + 1) * 4 + q) * 64 + lane) * 16) = (f32x4){u1[4 * q], u1[4 * q + 1], u1[4 * q + 2], u1[4 * q + 3]}; }
        }
        if (lane == 0) *(float*)(rec + R_EGL) = expf(gl);
    }
}
__device__ __forceinline__ void phase3(const Args& a, unsigned char* lds, int G) {
    const int tid = threadIdx.x, lane = tid & 63, wave = __builtin_amdgcn_readfirstlane(tid >> 6);
    const int gw = blockIdx.x * NWAVES + wave, NGW = G * NWAVES;
    float* Am = (float*)(lds + wave * SLOT_BYTES);
    float* tab = Am + 64 * AP;
#pragma unroll 1
    for (int ch = gw; ch < NB * NH * 64; ch += NGW) chunk_prep_item(a, Am, tab, ch, lane);
}

constexpr int OT_OFF = 2 * R_OPS;

__device__ __forceinline__ void phase4b(const Args& a, int G) {
    const int tid = threadIdx.x, lane = tid & 63, wave = tid >> 6;
    const int gw = blockIdx.x * NWAVES + wave, NGW = G * NWAVES;
    const unsigned* ob = (const unsigned*)(a.ws + WS_OB2); const bf16* zg = (const bf16*)(a.ws + WS_ZG); bf16* mix = (bf16*)(a.ws + WS_XB);
    const int c8 = 8 * lane;
    float wn[8];
#pragma unroll
    for (int c = 0; c < 8; ++c) wn[c] = a.in[11][(c8 & 127) + c];
    constexpr int NP2 = MT / 2, PB = 2;
#pragma unroll 1
    for (int bt = gw; bt < NP2 / PB; bt += NGW) {
        v4u ow0[PB], ow1[PB], z0[PB], z1[PB];
#pragma unroll
        for (int j = 0; j < PB; ++j) { const size_t p = (size_t)bt * PB + j;
            ow0[j] = *(const v4u*)(ob + p * 512 + c8); ow1[j] = *(const v4u*)(ob + p * 512 + c8 + 4);
            z0[j] = *(const v4u*)(zg + (2 * p) * 512 + c8); z1[j] = *(const v4u*)(zg + (2 * p + 1) * 512 + c8); }
#pragma unroll
        for (int j = 0; j < PB; ++j) { const size_t p = (size_t)bt * PB + j;
            const unsigned ww[8] = {ow0[j].x, ow0[j].y, ow0[j].z, ow0[j].w, ow1[j].x, ow1[j].y, ow1[j].z, ow1[j].w};
            float oa[8], obv[8], za[8], zb[8]; float sa = 0.f, sb = 0.f;
#pragma unroll
            for (int c = 0; c < 8; ++c) { oa[c] = bflo(ww[c]); obv[c] = bfhi(ww[c]); sa += oa[c] * oa[c]; sb += obv[c] * obv[c]; }
            sa = red16(sa); sb = red16(sb);
            unpack8(z0[j], za); unpack8(z1[j], zb);
            const float ra = __builtin_amdgcn_rsqf(sa * (1.0f / HD) + RMS_EPS), rb = __builtin_amdgcn_rsqf(sb * (1.0f / HD) + RMS_EPS);
            float ya[8], yb[8];
#pragma unroll
            for (int c = 0; c < 8; ++c) { ya[c] = oa[c] * ra * wn[c] * silu_f(za[c]); yb[c] = obv[c] * rb * wn[c] * silu_f(zb[c]); }
            *(v4u*)(mix + (2 * p) * D + 512 + c8) = pack8(ya); *(v4u*)(mix + (2 * p + 1) * D + 512 + c8) = pack8(yb); }
    }
}
__device__ __forceinline__ void phase4(const Args& a, unsigned char* lds, int G) {
    const int tid = threadIdx.x, lane = tid & 63, wave = __builtin_amdgcn_readfirstlane(tid >> 6);
    unsigned char* ws = a.ws;
    const int r = lane & 31, hf = lane >> 5;
    if (wave == 0) {
        float* Am = (float*)lds;
#pragma unroll 1
        for (int sq = blockIdx.x; sq < NB * NH + NBS * NH; sq += G) if (sq >= NB * NH) chunk_prep_item(a, Am, Am + 64 * AP, NB * NH * 64 + sq - NB * NH, lane);
    }
    asm volatile("s_waitcnt vmcnt(0) lgkmcnt(0)" ::: "memory");
    for (int sq = blockIdx.x; sq < NB * NH + NBS * NH; sq += G) {
        const bool smp = sq >= NB * NH;
        const int sl = smp ? sq - NB * NH : sq, hh = sl & 3;
        const int ch0 = smp ? NB * NH * 64 + sl : sq * 64, nch = smp ? 1 : 64, ntok = smp ? DSEQ : 64;
        const int rbase = smp ? MP + (sl >> 2) * DSEQ : (sl >> 2) * SEQ;
        const unsigned char* rec0 = ws + WS_PREP + (size_t)ch0 * REC;
        __syncthreads();
        if (wave >= 4) {
            const int hw = wave - 4;
            v4u pf[14];
#pragma unroll
            for (int j = 0; j < 14; ++j) pf[j] = *(const v4u*)(rec0 + (hw + 4 * j) * 1024 + lane * 16);
#pragma unroll
            for (int j = 0; j < 14; ++j) *(v4u*)(lds + (hw + 4 * j) * 1024 + lane * 16) = pf[j];
            if (nch > 1) {
#pragma unroll
                for (int j = 0; j < 14; ++j) pf[j] = *(const v4u*)(rec0 + REC + (hw + 4 * j) * 1024 + lane * 16); }
            asm volatile("s_waitcnt lgkmcnt(0)" ::: "memory");
            __builtin_amdgcn_s_barrier(); asm volatile("" ::: "memory");
#pragma unroll 1
            for (int n = 0; n < nch; ++n) {
                if (n + 1 < nch) { unsigned char* dst = lds + ((n + 1) & 1) * R_OPS;
#pragma unroll
                    for (int j = 0; j < 14; ++j) *(v4u*)(dst + (hw + 4 * j) * 1024 + lane * 16) = pf[j]; }
                if (n + 2 < nch) { const unsigned char* rn = rec0 + (size_t)(n + 2) * REC;
#pragma unroll
                    for (int j = 0; j < 14; ++j) pf[j] = *(const v4u*)(rn + (hw + 4 * j) * 1024 + lane * 16); }
                asm volatile("s_waitcnt lgkmcnt(0)" ::: "memory");
                __builtin_amdgcn_s_barrier(); asm volatile("" ::: "memory");
            }
        } else {
            const int w = wave;
            f32x16 S[4];
            if (smp) { const float* sp = a.in[4] + (size_t)sl * HD * HD + 32 * w + r;
#pragma unroll
                for (int dt = 0; dt < 4; ++dt)
#pragma unroll
                    for (int i = 0; i < 16; ++i) S[dt][i] = sp[(size_t)(32 * dt + (i & 3) + 8 * (i >> 2) + 4 * hf) * HD]; }
            else {
#pragma unroll
                for (int dt = 0; dt < 4; ++dt) S[dt] = zero16(); }
            f32x16 un0, un1;
#pragma unroll
            for (int q = 0; q < 4; ++q) { const f32x4 t0 = *(const f32x4*)(rec0 + R_U + (((w * 2 + 0) * 4 + q) * 64 + lane) * 16), t1 = *(const f32x4*)(rec0 + R_U + (((w * 2 + 1) * 4 + q) * 64 + lane) * 16);
#pragma unroll
                for (int c = 0; c < 4; ++c) { un0[4 * q + c] = t0[c]; un1[4 * q + c] = t1[c]; } }
            float egn = *(const float*)(rec0 + R_EGL);
            __builtin_amdgcn_s_barrier(); asm volatile("" ::: "memory");
#pragma unroll 1
            for (int n = 0; n < nch; ++n) {
                const unsigned char* op = lds + (n & 1) * R_OPS + lane * 16;
                f32x16 av0 = un0, av1 = un1, ao0 = zero16(), ao1 = zero16();
                const float eg = egn;
                if (n + 1 < nch) { const unsigned char* rn = rec0 + (size_t)(n + 1) * REC;
#pragma unroll
                    for (int q = 0; q < 4; ++q) { const f32x4 t0 = *(const f32x4*)(rn + R_U + (((w * 2 + 0) * 4 + q) * 64 + lane) * 16), t1 = *(const f32x4*)(rn + R_U + (((w * 2 + 1) * 4 + q) * 64 + lane) * 16);
#pragma unroll
                        for (int c = 0; c < 4; ++c) { un0[4 * q + c] = t0[c]; un1[4 * q + c] = t1[c]; } }
                    egn = *(const float*)(rn + R_EGL); }
                bf16x8 fa[4], fb[6];
#pragma unroll
                for (int q = 0; q < 4; ++q) fa[q] = *(const bf16x8*)(op + (q >> 1) * R_QG + ((q & 1) * 8 + 0) * 1024);
#pragma unroll
                for (int ks = 0; ks < 8; ++ks) {
                    bf16x8 fn[4];
                    if (ks < 7) {
#pragma unroll
                        for (int q = 0; q < 4; ++q) fn[q] = *(const bf16x8*)(op + (q >> 1) * R_QG + ((q & 1) * 8 + ks + 1) * 1024); }
                    else {
                        fb[0] = *(const bf16x8*)(op + R_ATTN + (0 * 4 + 0) * 1024); fb[1] = *(const bf16x8*)(op + R_ATTN + (1 * 4 + 0) * 1024);
#pragma unroll
                        for (int dt = 0; dt < 4; ++dt) fb[2 + dt] = *(const bf16x8*)(op + R_KDEC + (dt * 4 + 0) * 1024); }
                    __builtin_amdgcn_sched_barrier(0);
                    const bf16x8 B = pack_regs(S[ks >> 1], ks & 1);
                    av0 = MFMA32(fa[0], B, av0); av1 = MFMA32(fa[1], B, av1); ao0 = MFMA32(fa[2], B, ao0); ao1 = MFMA32(fa[3], B, ao1);
                    if (ks & 1) {
#pragma unroll
                        for (int i = 0; i < 16; ++i) S[ks >> 1][i] *= eg; }
                    __builtin_amdgcn_sched_barrier(0);
                    if (ks < 7) {
#pragma unroll
                        for (int q = 0; q < 4; ++q) fa[q] = fn[q]; }
                }
#pragma unroll
                for (int ks = 0; ks < 4; ++ks) {
                    const int jt = ks >> 1, s = ks & 1;
                    bf16x8 fn[6];
                    if (ks < 3) { fn[0] = *(const bf16x8*)(op + R_ATTN + (0 * 4 + ks + 1) * 1024); fn[1] = *(const bf16x8*)(op + R_ATTN + (1 * 4 + ks + 1) * 1024);
#pragma unroll
                        for (int dt = 0; dt < 4; ++dt) fn[2 + dt] = *(const bf16x8*)(op + R_KDEC + (dt * 4 + ks + 1) * 1024); }
                    __builtin_amdgcn_sched_barrier(0);
                    const bf16x8 Bv = pack_regs(jt ? av1 : av0, s);
                    if (jt == 0) ao0 = MFMA32(fb[0], Bv, ao0);
                    ao1 = MFMA32(fb[1], Bv, ao1);
#pragma unroll
                    for (int dt = 0; dt < 4; ++dt) S[dt] = MFMA32(fb[2 + dt], Bv, S[dt]);
                    __builtin_amdgcn_sched_barrier(0);
                    if (ks < 3) {
#pragma unroll
                        for (int q = 0; q < 6; ++q) fb[q] = fn[q]; }
                }
                unsigned* ob = (unsigned*)(ws + WS_OB2) + (size_t)((rbase + n * 64) >> 1) * 512 + hh * HD + 32 * w + r;
#pragma unroll
                for (int i2 = 0; i2 < 8; ++i2) { const int p = (((2 * i2) & 3) + 8 * ((2 * i2) >> 2) + 4 * hf) >> 1;
                    ob[(size_t)p * 512] = pk2(ao0[2 * i2], ao0[2 * i2 + 1]);
                    if (!smp) ob[(size_t)(16 + p) * 512] = pk2(ao1[2 * i2], ao1[2 * i2 + 1]); }
                __builtin_amdgcn_s_barrier(); asm volatile("" ::: "memory");
            }
            float* so = a.out + (smp ? O_ST_S : O_ST_P) + (size_t)sl * HD * HD + 32 * w + r;
#pragma unroll
            for (int dt = 0; dt < 4; ++dt)
#pragma unroll
                for (int i = 0; i < 16; ++i) so[(size_t)(32 * dt + (i & 3) + 8 * (i >> 2) + 4 * hf) * HD] = S[dt][i];
        }
    }
}

__device__ __forceinline__ void phase6(const Args& a, int G) {
    const int tid = threadIdx.x, lane = tid & 63, wave = tid >> 6;
    const int gw = blockIdx.x * NWAVES + wave, NGW = G * NWAVES;
    const float* outb = (const float*)(a.ws + WS_OUT); const float* ln_post = a.in[13];
    f32x4 lw[4];
#pragma unroll
    for (int i = 0; i < 4; ++i) lw[i] = *((const f32x4*)ln_post + 64 * i + lane);
    for (int r = gw; r < MT; r += NGW) {
        const float* xrow = (r < MP) ? a.in[0] + (size_t)r * D : a.in[1] + (size_t)(r - MP) * D;
        f32x4 v[4], xv[4]; float ss = 0.f;
#pragma unroll
        for (int i = 0; i < 4; ++i) { v[i] = *((const f32x4*)(outb + (size_t)r * D) + 64 * i + lane); xv[i] = *((const f32x4*)xrow + 64 * i + lane);
            ss += (v[i][0] * v[i][0] + v[i][1] * v[i][1]) + (v[i][2] * v[i][2] + v[i][3] * v[i][3]); }
        ss = wave_sum(ss);
        const float rs = 1.0f / sqrtf(ss * (1.0f / D) + RMS_EPS);
#pragma unroll
        for (int i = 0; i < 4; ++i) *((f32x4*)(a.out + O_Y + (size_t)r * D) + 64 * i + lane) = xv[i] + v[i] * rs * lw[i];
    }
}

constexpr int NPHASES = 8;
__global__ void __launch_bounds__(NTHREADS, 2) fwd(Args args) {
    extern __shared__ __attribute__((aligned(16))) unsigned char lds[];
    const int G = gridDim.x;
    const int lo = args.ph_lo, hi = args.ph_hi;
#if ONE_LAUNCH
    cg::grid_group grid = cg::this_grid();
    volatile LAS unsigned* xbw = (volatile LAS unsigned*)((LAS unsigned char*)lds + LDS_PHASE);
    if (threadIdx.x < 4) xbw[threadIdx.x] = 0u;
    __syncthreads();
    XcdBarrier xbar = xcd_barrier_post((unsigned*)(args.ws + WS_BAR), xbw);
#define SEAM() xcd_barrier(xbar)
#define SEAM_CG() grid.sync()
#else
#define SEAM() do {} while (0)
#define SEAM_CG() do {} while (0)
#endif
#define IN(k) (lo <= (k) && (k) < hi)
#define RUNP(k, ...) if (IN(k)) { __VA_ARGS__; if (REP_PHASE == (k)) { SEAM(); __VA_ARGS__; } if (IN((k) + 1)) { if ((k) == 0) SEAM_CG(); else SEAM(); } }
    RUNP(0, phase0(args, lds, G))
    RUNP(1, {
        pg8::Gemm g{(const pg8::bf16_t*)(args.ws + WS_XB), (const pg8::bf16_t*)(args.ws + WS_WB1), MT, NP, D};
        pg8::StaticOrder S; S.init(MT, NP, G, (int)blockIdx.x);
        pg8::EpiProj E{(pg8::bf16_t*)(args.ws + WS_PA), (pg8::bf16_t*)(args.ws + WS_PQ), (pg8::bf16_t*)(args.ws + WS_ZG), (const float*)(args.ws + WS_RSTD)};
        pg8::gemm_phase<pg8::EpiProj, pg8::StaticOrder, true, true>((LAS unsigned char*)lds, g, S, E); })
    RUNP(2, phase2(args, G))
    RUNP(3, phase3(args, lds, G))
    RUNP(4, phase4(args, lds, G))
    RUNP(5, phase4b(args, G))
    RUNP(6, {
        pg8::Gemm g{(const pg8::bf16_t*)(args.ws + WS_XB), (const pg8::bf16_t*)(args.ws + WS_WB2), MT, D, D};
        pg8::StaticOrder S; S.init(MT, D, G, (int)blockIdx.x);
        pg8::EpiF32 E{(float*)(args.ws + WS_OUT), D};
        pg8::gemm_phase<pg8::EpiF32, pg8::StaticOrder, true, true>((LAS unsigned char*)lds, g, S, E); })
    RUNP(7, phase6(args, G))
    if (REP_PHASE == 8) SEAM();
#undef IN
}

extern "C" void kernel_launch(void* const* d_in, const int* in_sizes, int n_in, void* d_out, int out_size, void* d_ws, size_t ws_size, hipStream_t stream) {
    static int grid = 0;
    if (grid == 0) {
        if (n_in != 14 || in_sizes[0] != MP * D || (size_t)out_size != O_END || ws_size < WS_END) {
            fprintf(stderr, "kernel_launch: unexpected shapes: n_in %d in0 %d out %d (want %zu) ws %zu (want >= %zu)\n", n_in, n_in > 0 ? in_sizes[0] : -1, out_size, (size_t)O_END, ws_size, (size_t)WS_END); grid = -1; return; }
        int dev = 0, cus = 0, per_cu = 0;
        (void)hipGetDevice(&dev); (void)hipDeviceGetAttribute(&cus, hipDeviceAttributeMultiprocessorCount, dev);
        if (hipFuncSetAttribute((const void*)fwd, hipFuncAttributeMaxDynamicSharedMemorySize, LDS_BYTES) != hipSuccess) { fprintf(stderr, "kernel_launch: hipFuncSetAttribute failed\n"); grid = -1; return; }
        (void)hipOccupancyMaxActiveBlocksPerMultiprocessor(&per_cu, (const void*)fwd, NTHREADS, LDS_BYTES);
        if (per_cu < 1) { fprintf(stderr, "kernel_launch: occupancy query says %d blocks per CU\n", per_cu); per_cu = 1; }
        (void)hipGetLastError();
        grid = cus * 1;
        fprintf(stderr, "kernel_launch: cus %d per_cu %d grid %d\n", cus, per_cu, grid);
    }
    if (grid < 0) return;
    if (hipMemsetAsync((char*)d_ws + WS_BAR, 0, 16384, stream) != hipSuccess) { fprintf(stderr, "kernel_launch: memset failed\n"); return; }
    Args a{};
    for (int i = 0; i < 14; ++i) a.in[i] = (const float*)d_in[i];
    a.out = (float*)d_out; a.ws = (unsigned char*)d_ws;
#if ONE_LAUNCH
    a.ph_lo = 0; a.ph_hi = NPHASES;
    void* kargs[] = {&a};
    hipError_t e = hipLaunchCooperativeKernel((const void*)fwd, dim3(grid), dim3(NTHREADS), kargs, LDS_BYTES, stream);
    if (e != hipSuccess) fprintf(stderr, "kernel_launch: cooperative launch failed: %s (grid %d)\n", hipGetErrorString(e), grid);
#else
    for (int p = 0; p < NPHASES; ++p) { a.ph_lo = p; a.ph_hi = p + 1;
        hipLaunchKernelGGL(fwd, dim3(grid), dim3(NTHREADS), LDS_BYTES, stream, a);
        const hipError_t le = hipPeekAtLastError();
        if (le != hipSuccess) { fprintf(stderr, "kernel_launch: launch %d failed: %s\n", p, hipGetErrorName(le)); break; } }
#endif
}
```
